# Optimizing an MI355X kernel written in HIP

```python
import math
import jax
import jax.numpy as jnp
from jax import lax
import numpy as np

D_MODEL = 1024
BATCH = 16
SEQ = 2048
DEPTH = 2
DEC_BATCH = 128
DEC_SEQ = 1
PAST_LEN = 16384
PAGE_SIZE = 128

HEAD_DIM = 64
ROT_DIM = HEAD_DIM // 4
ROPE_THETA = 500000.0
BRANCH_W = 384
N_HEADS = BRANCH_W // HEAD_DIM
N_KV = 2
QW = N_HEADS * HEAD_DIM
KVW = N_KV * HEAD_DIM
WIN_A = 128
DIL_GROUPS = ((128, 1), (512, 4), (2048, 16))
N_DIL = len(DIL_GROUPS)
CONV_W = 3
CHUNK = 128
N_SG = 6
N_BRANCH = 4
N_IN = (QW + 2 * KVW) * (1 + N_DIL) + 5 * BRANCH_W
D_FF = -(-(8 * D_MODEL) // (3 * 256)) * 256
Q_BLOCK = 128
EPS = 1e-6

kernel_name = 'hybrid_gated_parallel_mixer_decode_step'


def rms_norm(x, g):
    xf = x.astype(jnp.float32)
    xf = xf * lax.rsqrt(jnp.mean(xf * xf, axis=-1, keepdims=True) + EPS)
    return (xf * g.astype(jnp.float32)).astype(x.dtype)


def partial_rope(x, pos):
    half = ROT_DIM // 2
    inv_freq = ROPE_THETA ** (-2.0 * jnp.arange(half, dtype=jnp.float32) / ROT_DIM)
    ang = pos[:, None] * inv_freq[None, :]
    cos = jnp.cos(ang)[None, :, None, :]
    sin = jnp.sin(ang)[None, :, None, :]
    xf = x.astype(jnp.float32)
    x1 = xf[..., :half]
    x2 = xf[..., half:ROT_DIM]
    out = jnp.concatenate([x1 * cos - x2 * sin, x2 * cos + x1 * sin, xf[..., ROT_DIM:]], axis=-1)
    return out.astype(x.dtype)


def split_columns(z):
    sizes = [QW, KVW, KVW] * (1 + N_DIL) + [BRANCH_W] * 5
    out, o = [], 0
    for s in sizes:
        out.append(z[..., o:o + s])
        o += s
    return out


def attn_heads(q, k, v, qn, kn, pos):
    B, S, _ = q.shape
    q = partial_rope(rms_norm(q.reshape(B, S, N_HEADS, HEAD_DIM), qn), pos)
    k = partial_rope(rms_norm(k.reshape(B, S, N_KV, HEAD_DIM), kn), pos)
    return q, k, v.reshape(B, S, N_KV, HEAD_DIM)


def sliding_window_attn(q, k, v, n_buf, sink):
    B, S, H, dh = q.shape
    G = H // N_KV
    pad = WIN_A - n_buf
    kp = jnp.pad(k, ((0, 0), (pad, 0), (0, 0), (0, 0)))
    vp = jnp.pad(v, ((0, 0), (pad, 0), (0, 0), (0, 0)))
    qb = math.gcd(S, Q_BLOCK)
    nb = S // qb
    span = WIN_A + qb
    qg = q.reshape(B, nb, qb, N_KV, G, dh)
    sink_l = jnp.broadcast_to(sink.astype(jnp.float32).reshape(1, N_KV, G, 1, 1), (B, N_KV, G, qb, 1))
    rel = WIN_A + jnp.arange(qb)[:, None] - jnp.arange(span)[None, :]
    in_band = (rel >= 0) & (rel <= WIN_A)
    scale = 1.0 / math.sqrt(dh)

    def block(i):
        start = i * qb
        kb = lax.dynamic_slice_in_dim(kp, start, span, axis=1)
        vb = lax.dynamic_slice_in_dim(vp, start, span, axis=1)
        s = jnp.einsum('bqkgd,bskd->bkgqs', qg[:, i], kb, preferred_element_type=jnp.float32) * scale
        real = (start + jnp.arange(span)) >= pad
        s = jnp.where(in_band & real[None, :], s, -jnp.inf)
        p = jax.nn.softmax(jnp.concatenate([s, sink_l], axis=-1), axis=-1)[..., :span]
        return jnp.einsum('bkgqs,bskd->bqkgd', p.astype(v.dtype), vb)

    o = lax.map(block, jnp.arange(nb))
    return jnp.moveaxis(o, 0, 1).reshape(B, S, H, dh)


def dilated_attn(q, k, v, n_buf, window, dil):
    B, S, H, dh = q.shape
    G = H // N_KV
    pad = window - n_buf
    kp = jnp.pad(k, ((0, 0), (pad, 0), (0, 0), (0, 0)))
    vp = jnp.pad(v, ((0, 0), (pad, 0), (0, 0), (0, 0)))
    nk = window // dil + 1
    qb = math.gcd(S, Q_BLOCK)
    nb = S // qb
    qg = q.reshape(B, nb, qb, N_KV, G, dh)
    steps = dil * jnp.arange(nk)
    scale = 1.0 / math.sqrt(dh)

    def block(i):
        kidx = i * qb + window + jnp.arange(qb)[:, None] - steps[None, :]
        kb = jnp.take(kp, kidx, axis=1)
        vb = jnp.take(vp, kidx, axis=1)
        s = jnp.einsum('bqkgd,bqnkd->bkgqn', qg[:, i], kb, preferred_element_type=jnp.float32) * scale
        s = jnp.where(kidx >= pad, s, -jnp.inf)
        lse = jax.nn.logsumexp(s, axis=-1)
        p = jnp.exp(s - lse[..., None])
        o = jnp.einsum('bkgqn,bqnkd->bqkgd', p.astype(v.dtype), vb)
        return o, jnp.moveaxis(lse, 3, 1)

    o, lse = lax.map(block, jnp.arange(nb))
    o = jnp.moveaxis(o, 0, 1).reshape(B, S, H, dh)
    lse = jnp.moveaxis(lse, 0, 1).reshape(B, S, H)
    return o, lse


def chunk_spatial_gate(u, v, ws, bs):
    B, S, C = v.shape
    sp = -(-S // CHUNK) * CHUNK
    vp = jnp.pad(v, ((0, 0), (0, sp - S), (0, 0))).reshape(B, sp // CHUNK, CHUNK, N_SG, C // N_SG)
    tri = jnp.tril(jnp.ones((CHUNK, CHUNK), dtype=bool))
    wm = jnp.where(tri[None], ws, 0.0).astype(v.dtype)
    sv = jnp.einsum('gij,bcjge->bcige', wm, vp) + bs.T.astype(v.dtype)[None, None, :, :, None]
    return u * sv.reshape(B, sp, C)[:, :S]


def trunk_layer(x, pos, buf_a, bufs_b, buf_c, ln1, w_in, q_norm_a, k_norm_a, sink_a, q_norm_b, k_norm_b,
                conv_c, ws_d, bs_d, w_gate, b_gate, w_branch, w_o, ln2, w_ffn_in, w_ffn_out):
    B, S, _ = x.shape
    h = rms_norm(x, ln1)
    cols = split_columns(h @ w_in)
    q, k, v = attn_heads(cols[0], cols[1], cols[2], q_norm_a, k_norm_a, pos)
    kv = jnp.concatenate([buf_a, jnp.stack([k, v], axis=1)], axis=2)
    o_a = sliding_window_attn(q, kv[:, 0], kv[:, 1], buf_a.shape[2], sink_a)
    new_a = kv[:, :, kv.shape[2] - min(WIN_A, kv.shape[2]):]
    outs, lses, new_b = [], [], []
    for g, (window, dil) in enumerate(DIL_GROUPS):
        c = 3 + 3 * g
        q, k, v = attn_heads(cols[c], cols[c + 1], cols[c + 2], q_norm_b[g], k_norm_b[g], pos)
        kv = jnp.concatenate([bufs_b[g], jnp.stack([k, v], axis=1)], axis=2)
        o, lse = dilated_attn(q, kv[:, 0], kv[:, 1], bufs_b[g].shape[2], window, dil)
        outs.append(o)
        lses.append(lse)
        new_b.append(kv[:, :, kv.shape[2] - min(window, kv.shape[2]):])
    wts = jax.nn.softmax(jnp.stack(lses), axis=0)
    o_b = jnp.einsum('gbsh,gbshd->bshd', wts, jnp.stack(outs).astype(jnp.float32)).astype(x.dtype)
    c = 3 + 3 * N_DIL
    gate_b, gate_c, x_c = cols[c], cols[c + 1], cols[c + 2]
    zc = jnp.concatenate([buf_c, gate_c * x_c], axis=1)
    conv = sum(conv_c[j] * zc[:, j:j + S] for j in range(CONV_W))
    o_c = gate_b * conv
    new_c = zc[:, S:]
    u_d, v_d = cols[c + 3], cols[c + 4]
    o_d = chunk_spatial_gate(u_d, v_d, ws_d, bs_d)
    branches = (o_a.reshape(B, S, BRANCH_W), o_b.reshape(B, S, BRANCH_W), o_c, o_d)
    merged = sum(jax.nn.sigmoid((h @ w_gate[n] + b_gate[n]).astype(jnp.float32)).astype(x.dtype) * (br @ w_branch[n])
                 for n, br in enumerate(branches))
    x = x + merged @ w_o
    h2 = rms_norm(x, ln2)
    gt, up = jnp.split(h2 @ w_ffn_in, 2, axis=-1)
    x = x + (jax.nn.silu(gt) * up) @ w_ffn_out
    return x, new_a, new_b, new_c, v_d


def setup_inputs(seed: int = 0) -> dict:
    key = jax.random.key(seed)
    ks = jax.random.split(key, 24)
    f32 = jnp.float32

    def normal(k, shape, scale):
        return scale * jax.random.normal(k, shape, f32)

    def gain(k, shape):
        return 1.0 + 0.1 * jax.random.normal(k, shape, f32)

    la = min(WIN_A, PAST_LEN)
    lb = [min(w, PAST_LEN) for w, _ in DIL_GROUPS]
    return {
        'x_prompt': normal(ks[0], (BATCH, SEQ, D_MODEL), 1.0),
        'x_sample': normal(ks[1], (DEC_BATCH, DEC_SEQ, D_MODEL), 1.0),
        'cache_a': normal(ks[2], (DEPTH, DEC_BATCH, 2, la, N_KV, HEAD_DIM), 1.0),
        'cache_b1': normal(ks[3], (DEPTH, DEC_BATCH, 2, lb[0], N_KV, HEAD_DIM), 1.0),
        'cache_b2': normal(ks[4], (DEPTH, DEC_BATCH, 2, lb[1], N_KV, HEAD_DIM), 1.0),
        'cache_b3': normal(ks[5], (DEPTH, DEC_BATCH, 2, lb[2], N_KV, HEAD_DIM), 1.0),
        'state_c': normal(ks[6], (DEPTH, DEC_BATCH, CONV_W - 1, BRANCH_W), 1.0),
        'ln1': gain(ks[7], (DEPTH, D_MODEL)),
        'w_in': normal(ks[8], (DEPTH, D_MODEL, N_IN), D_MODEL ** -0.5),
        'q_norm_a': gain(ks[9], (DEPTH, HEAD_DIM)),
        'k_norm_a': gain(ks[10], (DEPTH, HEAD_DIM)),
        'sink_a': normal(ks[11], (DEPTH, N_HEADS), 1.0),
        'q_norm_b': gain(ks[12], (DEPTH, N_DIL, HEAD_DIM)),
        'k_norm_b': gain(ks[13], (DEPTH, N_DIL, HEAD_DIM)),
        'conv_c': normal(ks[14], (DEPTH, CONV_W, BRANCH_W), CONV_W ** -0.5),
        'ws_d': normal(ks[15], (DEPTH, N_SG, CHUNK, CHUNK), CHUNK ** -0.5),
        'bs_d': 1.0 + normal(ks[16], (DEPTH, N_SG, CHUNK), 0.1),
        'w_gate': normal(ks[17], (DEPTH, N_BRANCH, D_MODEL, D_MODEL), D_MODEL ** -0.5),
        'b_gate': normal(ks[18], (DEPTH, N_BRANCH, D_MODEL), 0.02),
        'w_branch': normal(ks[19], (DEPTH, N_BRANCH, BRANCH_W, D_MODEL), BRANCH_W ** -0.5),
        'w_o': normal(ks[20], (DEPTH, D_MODEL, D_MODEL), D_MODEL ** -0.5),
        'ln2': gain(ks[21], (DEPTH, D_MODEL)),
        'w_ffn_in': normal(ks[22], (DEPTH, D_MODEL, 2 * D_FF), D_MODEL ** -0.5),
        'w_ffn_out': normal(ks[23], (DEPTH, D_FF, D_MODEL), D_FF ** -0.5),
    }


def reference(x_prompt, x_sample, cache_a, cache_b1, cache_b2, cache_b3, state_c, ln1, w_in, q_norm_a, k_norm_a,
              sink_a, q_norm_b, k_norm_b, conv_c, ws_d, bs_d, w_gate, b_gate, w_branch, w_o, ln2, w_ffn_in,
              w_ffn_out):
    bp, sp, _ = x_prompt.shape
    ds = x_sample.shape[1]
    dt = x_prompt.dtype
    pos_p = jnp.arange(sp, dtype=jnp.float32)
    pos_s = PAST_LEN + jnp.arange(ds, dtype=jnp.float32)
    empty_kv = jnp.zeros((bp, 2, 0, N_KV, HEAD_DIM), dt)
    zero_conv = jnp.zeros((bp, CONV_W - 1, BRANCH_W), dt)
    caches_b = (cache_b1, cache_b2, cache_b3)
    y_p, y_s = x_prompt, x_sample
    a_p, a_s, c_p, c_s, d_s = [], [], [], [], []
    b_p = [[] for _ in DIL_GROUPS]
    b_s = [[] for _ in DIL_GROUPS]
    for l in range(DEPTH):
        lw = (ln1[l], w_in[l], q_norm_a[l], k_norm_a[l], sink_a[l], q_norm_b[l], k_norm_b[l], conv_c[l],
              ws_d[l], bs_d[l], w_gate[l], b_gate[l], w_branch[l], w_o[l], ln2[l], w_ffn_in[l], w_ffn_out[l])
        y_p, na, nb, nc, _ = trunk_layer(y_p, pos_p, empty_kv, (empty_kv,) * N_DIL, zero_conv, *lw)
        y_s, na2, nb2, nc2, vd = trunk_layer(y_s, pos_s, cache_a[l], tuple(cb[l] for cb in caches_b),
                                             state_c[l], *lw)
        a_p.append(na)
        a_s.append(na2)
        for g in range(N_DIL):
            b_p[g].append(nb[g])
            b_s[g].append(nb2[g])
        c_p.append(nc)
        c_s.append(nc2)
        d_s.append(vd)
    return (y_p, y_s, jnp.stack(a_p), jnp.stack(a_s), jnp.stack(b_p[0]), jnp.stack(b_s[0]),
            jnp.stack(b_p[1]), jnp.stack(b_s[1]), jnp.stack(b_p[2]), jnp.stack(b_s[2]),
            jnp.stack(c_p), jnp.stack(c_s), jnp.stack(d_s))
```

```cpp
#include <hip/hip_runtime.h>
#include <hip/hip_cooperative_groups.h>
#include <cstdio>
#include <cstdint>
namespace cg = cooperative_groups;
#ifndef ONE_LAUNCH
#define ONE_LAUNCH 1
#endif
namespace pg8 {
#define PG8_LAS __attribute__((address_space(3)))
typedef unsigned short bf16_t;
typedef short bf16x8 __attribute__((ext_vector_type(8)));
typedef float f32x4 __attribute__((ext_vector_type(4)));
typedef unsigned u32x4 __attribute__((ext_vector_type(4)));
constexpr int BM = 256, BK = 64, HALF = 128, HTB = HALF * BK * 2  , STAGE_BYTES = 8 * HTB, NXCD = 8, WGM = 8;

__host__ __device__ __forceinline__ int lds_byte(int r, int c) { const int st = (r >> 4) * 2 + (c >> 5), rr = r & 15, cc = c & 31, ob = rr * 64 + cc * 2; return st * 1024 + (ob ^ (((ob >> 9) & 1) << 5)); }
__host__ __device__ __forceinline__ void stage_rc(int b, int& R, int& C) { const int st = b / 1024, sb = b % 1024, swz = sb ^ (((sb >> 9) & 1) << 5); R = (st >> 1) * 16 + swz / 64; C = (st & 1) * 32 + (swz % 64) / 2; }
__host__ __device__ __forceinline__ int perm32(int rho) { const int n = rho >> 4, i = rho & 15; return 8 * (i >> 2) + 4 * n + (i & 3); }

struct Unit { int pm, pn; };
struct Gemm { const bf16_t* A; const bf16_t* Bt; int M, N, K; };

struct StaticOrder {
    int nM, nN, nwg, G, c;
    __host__ __device__ void init(int M, int N, int G_, int c_) { nM = M / BM; nN = N / BM; nwg = nM * nN; G = G_; c = c_; }
    __host__ __device__ bool next(int i, Unit& u) const {
        const long L = (long)i * G + c; if (L >= nwg) return false;
        int wgid = (int)L; { const int q = nwg / NXCD, r = nwg % NXCD, xcd = wgid % NXCD, off = wgid / NXCD; wgid = (xcd < r ? xcd * (q + 1) : r * (q + 1) + (xcd - r) * q) + off; }
        const int nig = WGM * nN, gid = wgid / nig, fm = gid * WGM, gsz = (nM - fm) < WGM ? (nM - fm) : WGM;
        u.pm = fm + ((wgid % nig) % gsz); u.pn = (wgid % nig) / gsz; return true;
    }
    __device__ __forceinline__ void a_ready(const Unit&) const {}
    __device__ __forceinline__ void done(const Unit&) const {}
};

__device__ __forceinline__ unsigned cvt_pk_bf16(float lo, float hi) { unsigned r; asm volatile("v_cvt_pk_bf16_f32 %0, %1, %2" : "=v"(r) : "v"(lo), "v"(hi)); return r; }
typedef float f32x2 __attribute__((ext_vector_type(2)));
__device__ __forceinline__ f32x2 gelu_pk(f32x2 v) {
    const f32x2 av = __builtin_elementwise_abs(v), d = av * 0.2316418882f + 1.0f;
    f32x2 t; t.x = __builtin_amdgcn_rcpf(d.x); t.y = __builtin_amdgcn_rcpf(d.y);
    f32x2 q = t * 0.5307027145f + (-0.7265760135f); q = q * t + 0.7107068705f; q = q * t + (-0.142248368f); q = q * t + 0.127414796f; q = q * t;
    const f32x2 s = (v * v) * (-0.72134752044f);
    f32x2 e; e.x = __builtin_amdgcn_exp2f(s.x); e.y = __builtin_amdgcn_exp2f(s.y);
    const f32x2 m = v * (q * e), r = v - m;
    f32x2 o; o.x = v.x < 0.f ? m.x : r.x; o.y = v.y < 0.f ? m.y : r.y; return o;
}

template <int ACT  > struct EpiBf16 {
    static constexpr bool PERM = true, AFTER_DRAIN = false; static_assert(ACT == 0 || ACT == 1, "EpiBf16: ACT is 0 (none) or 1 (gelu_pk)");
    bf16_t* O; int ldc; const float* bias; int split_cols; size_t split_stride; float scale0;
    __device__ __forceinline__ void operator()(const f32x4 (&acc)[2][2][4][2], const Unit& u, int wr, int wc, int fr, int fq) const {
        const int row0 = u.pm * BM + wr * 64 + fr; int colt = u.pn * BM; bf16_t* base = O;
        float sc = 1.f; if (split_cols) { const int t = colt / split_cols; base += (size_t)t * split_stride; colt -= t * split_cols; if (t == 0) sc = scale0; }
        const int col0 = colt + wc * 32 + 8 * fq, bcol0 = u.pn * BM + wc * 32 + 8 * fq;
        f32x4 bv[2][2];
#pragma unroll
        for (int bj = 0; bj < 2; ++bj)
#pragma unroll
            for (int n = 0; n < 2; ++n) bv[bj][n] = bias ? *(const f32x4*)(bias + bcol0 + bj * HALF + 4 * n) : (f32x4){0.f, 0.f, 0.f, 0.f};
#pragma unroll
        for (int ai = 0; ai < 2; ++ai)
#pragma unroll
            for (int m = 0; m < 4; ++m) { bf16_t* rowp = base + (size_t)(row0 + ai * HALF + m * 16) * ldc + col0;
#pragma unroll
                for (int bj = 0; bj < 2; ++bj) { f32x4 v0 = acc[ai][bj][m][0] + bv[bj][0], v1 = acc[ai][bj][m][1] + bv[bj][1];
                    if (ACT == 1) { f32x2 a = gelu_pk((f32x2){v0[0], v0[1]}), b = gelu_pk((f32x2){v0[2], v0[3]}), c = gelu_pk((f32x2){v1[0], v1[1]}), d = gelu_pk((f32x2){v1[2], v1[3]});
                        v0 = (f32x4){a.x, a.y, b.x, b.y}; v1 = (f32x4){c.x, c.y, d.x, d.y}; }
                    v0 = v0 * sc; v1 = v1 * sc; u32x4 w; w.x = cvt_pk_bf16(v0[0], v0[1]); w.y = cvt_pk_bf16(v0[2], v0[3]); w.z = cvt_pk_bf16(v1[0], v1[1]); w.w = cvt_pk_bf16(v1[2], v1[3]);
                    *(u32x4*)(rowp + bj * HALF) = w; } }
    }
};

template <class Epi, class Sched, bool ALIGN_EPI = false, bool SP2 = false>
__device__ __forceinline__ void gemm_phase(PG8_LAS unsigned char* lds, const Gemm g, const Sched& S, const Epi& E, int tid_in) {
    int tid_l = tid_in; asm volatile("" : "+v"(tid_l));
    const int tid = tid_l, wid = __builtin_amdgcn_readfirstlane(tid >> 6), lane = tid & 63, wr = wid >> 2, wc = wid & 3, fr = lane & 15, fq = lane >> 4;
    const int K = g.K, nt = K / BK;
    unsigned voffA[2], voffB[2];
#pragma unroll
    for (int i = 0; i < 2; ++i) { int R, C; stage_rc(tid * 16 + i * 8192, R, C); const int Rb = Epi::PERM ? ((R & ~31) + perm32(R & 31)) : R;
        voffA[i] = (unsigned)(R * K + C) * 2u; voffB[i] = (unsigned)(Rb * K + C) * 2u; }
    const size_t kstep = (size_t)(BK * 2);
    const size_t hstep = (size_t)HALF * K * 2;
    const size_t tstep = 2 * hstep;
    const unsigned ldsw = (unsigned)wid * 1024u;
    const int aoff = lds_byte(wr * 64 + fr, fq * 8), boff = lds_byte(wc * 32 + fr, fq * 8);
#define PG8_SA(b, h) (((b) * 2 + (h)) * HTB)
#define PG8_SB(b, h) ((4 + (b) * 2 + (h)) * HTB)
#define PG8_STAGE(bufoff, gbase, voff) do { _Pragma("unroll") for (int _i = 0; _i < 2; ++_i) \
        __builtin_amdgcn_global_load_lds((const unsigned*)((const char*)(gbase) + (voff)[_i]), (PG8_LAS unsigned*)(lds + (bufoff) + ldsw + _i * 8192), 16, 0, 0); } while (0)
#define PG8_LDA(dst, b, h) do { _Pragma("unroll") for (int m = 0; m < 4; ++m) _Pragma("unroll") for (int k = 0; k < 2; ++k) dst[m][k] = *(const PG8_LAS bf16x8*)(lds + PG8_SA(b, h) + aoff + m * 2048 + k * 1024); } while (0)
#define PG8_LDB(dst, b, h) do { _Pragma("unroll") for (int n = 0; n < 2; ++n) _Pragma("unroll") for (int k = 0; k < 2; ++k) dst[n][k] = *(const PG8_LAS bf16x8*)(lds + PG8_SB(b, h) + boff + n * 2048 + k * 1024); } while (0)
#define PG8_MMA(ai, bj, At, Bt) do { __builtin_amdgcn_s_setprio(1); _Pragma("unroll") for (int m = 0; m < 4; ++m) _Pragma("unroll") for (int n = 0; n < 2; ++n) _Pragma("unroll") for (int k = 0; k < 2; ++k) \
        acc[ai][bj][m][n] = __builtin_amdgcn_mfma_f32_16x16x32_bf16(Bt[n][k], At[m][k], acc[ai][bj][m][n], 0, 0, 0); __builtin_amdgcn_s_setprio(0); } while (0)
#define PG8_WAIT_V(n) asm volatile("s_waitcnt vmcnt(" #n ")" ::: "memory")
#define PG8_WAIT_L(n) asm volatile("s_waitcnt lgkmcnt(" #n ")" ::: "memory")
#define PG8_BAR __builtin_amdgcn_s_barrier()
#define PG8_SCHED __builtin_amdgcn_sched_barrier(0)
    Unit cur, nxt; int ui = 0;
    if (!S.next(0, cur)) return;
    f32x4 acc[2][2][4][2];
#pragma unroll
    for (int a = 0; a < 2; ++a)
#pragma unroll
        for (int b = 0; b < 2; ++b)
#pragma unroll
            for (int m = 0; m < 4; ++m)
#pragma unroll
                for (int n = 0; n < 2; ++n) acc[a][b][m][n] = (f32x4){0.f, 0.f, 0.f, 0.f};
    bf16x8 At[4][2], B0[2][2], B1[2][2];
    const char* cA = (const char*)g.A + (size_t)cur.pm * tstep; const char* cB = (const char*)g.Bt + (size_t)cur.pn * tstep;
    S.a_ready(cur);
    if constexpr (SP2) {
        PG8_STAGE(PG8_SB(0, 0), cB, voffB); PG8_STAGE(PG8_SB(0, 1), cB + hstep, voffB); PG8_STAGE(PG8_SA(0, 0), cA, voffA); PG8_STAGE(PG8_SA(0, 1), cA + hstep, voffA);
        if (wr == 1) PG8_BAR;
        PG8_WAIT_V(2); PG8_BAR;
        PG8_STAGE(PG8_SB(1, 0), cB + kstep, voffB); PG8_STAGE(PG8_SA(1, 0), cA + kstep, voffA); PG8_STAGE(PG8_SB(1, 1), cB + hstep + kstep, voffB);
        PG8_WAIT_V(6); PG8_BAR;
    } else {
        PG8_STAGE(PG8_SB(0, 0), cB, voffB); PG8_STAGE(PG8_SA(0, 0), cA, voffA); PG8_STAGE(PG8_SB(0, 1), cB + hstep, voffB); PG8_STAGE(PG8_SA(0, 1), cA + hstep, voffA);
        if (wr == 1) PG8_BAR;
        PG8_WAIT_V(4); PG8_BAR;
        PG8_STAGE(PG8_SB(1, 0), cB + kstep, voffB); PG8_STAGE(PG8_SA(1, 0), cA + kstep, voffA); PG8_STAGE(PG8_SB(1, 1), cB + hstep + kstep, voffB);
        PG8_WAIT_V(6); PG8_BAR;
    }
    for (;;) {
        const bool has_next = S.next(ui + 1, nxt);
        const char* nA = has_next ? (const char*)g.A + (size_t)nxt.pm * tstep : cA; const char* nB = has_next ? (const char*)g.Bt + (size_t)nxt.pn * tstep : cB;
        for (int t = 0; t < nt; t += 2) {
            const bool last = (t == nt - 2);
            const char* a1 = cA + (size_t)(t + 1) * kstep;
            const char* a2 = last ? nA : cA + (size_t)(t + 2) * kstep; const char* b2 = last ? nB : cB + (size_t)(t + 2) * kstep;
            const char* a3 = a2 + kstep; const char* b3 = b2 + kstep;
            if (last && has_next) S.a_ready(nxt);
            if constexpr (SP2) {
            PG8_LDB(B0, 0, 0); PG8_LDB(B1, 0, 1); PG8_SCHED; PG8_LDA(At, 0, 0); PG8_STAGE(PG8_SA(1, 1), a1 + hstep, voffA);
            PG8_WAIT_V(8); PG8_WAIT_L(0); PG8_BAR; PG8_MMA(0, 0, At, B0); PG8_MMA(0, 1, At, B1); PG8_BAR; PG8_SCHED;
            PG8_LDA(At, 0, 1); PG8_STAGE(PG8_SB(0, 0), b2, voffB); PG8_STAGE(PG8_SB(0, 1), b2 + hstep, voffB); PG8_STAGE(PG8_SA(0, 0), a2, voffA);
            PG8_WAIT_V(8); PG8_WAIT_L(0); PG8_BAR; PG8_MMA(1, 0, At, B0); PG8_MMA(1, 1, At, B1); PG8_BAR; PG8_SCHED;
            PG8_LDB(B0, 1, 0); PG8_LDB(B1, 1, 1); PG8_SCHED; PG8_LDA(At, 1, 0); PG8_STAGE(PG8_SA(0, 1), a2 + hstep, voffA);
            PG8_WAIT_V(8); PG8_WAIT_L(0); PG8_BAR; PG8_MMA(0, 0, At, B0); PG8_MMA(0, 1, At, B1); PG8_BAR; PG8_SCHED;
            PG8_LDA(At, 1, 1); PG8_STAGE(PG8_SB(1, 0), b3, voffB); PG8_STAGE(PG8_SB(1, 1), b3 + hstep, voffB); PG8_STAGE(PG8_SA(1, 0), a3, voffA);
            PG8_WAIT_V(8); PG8_WAIT_L(0); PG8_BAR; PG8_MMA(1, 0, At, B0); PG8_MMA(1, 1, At, B1); PG8_BAR; PG8_SCHED;
            } else {
            PG8_LDB(B0, 0, 0); PG8_SCHED; PG8_LDA(At, 0, 0); PG8_STAGE(PG8_SA(1, 1), a1 + hstep, voffA);
            PG8_WAIT_L(8); PG8_BAR; PG8_WAIT_L(0); PG8_MMA(0, 0, At, B0); PG8_BAR; PG8_SCHED;
            PG8_LDB(B1, 0, 1); PG8_STAGE(PG8_SB(0, 0), b2, voffB);
            PG8_BAR; PG8_WAIT_L(0); PG8_MMA(0, 1, At, B1); PG8_BAR;
            PG8_LDA(At, 0, 1); PG8_STAGE(PG8_SA(0, 0), a2, voffA);
            PG8_BAR; PG8_WAIT_L(0); PG8_MMA(1, 0, At, B0); PG8_BAR; PG8_SCHED;
            PG8_STAGE(PG8_SB(0, 1), b2 + hstep, voffB);
            PG8_WAIT_V(6); PG8_BAR; PG8_MMA(1, 1, At, B1); PG8_BAR;
            PG8_LDB(B0, 1, 0); PG8_SCHED; PG8_LDA(At, 1, 0); PG8_STAGE(PG8_SA(0, 1), a2 + hstep, voffA);
            PG8_WAIT_L(8); PG8_BAR; PG8_WAIT_L(0); PG8_MMA(0, 0, At, B0); PG8_BAR; PG8_SCHED;
            PG8_LDB(B1, 1, 1); PG8_STAGE(PG8_SB(1, 0), b3, voffB);
            PG8_BAR; PG8_WAIT_L(0); PG8_MMA(0, 1, At, B1); PG8_BAR;
            PG8_LDA(At, 1, 1); PG8_STAGE(PG8_SA(1, 0), a3, voffA);
            PG8_BAR; PG8_WAIT_L(0); PG8_MMA(1, 0, At, B0); PG8_BAR; PG8_SCHED;
            PG8_STAGE(PG8_SB(1, 1), b3 + hstep, voffB);
            PG8_WAIT_V(6); PG8_BAR; PG8_MMA(1, 1, At, B1); PG8_BAR;
            }
        }
        if constexpr (ALIGN_EPI) { if (wr == 0) PG8_BAR; }
        if constexpr (!Epi::AFTER_DRAIN) { E(acc, cur, wr, wc, fr, fq); S.done(cur); }
        if (!has_next) break;
#pragma unroll
        for (int a = 0; a < 2; ++a)
#pragma unroll
            for (int b = 0; b < 2; ++b)
#pragma unroll
                for (int m = 0; m < 4; ++m)
#pragma unroll
                    for (int n = 0; n < 2; ++n) acc[a][b][m][n] = (f32x4){0.f, 0.f, 0.f, 0.f};
        cur = nxt; cA = nA; cB = nB; ++ui;
        if constexpr (ALIGN_EPI) { if (wr == 1) PG8_BAR; }
    }
    PG8_WAIT_V(0);
    if constexpr (!ALIGN_EPI) { if (wr == 0) PG8_BAR; }
    PG8_BAR;
    if constexpr (Epi::AFTER_DRAIN) { E.fused(acc, cur, wr, wc, fr, fq, lds, wid, lane); S.done(cur); }
#undef PG8_SA
#undef PG8_SB
#undef PG8_STAGE
#undef PG8_LDA
#undef PG8_LDB
#undef PG8_MMA
#undef PG8_WAIT_V
#undef PG8_WAIT_L
#undef PG8_BAR
#undef PG8_SCHED
}
}
#define PG8_SP2 true
#define PG8_ALIGN true
namespace mk {
#define LAS __attribute__((address_space(3)))
using pg8::bf16_t; using pg8::bf16x8; using pg8::f32x4; using pg8::u32x4;
typedef float f32x16 __attribute__((ext_vector_type(16)));
typedef short s16x4 __attribute__((ext_vector_type(4)));
typedef unsigned u32x2 __attribute__((ext_vector_type(2)));

constexpr int MP = 32768, MS = 128, MTOK = MP + MS, MPAD = 33024, NTM = MPAD / 256;
constexpr int ZLD = 8704, GOFF = 4608, BW = 384, DFF = 2816;
constexpr int LDS_BYTES = 131072;
constexpr float LOG2E = 1.4426950408889634f, LN2 = 0.6931471805599453f, EPS = 1e-6f;
enum { I_XP = 0, I_XS, I_CA, I_CB1, I_CB2, I_CB3, I_SC, I_LN1, I_WIN, I_QNA, I_KNA, I_SINK, I_QNB, I_KNB, I_CONV, I_WSD, I_BSD, I_WG, I_BG, I_WB, I_WO, I_LN2, I_WFI, I_WFO };
constexpr size_t O_YP = 0, O_YS = 33554432, O_AP = O_YS + 131072, O_AS = O_AP + 1048576, O_B1P = O_AS + 8388608, O_B1S = O_B1P + 1048576, O_B2P = O_B1S + 8388608,
                 O_B2S = O_B2P + 4194304, O_B3P = O_B2S + 33554432, O_B3S = O_B3P + 16777216, O_CP = O_B3S + 134217728, O_CS = O_CP + 24576, O_DS = O_CS + 196608, O_END = O_DS + 98304;
static_assert(O_END == 241623040, "output size");
constexpr size_t al(size_t x) { return (x + 255) & ~(size_t)255; }
constexpr size_t WS_ROPE = 0;
constexpr size_t WS_WM = al(WS_ROPE + 2049 * 16 * 4);
constexpr size_t WS_W = al(WS_WM + 2 * 6 * 128 * 128 * 2);
constexpr size_t W1_B = (size_t)ZLD * 1024 * 2, WB_B = 4ull * 1024 * 384 * 2, WO_B = 1024ull * 1024 * 2, WF_B = 5632ull * 1024 * 2, WD_B = 1024ull * 2816 * 2;
constexpr size_t WL_B = W1_B + WB_B + WO_B + WF_B + WD_B;
constexpr size_t WS_X = al(WS_W + 2 * WL_B);
constexpr size_t WS_H = al(WS_X + (size_t)MPAD * 1024 * 4);
constexpr size_t WS_ZG = al(WS_H + (size_t)MPAD * 1024 * 2);
constexpr size_t WS_BR = al(WS_ZG + (size_t)MPAD * ZLD * 2);
constexpr size_t WS_OB = al(WS_BR + 4ull * MPAD * BW * 2);
constexpr size_t WS_LSE = al(WS_OB + 3ull * MPAD * BW * 2);
constexpr size_t WS_PART = al(WS_LSE + 3ull * MPAD * 8 * 4);
constexpr size_t WS_MRG = al(WS_PART + (size_t)MPAD * 1024 * 4);
constexpr size_t WS_ACT = al(WS_MRG + (size_t)MPAD * 1024 * 2);
constexpr size_t WS_BAR = al(WS_ACT + (size_t)MPAD * DFF * 2);
constexpr size_t WS_SS = al(WS_BAR + 256);
constexpr size_t WS_END = al(WS_SS + 4ull * MPAD * 4);

struct Params { const float* in[24]; float* out; unsigned char* ws; int ph_lo, ph_hi; };
static_assert(sizeof(Params) == 216, "Params has padding");

#define DI __device__ __forceinline__
typedef float f32x2v __attribute__((ext_vector_type(2)));
typedef __bf16 bf16x2v __attribute__((ext_vector_type(2)));
DI unsigned pk2(float lo, float hi) { const f32x2v v = {lo, hi}; return __builtin_bit_cast(unsigned, __builtin_convertvector(v, bf16x2v)); }
DI float bflo(unsigned w) { return __uint_as_float(w << 16); }
DI float bfhi(unsigned w) { return __uint_as_float(w & 0xffff0000u); }
DI float bf1(bf16_t v) { return __uint_as_float((unsigned)v << 16); }
DI void unpack8(const u32x4 w, float (&x)[8]) { x[0] = bflo(w.x); x[1] = bfhi(w.x); x[2] = bflo(w.y); x[3] = bfhi(w.y); x[4] = bflo(w.z); x[5] = bfhi(w.z); x[6] = bflo(w.w); x[7] = bfhi(w.w); }
DI u32x4 pack8(const float (&x)[8]) { u32x4 w; w.x = pk2(x[0], x[1]); w.y = pk2(x[2], x[3]); w.z = pk2(x[4], x[5]); w.w = pk2(x[6], x[7]); return w; }
DI float wave_sum(float v) {
#pragma unroll
    for (int o = 1; o < 64; o <<= 1) v += __shfl_xor(v, o);
    return v; }
DI float wave_max(float v) {
#pragma unroll
    for (int o = 1; o < 64; o <<= 1) v = fmaxf(v, __shfl_xor(v, o));
    return v; }
DI float ex2(float x) { return __builtin_amdgcn_exp2f(x); }
DI int crow(int reg, int h) { return (reg & 3) + 8 * (reg >> 2) + 4 * h; }
#define MFMA32(a, b, c) __builtin_amdgcn_mfma_f32_32x32x16_bf16((a), (b), (c), 0, 0, 0)

struct QuadOrder {
    pg8::StaticOrder o;
    __device__ bool next(int i, pg8::Unit& u) const { pg8::Unit q; if (!o.next(i >> 2, q)) return false; const int n = i & 3; u.pm = n * NTM + q.pm; u.pn = n * 4 + q.pn; return true; }
    DI void a_ready(const pg8::Unit&) const {}
    DI void done(const pg8::Unit&) const {}
};
typedef f32x4 AccT[2][2][4][2];
struct EpiZG {
    static constexpr bool PERM = true, AFTER_DRAIN = false;
    bf16_t* O; const float* bias; const float* rope; const float* qna; const float* kna; const float* qnb; const float* knb; float* out; int l; const float* ss;
    DI void operator()(const AccT& acc, const pg8::Unit& u, int wr, int wc, int fr_, int fq_) const {
        int fr = fr_, fq = fq_; asm volatile("" : "+v"(fr), "+v"(fq));
        const int rowb = u.pm * 256 + wr * 64 + fr;
        if (u.pn >= 18) {
            const int col0 = u.pn * 256 + wc * 32 + 8 * fq;
            f32x4 bv[2][2];
#pragma unroll
            for (int bj = 0; bj < 2; ++bj) { bv[bj][0] = *(const f32x4*)(bias + col0 + bj * 128 - GOFF); bv[bj][1] = *(const f32x4*)(bias + col0 + bj * 128 - GOFF + 4); }
#pragma unroll
            for (int ai = 0; ai < 2; ++ai)
#pragma unroll
                for (int m = 0; m < 4; ++m) {
                    const float rsr = 1.0f / sqrtf(ss[rowb + ai * 128 + m * 16] * (1.f / 1024.f) + EPS);
#pragma unroll
                    for (int bj = 0; bj < 2; ++bj) {
                        f32x4 v0 = acc[ai][bj][m][0] * rsr + bv[bj][0], v1 = acc[ai][bj][m][1] * rsr + bv[bj][1];
#pragma unroll
                        for (int e = 0; e < 4; ++e) { v0[e] = __builtin_amdgcn_rcpf(1.f + ex2(-LOG2E * v0[e])); v1[e] = __builtin_amdgcn_rcpf(1.f + ex2(-LOG2E * v1[e])); }
                        u32x4 w; w.x = pk2(v0[0], v0[1]); w.y = pk2(v0[2], v0[3]); w.z = pk2(v1[0], v1[1]); w.w = pk2(v1[2], v1[3]);
                        *(u32x4*)(O + (size_t)(rowb + ai * 128 + m * 16) * ZLD + col0 + bj * 128) = w;
                    }
                    asm volatile("" ::: "memory");
                }
            return;
        }
        const int c64 = u.pn * 4 + wc, colL = c64 * 64 + 8 * fq;
        int type = 3, gi = 0, hh = 0;
        if (c64 < 40) { gi = c64 / 10; hh = c64 - gi * 10; type = hh < 6 ? 0 : (hh < 8 ? 1 : 2); }
        f32x4 g00 = (f32x4){1.f, 1.f, 1.f, 1.f}, g01 = g00, g10 = g00, g11 = g00;
        if (type <= 1) { const float* gn = (type == 0 ? (gi == 0 ? qna : qnb + (gi - 1) * 64) : (gi == 0 ? kna : knb + (gi - 1) * 64)) + 8 * fq;
            g00 = *(const f32x4*)gn; g01 = *(const f32x4*)(gn + 4); g10 = *(const f32x4*)(gn + 32); g11 = *(const f32x4*)(gn + 36); }
        const int W = gi < 2 ? 128 : (gi == 2 ? 512 : 2048);
        const size_t obase_p = gi == 0 ? O_AP : (gi == 1 ? O_B1P : (gi == 2 ? O_B2P : O_B3P)), obase_s = gi == 0 ? O_AS : (gi == 1 ? O_B1S : (gi == 2 ? O_B2S : O_B3S));
#pragma unroll
        for (int ai = 0; ai < 2; ++ai)
#pragma unroll
            for (int m = 0; m < 4; ++m) {
                const int row = rowb + ai * 128 + m * 16;
                const float rsr = 1.0f / sqrtf(ss[row] * (1.f / 1024.f) + EPS);
                f32x4 v00 = acc[ai][0][m][0] * rsr, v01 = acc[ai][0][m][1] * rsr, v10 = acc[ai][1][m][0] * rsr, v11 = acc[ai][1][m][1] * rsr;
                const bool samp = row >= MP; const int t = row & 2047;
                if (type <= 1) {
                    float ss = 0.f;
#pragma unroll
                    for (int e = 0; e < 4; ++e) ss += v00[e] * v00[e] + v01[e] * v01[e] + v10[e] * v10[e] + v11[e] * v11[e];
                    ss += __shfl_xor(ss, 16); ss += __shfl_xor(ss, 32);
                    const float rs = 1.0f / sqrtf(ss * (1.f / 64.f) + EPS);
                    v00 = v00 * rs * g00; v01 = v01 * rs * g01; v10 = v10 * rs * g10; v11 = v11 * rs * g11;
                    f32x4 y0, y1;
#pragma unroll
                    for (int e = 0; e < 4; ++e) { y0[e] = __shfl_xor(v00[e], 16); y1[e] = __shfl_xor(v01[e], 16); }
                    if (fq < 2) {
                        const float* rp = rope + (samp ? 2048 : t) * 16;
                        const f32x4 c0 = *(const f32x4*)rp, c1 = *(const f32x4*)(rp + 4), c2 = *(const f32x4*)(rp + 8), c3 = *(const f32x4*)(rp + 12);
                        const float sg = fq == 0 ? -1.f : 1.f;
                        v00 = (f32x4){v00[0] * c0[0] + sg * y0[0] * c0[1], v00[1] * c0[2] + sg * y0[1] * c0[3], v00[2] * c1[0] + sg * y0[2] * c1[1], v00[3] * c1[2] + sg * y0[3] * c1[3]};
                        v01 = (f32x4){v01[0] * c2[0] + sg * y1[0] * c2[1], v01[1] * c2[2] + sg * y1[1] * c2[3], v01[2] * c3[0] + sg * y1[2] * c3[1], v01[3] * c3[2] + sg * y1[3] * c3[3]};
                    }
                }
                bf16_t* zp = O + (size_t)row * ZLD + colL;
                { u32x4 w; w.x = pk2(v00[0], v00[1]); w.y = pk2(v00[2], v00[3]); w.z = pk2(v01[0], v01[1]); w.w = pk2(v01[2], v01[3]); *(u32x4*)zp = w; }
                { u32x4 w; w.x = pk2(v10[0], v10[1]); w.y = pk2(v10[2], v10[3]); w.z = pk2(v11[0], v11[1]); w.w = pk2(v11[2], v11[3]); *(u32x4*)(zp + 32) = w; }
                if ((type == 1 || type == 2) && row < MTOK) {
                    const int b = samp ? row - MP : row >> 11, jrow = samp ? W - 1 : t - (2048 - W);
                    if (jrow >= 0) {
                        const size_t cb = samp ? obase_s + ((size_t)(l * 128 + b) * 2) * W * 128 : obase_p + ((size_t)(l * 16 + b) * 2) * W * 128;
                        float* d = out + cb + ((size_t)(type - 1) * W + jrow) * 128 + (hh - (type == 1 ? 6 : 8)) * 64 + 8 * fq;
                        *(f32x4*)d = v00; *(f32x4*)(d + 4) = v01; *(f32x4*)(d + 32) = v10; *(f32x4*)(d + 36) = v11;
                    }
                }
                asm volatile("" ::: "memory");
            }
    }
};
struct EpiBranch {
    static constexpr bool PERM = true, AFTER_DRAIN = false;
    const bf16_t* G; float* part; bf16_t* mrg;
    DI void operator()(const AccT& acc, const pg8::Unit& u, int wr, int wc, int fr_, int fq_) const {
        int fr = fr_, fq = fq_; asm volatile("" : "+v"(fr), "+v"(fq));
        const int n = u.pm / NTM, pm = u.pm - n * NTM, pn = u.pn & 3;
        const int row0 = pm * 256 + wr * 64 + fr, col0 = pn * 256 + wc * 32 + 8 * fq;
#pragma unroll
        for (int ai = 0; ai < 2; ++ai)
#pragma unroll
            for (int m = 0; m < 4; ++m) {
                const size_t row = (size_t)(row0 + ai * 128 + m * 16);
#pragma unroll
                for (int bj = 0; bj < 2; ++bj) {
                    const int col = col0 + bj * 128;
                    const u32x4 gw = *(const u32x4*)(G + row * ZLD + GOFF + n * 1024 + col);
                    float gv[8]; unpack8(gw, gv);
                    f32x4 v0 = acc[ai][bj][m][0], v1 = acc[ai][bj][m][1];
#pragma unroll
                    for (int e = 0; e < 4; ++e) { v0[e] *= gv[e]; v1[e] *= gv[4 + e]; }
                    float* pp = part + row * 1024 + col;
                    if (n > 0) { v0 += *(const f32x4*)pp; v1 += *(const f32x4*)(pp + 4); }
                    if (n < 3) { *(f32x4*)pp = v0; *(f32x4*)(pp + 4) = v1; }
                    else { u32x4 w; w.x = pk2(v0[0], v0[1]); w.y = pk2(v0[2], v0[3]); w.z = pk2(v1[0], v1[1]); w.w = pk2(v1[2], v1[3]); *(u32x4*)(mrg + row * 1024 + col) = w; }
                    asm volatile("" ::: "memory");
                }
            }
    }
};
struct EpiResid {
    static constexpr bool PERM = true, AFTER_DRAIN = false;
    const float* src; float* dst; int nrows; bf16_t* xb; float* ssacc;
    DI void operator()(const AccT& acc, const pg8::Unit& u, int wr, int wc, int fr_, int fq_) const {
        int fr = fr_, fq = fq_; asm volatile("" : "+v"(fr), "+v"(fq));
        const int row0 = u.pm * 256 + wr * 64 + fr, col0 = u.pn * 256 + wc * 32 + 8 * fq;
#pragma unroll
        for (int ai = 0; ai < 2; ++ai)
#pragma unroll
            for (int m = 0; m < 4; ++m) {
                const int row = row0 + ai * 128 + m * 16;
                if (row < nrows) {
                    float sq = 0.f;
#pragma unroll
                    for (int bj = 0; bj < 2; ++bj) {
                        const size_t off = (size_t)row * 1024 + col0 + bj * 128;
                        const f32x4 a0 = *(const f32x4*)(src + off) + acc[ai][bj][m][0], a1 = *(const f32x4*)(src + off + 4) + acc[ai][bj][m][1];
                        *(f32x4*)(dst + off) = a0; *(f32x4*)(dst + off + 4) = a1;
                        if (xb) { u32x4 w; w.x = pk2(a0[0], a0[1]); w.y = pk2(a0[2], a0[3]); w.z = pk2(a1[0], a1[1]); w.w = pk2(a1[2], a1[3]); *(u32x4*)(xb + off) = w;
                            sq += (a0[0] * a0[0] + a0[1] * a0[1]) + (a0[2] * a0[2] + a0[3] * a0[3]) + (a1[0] * a1[0] + a1[1] * a1[1]) + (a1[2] * a1[2] + a1[3] * a1[3]); }
                    }
                    if (xb) { sq += __shfl_xor(sq, 16); sq += __shfl_xor(sq, 32); if (fq == 0) unsafeAtomicAdd(ssacc + row, sq); }
                    asm volatile("" ::: "memory");
                }
            }
    }
};
struct EpiSwiglu {
    static constexpr bool PERM = true, AFTER_DRAIN = false;
    bf16_t* O; const float* ss;
    DI void operator()(const AccT& acc, const pg8::Unit& u, int wr, int wc, int fr_, int fq_) const {
        int fr = fr_, fq = fq_; asm volatile("" : "+v"(fr), "+v"(fq));
        const int row0 = u.pm * 256 + wr * 64 + fr, col0 = u.pn * 128 + wc * 32 + 8 * fq;
#pragma unroll
        for (int ai = 0; ai < 2; ++ai)
#pragma unroll
            for (int m = 0; m < 4; ++m) {
                float o[8]; const float rsr = 1.0f / sqrtf(ss[row0 + ai * 128 + m * 16] * (1.f / 1024.f) + EPS);
#pragma unroll
                for (int nn = 0; nn < 2; ++nn)
#pragma unroll
                    for (int e = 0; e < 4; ++e) { const float g = acc[ai][0][m][nn][e] * rsr, up = acc[ai][1][m][nn][e] * rsr; o[nn * 4 + e] = g * __builtin_amdgcn_rcpf(1.f + ex2(-LOG2E * g)) * up; }
                *(u32x4*)(O + (size_t)(row0 + ai * 128 + m * 16) * DFF + col0) = pack8(o);
                asm volatile("" ::: "memory");
            }
    }
};
DI void tr_item(const float* W, int N, bf16_t* WT, int ldk, int k0, int n0, int drow0, LAS float* scr, int lane, const float* gain = nullptr) {
#pragma unroll 8
    for (int i = 0; i < 32; ++i) { const int kk = 2 * i + (lane >> 5); float wv = W[(size_t)(k0 + kk) * N + n0 + (lane & 31)]; if (gain) wv *= gain[k0 + kk]; scr[kk * 33 + (lane & 31)] = wv; }
    const int c = lane & 7;
#pragma unroll
    for (int j = 0; j < 4; ++j) { const int n = (lane >> 3) + 8 * j; const LAS float* s = scr + (8 * c) * 33 + n;
        u32x4 o; o.x = pk2(s[0 * 33], s[1 * 33]); o.y = pk2(s[2 * 33], s[3 * 33]); o.z = pk2(s[4 * 33], s[5 * 33]); o.w = pk2(s[6 * 33], s[7 * 33]);
        *(u32x4*)(WT + (size_t)(drow0 + n) * ldk + k0 + 8 * c) = o; }
}
constexpr int IT_IN = 16 * 140, IT_G = 4 * 512, IT_B = 4 * 192, IT_O = 512, IT_FI = 16 * 176, IT_FO = 44 * 32, IT_L = IT_IN + IT_G + IT_B + IT_O + IT_FI + IT_FO;
DI void prologue_weights(const Params& p, LAS unsigned char* lds, int gw, int NGW, int wave, int lane) {
    LAS float* scr = (LAS float*)(lds + wave * 8448);
    for (int it = gw; it < 2 * IT_L; it += NGW) {
        const int l = it / IT_L; int r = it - l * IT_L;
        unsigned char* wl = p.ws + WS_W + (size_t)l * WL_B;
        bf16_t* W1t = (bf16_t*)wl; bf16_t* Wbt = (bf16_t*)(wl + W1_B); bf16_t* Wot = (bf16_t*)(wl + W1_B + WB_B); bf16_t* Wft = (bf16_t*)(wl + W1_B + WB_B + WO_B); bf16_t* Wdt = (bf16_t*)(wl + W1_B + WB_B + WO_B + WF_B);
        if (r < IT_IN) { const int kb = r / 140, nb = r % 140; const int n0 = 32 * nb, w = n0 & 255; tr_item(p.in[I_WIN] + (size_t)l * 1024 * 4480, 4480, W1t, 1024, 64 * kb, n0, (n0 & ~255) + 128 * ((w >> 5) & 1) + 32 * (w >> 6), scr, lane, p.in[I_LN1] + l * 1024); continue; } r -= IT_IN;
        if (r < IT_G) { const int n = r / 512, r2 = r % 512, kb = r2 / 32, nb = r2 % 32; tr_item(p.in[I_WG] + (size_t)(l * 4 + n) * 1024 * 1024, 1024, W1t, 1024, 64 * kb, 32 * nb, GOFF + n * 1024 + 32 * nb, scr, lane, p.in[I_LN1] + l * 1024); continue; } r -= IT_G;
        if (r < IT_B) { const int n = r / 192, r2 = r % 192, kb = r2 / 32, nb = r2 % 32; tr_item(p.in[I_WB] + (size_t)(l * 4 + n) * 384 * 1024, 1024, Wbt + (size_t)n * 1024 * 384, 384, 64 * kb, 32 * nb, 32 * nb, scr, lane); continue; } r -= IT_B;
        if (r < IT_O) { const int kb = r / 32, nb = r % 32; tr_item(p.in[I_WO] + (size_t)l * 1024 * 1024, 1024, Wot, 1024, 64 * kb, 32 * nb, 32 * nb, scr, lane); continue; } r -= IT_O;
        if (r < IT_FI) { const int kb = r / 176, nb = r % 176, n0 = 32 * nb; const int dr = n0 < DFF ? 256 * (n0 / 128) + (n0 % 128) : 256 * ((n0 - DFF) / 128) + 128 + ((n0 - DFF) % 128);
            tr_item(p.in[I_WFI] + (size_t)l * 1024 * 5632, 5632, Wft, 1024, 64 * kb, n0, dr, scr, lane, p.in[I_LN2] + l * 1024); continue; } r -= IT_FI;
        { const int kb = r / 32, nb = r % 32; tr_item(p.in[I_WFO] + (size_t)l * DFF * 1024, 1024, Wdt, DFF, 64 * kb, 32 * nb, 32 * nb, scr, lane); }
    }
}
__constant__ float INV_FREQ[8] = {1.0f, 0.1939227432012558f, 0.03760603070259094f, 0.007292664609849453f, 0.0014142135623842478f, 0.00027424818836152554f, 5.3182957344688475e-05f, 1.0313385246263351e-05f};
DI void prologue_misc(const Params& p, int gt, int NT) {
    for (int i = gt; i < 2 * 16384; i += NT) { const int l = i >> 14, j = i & 16383, rr = j >> 7, prow = 4352 + (rr < 64 ? 64 + rr : 128 + rr); *(u32x4*)(p.ws + WS_W + (size_t)l * WL_B + (size_t)prow * 2048 + (size_t)(j & 127) * 16) = (u32x4){0u, 0u, 0u, 0u}; }
    bf16_t* Wm = (bf16_t*)(p.ws + WS_WM);
    for (int i = gt; i < 2 * 6 * 128 * 64; i += NT) { const int e = 2 * i, jj = e & 127, ii = (e >> 7) & 127; const float a = p.in[I_WSD][e], b = p.in[I_WSD][e + 1];
        *(unsigned*)(Wm + e) = pk2(jj <= ii ? a : 0.f, jj + 1 <= ii ? b : 0.f); }
    float* rope = (float*)(p.ws + WS_ROPE);
    for (int i = gt; i < 2049 * 8; i += NT) { const int pos = (i >> 3) == 2048 ? 16384 : (i >> 3); double rev = (double)pos * (double)INV_FREQ[i & 7] * 0.15915494309189535; rev -= rint(rev);
        const float rf = (float)rev; rope[2 * i] = __builtin_amdgcn_cosf(rf); rope[2 * i + 1] = __builtin_amdgcn_sinf(rf); }
}
DI void xcast_phase(const float* xp, const float* xs, float* xcopy, bf16_t* XB, float* ss, int gw, int NGW, int lane) {
    for (int m = gw; m < MPAD; m += NGW) {
        u32x2* ho = (u32x2*)(XB + (size_t)m * 1024) + lane;
        if (lane == 0) { ss[(size_t)MPAD + m] = 0.f; ss[2ull * MPAD + m] = 0.f; ss[3ull * MPAD + m] = 0.f; }
        if (m >= MTOK) {
#pragma unroll
            for (int j = 0; j < 4; ++j) { ho[64 * j] = (u32x2){0u, 0u}; ((f32x4*)(xcopy + (size_t)m * 1024))[lane + 64 * j] = (f32x4){0.f, 0.f, 0.f, 0.f}; }
            if (lane == 0) ss[m] = 0.f;
            continue;
        }
        const float* src = m >= MP ? xs + (size_t)(m - MP) * 1024 : xp + (size_t)m * 1024;
        f32x4 v[4]; float sq = 0.f;
#pragma unroll
        for (int j = 0; j < 4; ++j) { v[j] = ((const f32x4*)src)[lane + 64 * j]; sq += (v[j].x * v[j].x + v[j].y * v[j].y) + (v[j].z * v[j].z + v[j].w * v[j].w); }
        sq = wave_sum(sq);
        if (lane == 0) ss[m] = sq;
#pragma unroll
        for (int j = 0; j < 4; ++j) { ho[64 * j] = (u32x2){pk2(v[j].x, v[j].y), pk2(v[j].z, v[j].w)}; ((f32x4*)(xcopy + (size_t)m * 1024))[lane + 64 * j] = v[j]; }
    }
}
DI void qk_phase(const Params& p, int l, int gw, int NGW, int lane) {
    bf16_t* ZG = (bf16_t*)(p.ws + WS_ZG); const float* rope = (const float*)(p.ws + WS_ROPE);
    const int sub = lane & 7, hh = lane >> 3;
    float gnv[4][8];
#pragma unroll
    for (int gi = 0; gi < 4; ++gi) {
        const float* gn = hh < 6 ? (gi == 0 ? p.in[I_QNA] + l * 64 : p.in[I_QNB] + (l * 3 + gi - 1) * 64) : (gi == 0 ? p.in[I_KNA] + l * 64 : p.in[I_KNB] + (l * 3 + gi - 1) * 64);
        const f32x4 g0 = *(const f32x4*)(gn + sub * 8), g1 = *(const f32x4*)(gn + sub * 8 + 4);
#pragma unroll
        for (int e = 0; e < 4; ++e) { gnv[gi][e] = g0[e]; gnv[gi][4 + e] = g1[e]; }
    }
    u32x4 nxt[4];
    if (gw < MTOK) {
#pragma unroll
        for (int gi = 0; gi < 4; ++gi) nxt[gi] = *(const u32x4*)(ZG + (size_t)gw * ZLD + gi * 640 + lane * 8);
    }
    for (int m = gw; m < MTOK; m += NGW) {
        const bool samp = m >= MP; const int b = samp ? m - MP : m >> 11, t = samp ? 0 : (m & 2047);
        const float* rp = rope + (samp ? 2048 : t) * 16;
        bf16_t* zrow = ZG + (size_t)m * ZLD;
        u32x4 cur[4];
#pragma unroll
        for (int gi = 0; gi < 4; ++gi) cur[gi] = nxt[gi];
        if (m + NGW < MTOK) {
#pragma unroll
            for (int gi = 0; gi < 4; ++gi) nxt[gi] = *(const u32x4*)(ZG + (size_t)(m + NGW) * ZLD + gi * 640 + lane * 8);
        }
        f32x4 rc0, rc1, rc2, rc3;
        if (sub < 2) { rc0 = *(const f32x4*)rp; rc1 = *(const f32x4*)(rp + 4); rc2 = *(const f32x4*)(rp + 8); rc3 = *(const f32x4*)(rp + 12); }
#pragma unroll
        for (int gi = 0; gi < 4; ++gi) {
            const int W = gi == 0 ? 128 : (gi == 1 ? 128 : (gi == 2 ? 512 : 2048));
            const size_t obase_p = gi == 0 ? O_AP : (gi == 1 ? O_B1P : (gi == 2 ? O_B2P : O_B3P)), obase_s = gi == 0 ? O_AS : (gi == 1 ? O_B1S : (gi == 2 ? O_B2S : O_B3S));
            float x[8]; unpack8(cur[gi], x);
            float ss = 0.f;
#pragma unroll
            for (int e = 0; e < 8; ++e) ss += x[e] * x[e];
            ss += __shfl_xor(ss, 1); ss += __shfl_xor(ss, 2); ss += __shfl_xor(ss, 4);
            const float rs = 1.0f / sqrtf(ss * (1.f / 64.f) + EPS);
#pragma unroll
            for (int e = 0; e < 8; ++e) x[e] = x[e] * rs * gnv[gi][e];
            float y[8];
#pragma unroll
            for (int e = 0; e < 8; ++e) y[e] = __shfl_xor(x[e], 1);
            if (sub < 2) {
                const float cs[16] = {rc0[0], rc0[1], rc0[2], rc0[3], rc1[0], rc1[1], rc1[2], rc1[3], rc2[0], rc2[1], rc2[2], rc2[3], rc3[0], rc3[1], rc3[2], rc3[3]};
#pragma unroll
                for (int e = 0; e < 8; ++e) { const float c = cs[2 * e], s = cs[2 * e + 1]; x[e] = sub == 0 ? x[e] * c - y[e] * s : x[e] * c + y[e] * s; }
            }
            *(u32x4*)(zrow + gi * 640 + lane * 8) = pack8(x);
            const int jrow = samp ? W - 1 : t - (2048 - W);
            const size_t cb = samp ? obase_s + ((size_t)(l * 128 + b) * 2) * W * 128 : obase_p + ((size_t)(l * 16 + b) * 2) * W * 128;
            if (jrow >= 0) {
                if (hh >= 6) { float* d = p.out + cb + (size_t)jrow * 128 + (hh - 6) * 64 + sub * 8; *(f32x4*)d = (f32x4){x[0], x[1], x[2], x[3]}; *(f32x4*)(d + 4) = (f32x4){x[4], x[5], x[6], x[7]}; }
                if (lane < 16) { float v[8]; unpack8(*(const u32x4*)(zrow + gi * 640 + 512 + lane * 8), v);
                    float* d = p.out + cb + (size_t)(W + jrow) * 128 + lane * 8; *(f32x4*)d = (f32x4){v[0], v[1], v[2], v[3]}; *(f32x4*)(d + 4) = (f32x4){v[4], v[5], v[6], v[7]}; }
            }
        }
        if (lane < 48 && (samp || t >= 2046)) {
            float gc[8], xc[8]; unpack8(*(const u32x4*)(zrow + 2944 + lane * 8), gc); unpack8(*(const u32x4*)(zrow + 3328 + lane * 8), xc);
            f32x4 z0 = (f32x4){gc[0] * xc[0], gc[1] * xc[1], gc[2] * xc[2], gc[3] * xc[3]}, z1 = (f32x4){gc[4] * xc[4], gc[5] * xc[5], gc[6] * xc[6], gc[7] * xc[7]};
            if (samp) {
                float* d = p.out + O_CS + ((size_t)(l * 128 + b) * 2) * BW + lane * 8; const float* s1 = p.in[I_SC] + ((size_t)(l * 128 + b) * 2 + 1) * BW + lane * 8;
                *(f32x4*)d = *(const f32x4*)s1; *(f32x4*)(d + 4) = *(const f32x4*)(s1 + 4); *(f32x4*)(d + BW) = z0; *(f32x4*)(d + BW + 4) = z1;
                float vd[8]; unpack8(*(const u32x4*)(zrow + 4096 + lane * 8), vd); float* dd = p.out + O_DS + (size_t)(l * 128 + b) * BW + lane * 8;
                *(f32x4*)dd = (f32x4){vd[0], vd[1], vd[2], vd[3]}; *(f32x4*)(dd + 4) = (f32x4){vd[4], vd[5], vd[6], vd[7]};
            } else { float* d = p.out + O_CP + ((size_t)(l * 16 + b) * 2 + (t - 2046)) * BW + lane * 8; *(f32x4*)d = z0; *(f32x4*)(d + 4) = z1; }
        }
    }
}
DI bf16x8 vt_frag(LAS unsigned char* img, int rowbase0, int tstep, int cc, int lane) {
    const int q = (lane & 15) >> 2, p4 = lane & 3, blk = (lane >> 4) & 1;
    const int colb = (32 * cc + 16 * blk + 4 * p4) * 2;
    const s16x4 lo = __builtin_amdgcn_ds_read_tr16_b64_v4i16((LAS s16x4*)(img + (rowbase0 + q) * 144 + colb));
    const s16x4 hi = __builtin_amdgcn_ds_read_tr16_b64_v4i16((LAS s16x4*)(img + (rowbase0 + tstep + q) * 144 + colb));
    return __builtin_shufflevector(lo, hi, 0, 1, 2, 3, 4, 5, 6, 7);
}
DI void attn_unit(LAS unsigned char* img, const bf16_t* ZG, int tok0, int dil, int qb, int gi, int kvh, bf16_t* Obuf, float* lse_out, const float* sink, int lane) {
    const int r = lane & 31, h = lane >> 5;
    const int colq = gi * 640 + kvh * 192, colk = gi * 640 + 384 + kvh * 64, colv = gi * 640 + 512 + kvh * 64;
    const int tq = tok0 + dil * (32 * qb + r);
    const bf16_t* qrow = ZG + (size_t)tq * ZLD + colq + 32 * h;
    f32x16 o[3][2]; float mrun[3], lrun[3];
#pragma unroll
    for (int g = 0; g < 3; ++g) { mrun[g] = -1e30f; lrun[g] = 0.f;
#pragma unroll
        for (int i = 0; i < 16; ++i) { o[g][0][i] = 0.f; o[g][1][i] = 0.f; } }
    const float SC = 0.125f * LOG2E;
    for (int c = 0; c < 5; ++c) {
        const int kb = 32 * (qb - 4 + c); if (kb < 0) continue;
        const int tk = tok0 + dil * (kb + r);
        const bf16_t* krow = ZG + (size_t)tk * ZLD + 32 * h;
        bf16x8 kf[4], vv[4], qf[3][4];
#pragma unroll
        for (int ks = 0; ks < 4; ++ks) { kf[ks] = *(const bf16x8*)(krow + colk + 8 * ks); vv[ks] = *(const bf16x8*)(krow + colv + 8 * ks); }
#pragma unroll
        for (int g = 0; g < 3; ++g)
#pragma unroll
            for (int ks = 0; ks < 4; ++ks) qf[g][ks] = *(const bf16x8*)(qrow + g * 64 + 8 * ks);
#pragma unroll
        for (int ks = 0; ks < 4; ++ks) *(LAS bf16x8*)(img + r * 144 + 64 * h + 16 * ks) = vv[ks];
        bf16x8 vf[2][2];
#pragma unroll
        for (int s = 0; s < 2; ++s)
#pragma unroll
            for (int cc = 0; cc < 2; ++cc) vf[s][cc] = vt_frag(img, 16 * s + 4 * h, 8, cc, lane);
#pragma unroll
        for (int g = 0; g < 3; ++g) {
            f32x16 s;
#pragma unroll
            for (int i = 0; i < 16; ++i) s[i] = 0.f;
#pragma unroll
            for (int ks = 0; ks < 4; ++ks) s = MFMA32(kf[ks], qf[g][ks], s);
            float t[16]; float mx = -1e30f;
#pragma unroll
            for (int i = 0; i < 16; ++i) { const int cr = crow(i, h); const bool valid = c == 0 ? (cr >= r) : (c == 4 ? (cr <= r) : true); t[i] = valid ? s[i] * SC : -1e30f; mx = fmaxf(mx, t[i]); }
            mx = fmaxf(mx, __shfl_xor(mx, 32));
            const float mnew = fmaxf(mrun[g], mx), alpha = ex2(mrun[g] - mnew);
            float rsum = 0.f;
#pragma unroll
            for (int i = 0; i < 16; ++i) { t[i] = ex2(t[i] - mnew); rsum += t[i]; }
            rsum += __shfl_xor(rsum, 32);
            lrun[g] = lrun[g] * alpha + rsum; mrun[g] = mnew;
#pragma unroll
            for (int i = 0; i < 16; ++i) { o[g][0][i] *= alpha; o[g][1][i] *= alpha; }
#pragma unroll
            for (int s2 = 0; s2 < 2; ++s2) {
                u32x4 pw; pw.x = pk2(t[8 * s2], t[8 * s2 + 1]); pw.y = pk2(t[8 * s2 + 2], t[8 * s2 + 3]); pw.z = pk2(t[8 * s2 + 4], t[8 * s2 + 5]); pw.w = pk2(t[8 * s2 + 6], t[8 * s2 + 7]);
                const bf16x8 pf = __builtin_bit_cast(bf16x8, pw);
                o[g][0] = MFMA32(vf[s2][0], pf, o[g][0]); o[g][1] = MFMA32(vf[s2][1], pf, o[g][1]);
            }
        }
    }
#pragma unroll
    for (int g = 0; g < 3; ++g) {
        const int head = kvh * 3 + g; float lsum = lrun[g];
        if (sink) lsum += ex2(sink[head] * LOG2E - mrun[g]);
        const float inv = 1.0f / lsum;
        bf16_t* orow = Obuf + (size_t)tq * BW + head * 64 + 4 * h;
#pragma unroll
        for (int cc = 0; cc < 2; ++cc)
#pragma unroll
            for (int q4 = 0; q4 < 4; ++q4) *(u32x2*)(orow + 32 * cc + 8 * q4) = (u32x2){pk2(o[g][cc][4 * q4] * inv, o[g][cc][4 * q4 + 1] * inv), pk2(o[g][cc][4 * q4 + 2] * inv, o[g][cc][4 * q4 + 3] * inv)};
        if (lse_out && h == 0) lse_out[(size_t)tq * 8 + head] = (mrun[g] + __builtin_amdgcn_logf(lsum)) * LN2;
    }
}
DI void sattn_unit(const bf16_t* ZG, const float* cache, int W, int dil, int b, int gi, int hq, bf16_t* Obuf, float* lse_out, const float* sink, int lane) {
    const int m = MP + b, kvh = hq / 3; const bf16_t* zrow = ZG + (size_t)m * ZLD + gi * 640;
    const bf16_t* qp = zrow + hq * 64;
    const float* Kc = cache + ((size_t)(b * 2 + 0) * W) * 128 + kvh * 64;
    const float* Vc = cache + ((size_t)(b * 2 + 1) * W) * 128 + kvh * 64;
    const float* k0 = Kc + (size_t)(W - (1 + lane) * dil) * 128; const float* k1 = Kc + (size_t)(W - (65 + lane) * dil) * 128;
    float s0 = 0.f, s1 = 0.f, s2 = 0.f;
#pragma unroll 2
    for (int d8 = 0; d8 < 8; ++d8) {
        float q[8], kn[8]; unpack8(*(const u32x4*)(qp + 8 * d8), q); unpack8(*(const u32x4*)(zrow + 384 + kvh * 64 + 8 * d8), kn);
        const f32x4 a0 = *(const f32x4*)(k0 + 8 * d8), a1 = *(const f32x4*)(k0 + 8 * d8 + 4), b0 = *(const f32x4*)(k1 + 8 * d8), b1 = *(const f32x4*)(k1 + 8 * d8 + 4);
#pragma unroll
        for (int e = 0; e < 4; ++e) { s0 += q[e] * a0[e] + q[4 + e] * a1[e]; s1 += q[e] * b0[e] + q[4 + e] * b1[e]; s2 += q[e] * kn[e] + q[4 + e] * kn[4 + e]; }
    }
    s0 *= 0.125f; s1 *= 0.125f; s2 *= 0.125f;
    const float mx = fmaxf(wave_max(fmaxf(s0, s1)), s2);
    const float p0 = __expf(s0 - mx), p1 = __expf(s1 - mx), p2 = __expf(s2 - mx);
    float lsum = wave_sum(p0 + p1) + p2;
    if (sink) lsum += __expf(sink[hq] - mx);
    float acc = p2 * bf1(zrow[512 + kvh * 64 + lane]);
    for (int n0 = 1; n0 <= 64; n0 += 8) {
        float va[8], vb[8];
#pragma unroll
        for (int j = 0; j < 8; ++j) { va[j] = Vc[(size_t)(W - (n0 + j) * dil) * 128 + lane]; vb[j] = Vc[(size_t)(W - (n0 + j + 64) * dil) * 128 + lane]; }
#pragma unroll
        for (int j = 0; j < 8; ++j) acc += __shfl(p0, n0 + j - 1) * va[j] + __shfl(p1, n0 + j - 1) * vb[j];
    }
    Obuf[(size_t)m * BW + hq * 64 + lane] = (bf16_t)(pk2(acc / lsum, 0.f) & 0xffffu);
    if (lse_out && lane == 0) lse_out[(size_t)m * 8 + hq] = mx + __logf(lsum);
}
DI void sg_unit(LAS unsigned char* img, const bf16_t* ZG, const bf16_t* Wm, const float* bs, int T0, int g, int ib, bf16_t* Od, int lane) {
    const int r = lane & 31, h = lane >> 5;
    f32x16 acc[2];
#pragma unroll
    for (int i = 0; i < 16; ++i) { acc[0][i] = 0.f; acc[1][i] = 0.f; }
    const bf16_t* wrow = Wm + ((size_t)g * 128 + 32 * ib + r) * 128 + 8 * h;
    for (int jc = 0; jc <= ib; ++jc) {
        const bf16_t* vrow = ZG + (size_t)(T0 + 32 * jc + r) * ZLD + 4096 + g * 64 + 32 * h;
#pragma unroll
        for (int ks = 0; ks < 4; ++ks) { const bf16x8 vv = *(const bf16x8*)(vrow + 8 * ks); *(LAS bf16x8*)(img + r * 144 + 64 * h + 16 * ks) = vv; }
#pragma unroll
        for (int s = 0; s < 2; ++s) {
            const bf16x8 wf = *(const bf16x8*)(wrow + 32 * jc + 16 * s);
            acc[0] = MFMA32(vt_frag(img, 16 * s + 8 * h, 4, 0, lane), wf, acc[0]);
            acc[1] = MFMA32(vt_frag(img, 16 * s + 8 * h, 4, 1, lane), wf, acc[1]);
        }
    }
    const int tok = T0 + 32 * ib + r; const float bias = bs[g * 128 + 32 * ib + r];
    const bf16_t* urow = ZG + (size_t)tok * ZLD + 3712 + g * 64 + 4 * h; bf16_t* orow = Od + (size_t)tok * BW + g * 64 + 4 * h;
#pragma unroll
    for (int cc = 0; cc < 2; ++cc)
#pragma unroll
        for (int q4 = 0; q4 < 4; ++q4) { const u32x2 uw = *(const u32x2*)(urow + 32 * cc + 8 * q4);
            *(u32x2*)(orow + 32 * cc + 8 * q4) = (u32x2){pk2(bflo(uw.x) * (acc[cc][4 * q4] + bias), bfhi(uw.x) * (acc[cc][4 * q4 + 1] + bias)), pk2(bflo(uw.y) * (acc[cc][4 * q4 + 2] + bias), bfhi(uw.y) * (acc[cc][4 * q4 + 3] + bias))}; }
}

#ifndef NAIVE_ATTN
#define NAIVE_ATTN 0
#endif
#ifndef NAIVE_SG
#define NAIVE_SG 0
#endif
DI void naive_attn_phase(const Params& p, int l, int gt, int NT) {
    const bf16_t* ZG = (const bf16_t*)(p.ws + WS_ZG); bf16_t* BR = (bf16_t*)(p.ws + WS_BR); bf16_t* OB = (bf16_t*)(p.ws + WS_OB); float* LSE = (float*)(p.ws + WS_LSE);
    const int sub = gt & 3;
    for (int it = gt >> 2; it < MP * 24; it += NT >> 2) {
        const int m = it / 24, rem = it % 24, hq = rem % 6, gi = rem / 6, t = m & 2047, dil = gi < 2 ? 1 : (gi == 2 ? 4 : 16), kvh = hq / 3;
        float q[16], acc[16];
        { float a[8], b[8]; const bf16_t* qp = ZG + (size_t)m * ZLD + gi * 640 + hq * 64 + sub * 16; unpack8(*(const u32x4*)qp, a); unpack8(*(const u32x4*)(qp + 8), b);
#pragma unroll
          for (int e = 0; e < 8; ++e) { q[e] = a[e]; q[8 + e] = b[e]; acc[e] = 0.f; acc[8 + e] = 0.f; } }
        float mx = -1e30f, ls = 0.f;
        for (int n = 0; n <= 128; ++n) {
            if (t - n * dil < 0) break;
            const bf16_t* kp = ZG + (size_t)(m - n * dil) * ZLD + gi * 640 + 384 + kvh * 64 + sub * 16;
            float a[8], b[8]; unpack8(*(const u32x4*)kp, a); unpack8(*(const u32x4*)(kp + 8), b);
            float d = 0.f;
#pragma unroll
            for (int e = 0; e < 8; ++e) d += q[e] * a[e] + q[8 + e] * b[e];
            d += __shfl_xor(d, 1); d += __shfl_xor(d, 2); d *= 0.125f;
            const float mn = fmaxf(mx, d), al = __expf(mx - mn), pe = __expf(d - mn);
            unpack8(*(const u32x4*)(kp + 128), a); unpack8(*(const u32x4*)(kp + 136), b);
#pragma unroll
            for (int e = 0; e < 8; ++e) { acc[e] = acc[e] * al + pe * a[e]; acc[8 + e] = acc[8 + e] * al + pe * b[e]; }
            ls = ls * al + pe; mx = mn;
        }
        if (gi == 0) ls += __expf(p.in[I_SINK][l * 6 + hq] - mx);
        const float inv = 1.0f / ls; float o[8], o2[8];
#pragma unroll
        for (int e = 0; e < 8; ++e) { o[e] = acc[e] * inv; o2[e] = acc[8 + e] * inv; }
        bf16_t* op = (gi == 0 ? BR : OB + (size_t)(gi - 1) * MPAD * BW) + (size_t)m * BW + hq * 64 + sub * 16;
        *(u32x4*)op = pack8(o); *(u32x4*)(op + 8) = pack8(o2);
        if (gi > 0 && sub == 0) LSE[(size_t)(gi - 1) * MPAD * 8 + (size_t)m * 8 + hq] = mx + __logf(ls);
    }
}
DI void naive_sg_phase(const Params& p, int l, int gt, int NT) {
    const bf16_t* ZG = (const bf16_t*)(p.ws + WS_ZG); bf16_t* BR = (bf16_t*)(p.ws + WS_BR);
    for (int it = gt; it < MP * 48; it += NT) {
        const int m = it / 48, c0 = (it % 48) * 8, g = c0 >> 6, i = m & 127, T0 = m - i;
        float sv[8];
#pragma unroll
        for (int e = 0; e < 8; ++e) sv[e] = 0.f;
        const float* wr = p.in[I_WSD] + ((size_t)(l * 6 + g) * 128 + i) * 128;
        for (int j = 0; j <= i; ++j) { float v[8]; unpack8(*(const u32x4*)(ZG + (size_t)(T0 + j) * ZLD + 4096 + c0), v); const float w = wr[j];
#pragma unroll
            for (int e = 0; e < 8; ++e) sv[e] += w * v[e]; }
        float u[8], o[8]; unpack8(*(const u32x4*)(ZG + (size_t)m * ZLD + 3712 + c0), u); const float bias = p.in[I_BSD][l * 768 + g * 128 + i];
#pragma unroll
        for (int e = 0; e < 8; ++e) o[e] = u[e] * (sv[e] + bias);
        *(u32x4*)(BR + 3ull * MPAD * BW + (size_t)m * BW + c0) = pack8(o);
    }
}
constexpr int CP_A = 256 * 32 * 127, CP_B2 = 256 * 32 * 511, CP_B3 = 256 * 32 * 2047, CP_T0 = CP_A, CP_T1 = 2 * CP_A, CP_T2 = CP_T1 + CP_B2, CP_T3 = CP_T2 + CP_B3, CP_NCH = CP_T3 / 64;
static_assert(CP_T3 % 64 == 0, "copy chunks");
DI void cp_decode(const Params& p, int l, int i, const float*& src, float*& dst) {
    if (i < CP_T0) { const int seg = i / (32 * 127), off = i % (32 * 127); const size_t base = ((size_t)l * 256 + seg) * 128 * 128; src = p.in[I_CA] + base + 128 + (size_t)off * 4; dst = p.out + O_AS + base + (size_t)off * 4; }
    else if (i < CP_T1) { i -= CP_T0; const int seg = i / (32 * 127), off = i % (32 * 127); const size_t base = ((size_t)l * 256 + seg) * 128 * 128; src = p.in[I_CB1] + base + 128 + (size_t)off * 4; dst = p.out + O_B1S + base + (size_t)off * 4; }
    else if (i < CP_T2) { i -= CP_T1; const int seg = i / (32 * 511), off = i % (32 * 511); const size_t base = ((size_t)l * 256 + seg) * 512 * 128; src = p.in[I_CB2] + base + 128 + (size_t)off * 4; dst = p.out + O_B2S + base + (size_t)off * 4; }
    else { i -= CP_T2; const int seg = i / (32 * 2047), off = i % (32 * 2047); const size_t base = ((size_t)l * 256 + seg) * 2048 * 128; src = p.in[I_CB3] + base + 128 + (size_t)off * 4; dst = p.out + O_B3S + base + (size_t)off * 4; }
}
constexpr int CP_NSL = 4;
DI void copy_slice(const Params& p, int l, int s, int gw, int NGW, int lane) {
    for (int c0 = s * NGW + gw; c0 < CP_NCH; c0 += 8 * CP_NSL * NGW) {
        f32x4 v[8]; float* dst[8]; bool ok[8];
#pragma unroll
        for (int q = 0; q < 8; ++q) { const int cid = c0 + q * CP_NSL * NGW; ok[q] = cid < CP_NCH; dst[q] = nullptr; v[q] = (f32x4){0.f, 0.f, 0.f, 0.f};
            if (ok[q]) { const float* src; cp_decode(p, l, cid * 64 + lane, src, dst[q]); v[q] = __builtin_nontemporal_load((const f32x4*)src); } }
#pragma unroll
        for (int q = 0; q < 8; ++q) if (ok[q]) __builtin_nontemporal_store(v[q], (f32x4*)dst[q]);
    }
}
DI void mixer_phase(const Params& p, LAS unsigned char* lds, int l, int gw, int NGW, int wave, int lane, int gt, int NT) {
    const bf16_t* ZG = (const bf16_t*)(p.ws + WS_ZG);
    bf16_t* BR = (bf16_t*)(p.ws + WS_BR); bf16_t* OB = (bf16_t*)(p.ws + WS_OB); float* LSE = (float*)(p.ws + WS_LSE);
    LAS unsigned char* img = lds + wave * 4608;
    int k = 0;
#if NAIVE_ATTN
    naive_attn_phase(p, l, gt, NT);
    for (int u = gw; u < 0; u += NGW) {
#else
    for (int u = gw; u < 8192; u += NGW) {
#endif
        const int gi = u >> 11, rem = u & 2047; const int ld = gi < 2 ? 0 : (gi == 2 ? 2 : 4), dil = 1 << ld, lnqb = 6 - ld;
        const int qb = rem & ((1 << lnqb) - 1), rem2 = rem >> lnqb, res = rem2 & (dil - 1), rem3 = rem2 >> ld, kvh = rem3 & 1, b = rem3 >> 1;
        attn_unit(img, ZG, b * 2048 + res, dil, qb, gi, kvh, gi == 0 ? BR : OB + (size_t)(gi - 1) * MPAD * BW, gi == 0 ? nullptr : LSE + (size_t)(gi - 1) * MPAD * 8, gi == 0 ? p.in[I_SINK] + l * 6 : nullptr, lane);
        if (k < CP_NSL) copy_slice(p, l, k++, gw, NGW, lane);
    }
    for (; k < CP_NSL; ++k) copy_slice(p, l, k, gw, NGW, lane);
    const bf16_t* Wm = (const bf16_t*)(p.ws + WS_WM) + (size_t)l * 6 * 128 * 128;
#if NAIVE_SG
    naive_sg_phase(p, l, gt, NT);
#else
    for (int u = gw; u < 6144; u += NGW) { const int ib = u & 3, g = (u >> 2) % 6, ch = u / 24; sg_unit(img, ZG, Wm, p.in[I_BSD] + l * 768, ch * 128, g, ib, BR + 3ull * MPAD * BW, lane); }
#endif
    for (int u = gw; u < 3072; u += NGW) {
        const int hq = u % 6, gi = (u / 6) & 3, b = u / 24; const int W = gi < 2 ? 128 : (gi == 2 ? 512 : 2048), dil = gi < 2 ? 1 : (gi == 2 ? 4 : 16);
        const float* cache = (gi == 0 ? p.in[I_CA] : (gi == 1 ? p.in[I_CB1] : (gi == 2 ? p.in[I_CB2] : p.in[I_CB3]))) + (size_t)l * 256 * W * 128;
        sattn_unit(ZG, cache, W, dil, b, gi, hq, gi == 0 ? BR : OB + (size_t)(gi - 1) * MPAD * BW, gi == 0 ? nullptr : LSE + (size_t)(gi - 1) * MPAD * 8, gi == 0 ? p.in[I_SINK] + l * 6 : nullptr, lane);
    }
    const float* cw = p.in[I_CONV] + l * 3 * BW;
    for (int it = gt; it < MTOK * 48; it += NT) {
        const int m = it / 48, c0 = (it % 48) * 8; const bool samp = m >= MP; const int t = m & 2047;
        const bf16_t* zrow = ZG + (size_t)m * ZLD;
        float gb[8], gc[8], xc[8], z1[8], z2[8];
        unpack8(*(const u32x4*)(zrow + 2560 + c0), gb); unpack8(*(const u32x4*)(zrow + 2944 + c0), gc); unpack8(*(const u32x4*)(zrow + 3328 + c0), xc);
        if (samp) { const float* s = p.in[I_SC] + ((size_t)(l * 128 + (m - MP)) * 2) * BW + c0;
#pragma unroll
            for (int e = 0; e < 8; ++e) { z2[e] = s[e]; z1[e] = s[BW + e]; } }
        else {
            float a[8], bb[8];
            if (t >= 1) { unpack8(*(const u32x4*)(zrow - ZLD + 2944 + c0), a); unpack8(*(const u32x4*)(zrow - ZLD + 3328 + c0), bb);
#pragma unroll
                for (int e = 0; e < 8; ++e) z1[e] = a[e] * bb[e]; }
            else {
#pragma unroll
                for (int e = 0; e < 8; ++e) z1[e] = 0.f; }
            if (t >= 2) { unpack8(*(const u32x4*)(zrow - 2 * ZLD + 2944 + c0), a); unpack8(*(const u32x4*)(zrow - 2 * ZLD + 3328 + c0), bb);
#pragma unroll
                for (int e = 0; e < 8; ++e) z2[e] = a[e] * bb[e]; }
            else {
#pragma unroll
                for (int e = 0; e < 8; ++e) z2[e] = 0.f; }
        }
        float oc[8];
#pragma unroll
        for (int e = 0; e < 8; ++e) oc[e] = gb[e] * (cw[c0 + e] * z2[e] + cw[BW + c0 + e] * z1[e] + cw[2 * BW + c0 + e] * (gc[e] * xc[e]));
        *(u32x4*)(BR + 2ull * MPAD * BW + (size_t)m * BW + c0) = pack8(oc);
        if (samp || t >= 2046) {
            const f32x4 z0 = (f32x4){gc[0] * xc[0], gc[1] * xc[1], gc[2] * xc[2], gc[3] * xc[3]}, z1v = (f32x4){gc[4] * xc[4], gc[5] * xc[5], gc[6] * xc[6], gc[7] * xc[7]};
            if (samp) { const int b = m - MP; float* d = p.out + O_CS + ((size_t)(l * 128 + b) * 2) * BW + c0;
                *(f32x4*)d = (f32x4){z1[0], z1[1], z1[2], z1[3]}; *(f32x4*)(d + 4) = (f32x4){z1[4], z1[5], z1[6], z1[7]}; *(f32x4*)(d + BW) = z0; *(f32x4*)(d + BW + 4) = z1v;
            } else { float* d = p.out + O_CP + ((size_t)(l * 16 + (m >> 11)) * 2 + (t - 2046)) * BW + c0; *(f32x4*)d = z0; *(f32x4*)(d + 4) = z1v; }
        }
        if (samp) { float uu[8], vv[8], od[8]; unpack8(*(const u32x4*)(zrow + 3712 + c0), uu); unpack8(*(const u32x4*)(zrow + 4096 + c0), vv);
            const int g = c0 >> 6; const float w00 = p.in[I_WSD][((size_t)l * 6 + g) * 16384], b0 = p.in[I_BSD][l * 768 + g * 128];
#pragma unroll
            for (int e = 0; e < 8; ++e) od[e] = uu[e] * (w00 * vv[e] + b0);
            *(u32x4*)(BR + 3ull * MPAD * BW + (size_t)m * BW + c0) = pack8(od);
            float* dd = p.out + O_DS + (size_t)(l * 128 + (m - MP)) * BW + c0; *(f32x4*)dd = (f32x4){vv[0], vv[1], vv[2], vv[3]}; *(f32x4*)(dd + 4) = (f32x4){vv[4], vv[5], vv[6], vv[7]}; }
    }
}
DI void merge_phase(const Params& p, int gt, int NT) {
    bf16_t* BR = (bf16_t*)(p.ws + WS_BR); const bf16_t* OB = (const bf16_t*)(p.ws + WS_OB); const float* LSE = (const float*)(p.ws + WS_LSE);
    for (int it = gt; it < MTOK * 48; it += NT) {
        const int m = it / 48, cch = it % 48, head = cch >> 3;
        const float l0 = LSE[(size_t)m * 8 + head], l1 = LSE[(size_t)MPAD * 8 + (size_t)m * 8 + head], l2 = LSE[2ull * MPAD * 8 + (size_t)m * 8 + head];
        const float mx = fmaxf(l0, fmaxf(l1, l2)); float w0 = __expf(l0 - mx), w1 = __expf(l1 - mx), w2 = __expf(l2 - mx); const float inv = 1.0f / (w0 + w1 + w2); w0 *= inv; w1 *= inv; w2 *= inv;
        float a[8], b[8], c[8], o[8];
        unpack8(*(const u32x4*)(OB + (size_t)m * BW + cch * 8), a); unpack8(*(const u32x4*)(OB + (size_t)MPAD * BW + (size_t)m * BW + cch * 8), b); unpack8(*(const u32x4*)(OB + 2ull * MPAD * BW + (size_t)m * BW + cch * 8), c);
#pragma unroll
        for (int e = 0; e < 8; ++e) o[e] = w0 * a[e] + w1 * b[e] + w2 * c[e];
        *(u32x4*)(BR + (size_t)MPAD * BW + (size_t)m * BW + cch * 8) = pack8(o);
    }
}
constexpr int NPH = 20;
DI void grid_barrier(unsigned* bar, unsigned target, int wave_s) {
    __syncthreads();
    if (wave_s == 0) {
        if (__builtin_amdgcn_mbcnt_hi(~0u, __builtin_amdgcn_mbcnt_lo(~0u, 0u)) == 0u) {
            __builtin_amdgcn_fence(__ATOMIC_RELEASE, "agent");
            __hip_atomic_fetch_add(bar, 1u, __ATOMIC_RELAXED, __HIP_MEMORY_SCOPE_AGENT);
            while (__hip_atomic_load(bar, __ATOMIC_RELAXED, __HIP_MEMORY_SCOPE_AGENT) < target) __builtin_amdgcn_s_sleep(1);
        }
        __builtin_amdgcn_fence(__ATOMIC_ACQUIRE, "agent");
    }
    __syncthreads();
}
#ifndef DEBUG_CHK
#define DEBUG_CHK 0
#endif
#if DEBUG_CHK
DI const float* xin_row(const Params& p, int m) { return m < MP ? p.in[I_XP] + (size_t)m * 1024 : p.in[I_XS] + (size_t)(m - MP) * 1024; }
DI void dbg_phase(const Params& p, int kind_in, int gw, int NGW, int lane, int gt, int NT) {
    const int L = (kind_in >= 10 && kind_in < 20) ? 1 : 0, kind = kind_in == 99 ? 99 : kind_in - 10 * L;
    float* dbg = (float*)(p.ws + WS_BAR + 128);
    const bf16_t* ZG = (const bf16_t*)(p.ws + WS_ZG); const bf16_t* BR = (const bf16_t*)(p.ws + WS_BR); const bf16_t* MRG = (const bf16_t*)(p.ws + WS_MRG);
    const bf16_t* H = (const bf16_t*)(p.ws + WS_H); const bf16_t* ACT = (const bf16_t*)(p.ws + WS_ACT); const float* X = (const float*)(p.ws + WS_X);
    if (kind == 99) {
        int code = 0;
        for (int k = 1; k <= 7; ++k) if (code == 0 && dbg[k] > 1e-3f * dbg[8 + k]) code = k;
        if (code) { const float a = 1.0f + 0.1f * sqrtf((float)code); for (int i = gt; i < 98304; i += NT) p.out[O_DS + i] *= a; }
        return;
    }
    for (int s = gw; s < 16384; s += NGW) {
        const int m = MP + (int)(((unsigned)s * 2654435761u) % 128u), ci = s & 7; const unsigned hsh = (unsigned)s * 40503u + 12345u; float fast = 0.f, naive = 0.f;
        const float* xr = L ? X + (size_t)m * 1024 : xin_row(p, m);
        if (kind == 1) {
            int c = (int)(hsh % 8576u); if (c >= 4480) c += 128;
            float ss = 0.f; for (int k = lane; k < 1024; k += 64) ss += xr[k] * xr[k];
            const float rs = 1.0f / sqrtf(wave_sum(ss) * (1.f / 1024.f) + EPS); float acc = 0.f;
            for (int k = lane; k < 1024; k += 64) { const float hv = xr[k] * rs * p.in[I_LN1][L * 1024 + k];
                acc += hv * (c < GOFF ? p.in[I_WIN][(size_t)L * 1024 * 4480 + (size_t)k * 4480 + c] : p.in[I_WG][(size_t)L * 4 * 1048576 + ((size_t)((c - GOFF) >> 10) * 1024 + k) * 1024 + ((c - GOFF) & 1023)]); }
            acc = wave_sum(acc); naive = c < GOFF ? acc : 1.0f / (1.0f + __expf(-(acc + p.in[I_BG][L * 4096 + c - GOFF])));
            fast = bf1(ZG[(size_t)m * ZLD + c]);
        } else if (kind == 2 || kind == 3 || kind == 6) {
            const int c = (int)(hsh & 1023u);
            float v = 0.f;
            if (kind == 2) {
                for (int n = 0; n < 4; ++n) { float acc = 0.f; for (int k = lane; k < 384; k += 64) acc += bf1(BR[((size_t)n * MPAD + m) * BW + k]) * p.in[I_WB][(size_t)L * 4 * 384 * 1024 + ((size_t)n * 384 + k) * 1024 + c];
                    v += bf1(ZG[(size_t)m * ZLD + GOFF + n * 1024 + c]) * wave_sum(acc); }
                naive = v; fast = bf1(MRG[(size_t)m * 1024 + c]);
            } else {
                float acc = 0.f; for (int k = lane; k < 1024; k += 64) acc += bf1(MRG[(size_t)m * 1024 + k]) * p.in[I_WO][(size_t)k * 1024 + c];
                v = xr[c] + wave_sum(acc);
                if (kind == 6) { float a2 = 0.f; for (int k = lane; k < DFF; k += 64) a2 += bf1(ACT[(size_t)m * DFF + k]) * p.in[I_WFO][(size_t)k * 1024 + c]; v += wave_sum(a2); }
                naive = v; fast = X[(size_t)m * 1024 + c];
            }
        } else if (kind == 7) {
            const int hs = (int)(hsh & 31u), gi = hs >> 3, hh = hs & 7, col0 = gi * 640 + hh * 64;
            float ss = 0.f; for (int k = lane; k < 1024; k += 64) ss += xr[k] * xr[k];
            const float rs = 1.0f / sqrtf(wave_sum(ss) * (1.f / 1024.f) + EPS); float z = 0.f;
            for (int k = 0; k < 1024; ++k) z += xr[k] * rs * p.in[I_LN1][k] * p.in[I_WIN][(size_t)k * 4480 + col0 + lane];
            const float r2 = 1.0f / sqrtf(wave_sum(z * z) * (1.f / 64.f) + EPS);
            const float* gn = hh < 6 ? (gi == 0 ? p.in[I_QNA] : p.in[I_QNB] + (gi - 1) * 64) : (gi == 0 ? p.in[I_KNA] : p.in[I_KNB] + (gi - 1) * 64);
            float y = z * r2 * gn[lane];
            const float pos = m >= MP ? 16384.f : (float)(m & 2047); const float ang = pos * INV_FREQ[lane & 7];
            const float other = __shfl_xor(y, 8);
            if (lane < 8) y = y * cosf(ang) - other * sinf(ang); else if (lane < 16) y = y * cosf(ang) + other * sinf(ang);
            naive = y; fast = bf1(ZG[(size_t)m * ZLD + col0 + lane]);
            atomicAdd(&dbg[kind], (fast - naive) * (fast - naive)); atomicAdd(&dbg[8 + kind], naive * naive); continue;
        } else if (kind == 7 + 100) {
        } else if (kind == 9) {
            const int b = m - MP, hq = (int)(hsh % 6u), gi = (int)((hsh >> 8) & 3u), kvh = hq / 3, W = gi < 2 ? 128 : (gi == 2 ? 512 : 2048), dil = gi < 2 ? 1 : (gi == 2 ? 4 : 16);
            const float* cache = (gi == 0 ? p.in[I_CA] : (gi == 1 ? p.in[I_CB1] : (gi == 2 ? p.in[I_CB2] : p.in[I_CB3])));
            const float* Kc = cache + ((size_t)(b * 2 + 0) * W) * 128 + kvh * 64; const float* Vc = cache + ((size_t)(b * 2 + 1) * W) * 128 + kvh * 64;
            const bf16_t* zr = ZG + (size_t)m * ZLD + gi * 640; const bf16_t* qp = zr + hq * 64;
            float sc[3], pv[3]; float mx = -1e30f;
            for (int j = 0; j < 3; ++j) { const int n = j < 2 ? 1 + lane + 64 * j : 0; const bool ok = j < 2 || lane == 0; float dsum = 0.f;
                if (ok) { for (int e = 0; e < 64; ++e) dsum += bf1(qp[e]) * (n == 0 ? bf1(zr[384 + kvh * 64 + e]) : Kc[(size_t)(W - n * dil) * 128 + e]); }
                sc[j] = ok ? dsum * 0.125f : -1e30f; mx = fmaxf(mx, sc[j]); }
            mx = wave_max(mx); float ls = 0.f;
            for (int j = 0; j < 3; ++j) { pv[j] = sc[j] > -1e29f ? __expf(sc[j] - mx) : 0.f; ls += pv[j]; }
            ls = wave_sum(ls); if (gi == 0) ls += __expf(p.in[I_SINK][hq] - mx);
            const bf16_t* fo = (gi == 0 ? BR : (const bf16_t*)(p.ws + WS_OB) + (size_t)(gi - 1) * MPAD * BW) + (size_t)m * BW + hq * 64;
            for (int dd = 0; dd < 8; ++dd) { float a = 0.f;
                for (int j = 0; j < 3; ++j) { const int n = j < 2 ? 1 + lane + 64 * j : 0; if (pv[j] > 0.f) a += pv[j] * (n == 0 ? bf1(zr[512 + kvh * 64 + dd]) : Vc[(size_t)(W - n * dil) * 128 + dd]); }
                a = wave_sum(a) / ls; const float f = bf1(fo[dd]);
                if (lane == 0) { atomicAdd(&dbg[7], (f - a) * (f - a)); atomicAdd(&dbg[15], a * a); } }
            continue;
        } else if (kind == 8) {
            const int mm = (int)(((unsigned)s * 2654435761u) % (unsigned)MP), hq = (int)(hsh % 6u), gi = (int)((hsh >> 8) & 3u), t = mm & 2047, dil = gi < 2 ? 1 : (gi == 2 ? 4 : 16), kvh = hq / 3;
            const bf16_t* qp = ZG + (size_t)mm * ZLD + gi * 640 + hq * 64;
            float sc[3], pv[3]; float mx = -1e30f;
            for (int j = 0; j < 3; ++j) { const int n = j < 2 ? lane + 64 * j : 128; const bool ok = (j < 2 || lane == 0) && (t - n * dil >= 0); float dsum = 0.f;
                if (ok) { const bf16_t* kp = ZG + (size_t)(mm - n * dil) * ZLD + gi * 640 + 384 + kvh * 64; for (int e = 0; e < 64; ++e) dsum += bf1(qp[e]) * bf1(kp[e]); }
                sc[j] = ok ? dsum * 0.125f : -1e30f; mx = fmaxf(mx, sc[j]); }
            mx = wave_max(mx); float ls = 0.f;
            for (int j = 0; j < 3; ++j) { pv[j] = sc[j] > -1e29f ? __expf(sc[j] - mx) : 0.f; ls += pv[j]; }
            ls = wave_sum(ls); if (gi == 0) ls += __expf(p.in[I_SINK][hq] - mx);
            const bf16_t* fo = (gi == 0 ? BR : (const bf16_t*)(p.ws + WS_OB) + (size_t)(gi - 1) * MPAD * BW) + (size_t)mm * BW + hq * 64;
            for (int dd = 0; dd < 8; ++dd) { float a = 0.f;
                for (int j = 0; j < 3; ++j) { const int n = j < 2 ? lane + 64 * j : 128; if (pv[j] > 0.f) a += pv[j] * bf1(ZG[(size_t)(mm - n * dil) * ZLD + gi * 640 + 512 + kvh * 64 + dd]); }
                a = wave_sum(a) / ls; const float f = bf1(fo[dd]);
                if (lane == 0) { atomicAdd(&dbg[gi], (f - a) * (f - a)); atomicAdd(&dbg[8 + gi], a * a); } }
            if (gi > 0 && lane == 0) { const float lf = ((const float*)(p.ws + WS_LSE))[(size_t)(gi - 1) * MPAD * 8 + (size_t)mm * 8 + hq], ln = mx + __logf(ls); atomicAdd(&dbg[4], (lf - ln) * (lf - ln)); atomicAdd(&dbg[12], 1.0f); }
            continue;
        } else if (kind == 4) {
            const int c = (int)(hsh & 1023u); const float* xx = X + (size_t)m * 1024;
            float ss = 0.f; for (int k = lane; k < 1024; k += 64) ss += xx[k] * xx[k];
            const float rs = 1.0f / sqrtf(wave_sum(ss) * (1.f / 1024.f) + EPS); naive = xx[c] * rs * p.in[I_LN2][L * 1024 + c]; fast = bf1(H[(size_t)m * 1024 + c]);
        } else if (kind == 5) {
            const int c = (int)(hsh % 2816u);
            float a1 = 0.f, a2 = 0.f; for (int k = lane; k < 1024; k += 64) { const float hv = bf1(H[(size_t)m * 1024 + k]); a1 += hv * p.in[I_WFI][(size_t)L * 1024 * 5632 + (size_t)k * 5632 + c]; a2 += hv * p.in[I_WFI][(size_t)L * 1024 * 5632 + (size_t)k * 5632 + DFF + c]; }
            a1 = wave_sum(a1); a2 = wave_sum(a2); naive = a1 / (1.0f + __expf(-a1)) * a2; fast = bf1(ACT[(size_t)m * DFF + c]);
        }
        if (lane == 0) { atomicAdd(&dbg[kind], (fast - naive) * (fast - naive)); atomicAdd(&dbg[8 + kind], naive * naive); }
    }
}
#endif
template <int PH> DI void run_phase(const Params& p0, LAS unsigned char* lds, int wave_s) {
    Params p;
    { int z_ = 0; asm volatile("" : "+s"(z_));
#pragma unroll
      for (int i = 0; i < 24; ++i) p.in[i] = p0.in[i + z_];
      p.out = (&p0.out)[z_]; p.ws = (&p0.ws)[z_]; p.ph_lo = 0; p.ph_hi = 0; }
    int tid = wave_s * 64 + (int)__builtin_amdgcn_mbcnt_hi(~0u, __builtin_amdgcn_mbcnt_lo(~0u, 0u)); asm volatile("" : "+v"(tid));
    const int G = gridDim.x, bid = blockIdx.x, NGW = G * 8, NT = G * 512;
    const int lane = tid & 63, wave = wave_s, gw = bid * 8 + wave, gt = bid * 512 + tid;
    float* X = (float*)(p.ws + WS_X); bf16_t* H = (bf16_t*)(p.ws + WS_H); bf16_t* ZG = (bf16_t*)(p.ws + WS_ZG); float* SS = (float*)(p.ws + WS_SS);
    if constexpr (PH == 0) {
        prologue_weights(p, lds, gw, NGW, wave, lane);
        prologue_misc(p, gt, NT);
        xcast_phase(p.in[I_XP], p.in[I_XS], X, H, SS, gw, NGW, lane);
    } else {
        constexpr int l = (PH - 1) / 10, k = (PH - 1) % 10;
        unsigned char* wl = p.ws + WS_W + (size_t)l * WL_B;
        const bf16_t* W1t = (const bf16_t*)wl; const bf16_t* Wbt = (const bf16_t*)(wl + W1_B); const bf16_t* Wot = (const bf16_t*)(wl + W1_B + WB_B);
        const bf16_t* Wft = (const bf16_t*)(wl + W1_B + WB_B + WO_B); const bf16_t* Wdt = (const bf16_t*)(wl + W1_B + WB_B + WO_B + WF_B);
        if constexpr (k == 0) {
            pg8::Gemm g{H, W1t, MPAD, ZLD, 1024}; pg8::StaticOrder S; S.init(MPAD, ZLD, G, bid);
            EpiZG E{ZG, p.in[I_BG] + (size_t)l * 4096, (const float*)(p.ws + WS_ROPE), p.in[I_QNA] + l * 64, p.in[I_KNA] + l * 64, p.in[I_QNB] + l * 192, p.in[I_KNB] + l * 192, p.out, l, SS + (size_t)(2 * l) * MPAD};
            pg8::gemm_phase<EpiZG, pg8::StaticOrder, PG8_ALIGN, PG8_SP2>(lds, g, S, E, tid);
        } else if constexpr (k == 1) {
        } else if constexpr (k == 2) {
            mixer_phase(p, lds, l, gw, NGW, wave, lane, gt, NT);
        } else if constexpr (k == 3) {
            merge_phase(p, gt, NT);
        } else if constexpr (k == 4) {
            pg8::Gemm g{(const bf16_t*)(p.ws + WS_BR), Wbt, 4 * MPAD, 4096, 384}; QuadOrder S; S.o.init(MPAD, 1024, G, bid);
            EpiBranch E{ZG, (float*)(p.ws + WS_PART), (bf16_t*)(p.ws + WS_MRG)};
            pg8::gemm_phase<EpiBranch, QuadOrder, PG8_ALIGN, PG8_SP2>(lds, g, S, E, tid);
        } else if constexpr (k == 5) {
            pg8::Gemm g{(const bf16_t*)(p.ws + WS_MRG), Wot, MPAD, 1024, 1024}; pg8::StaticOrder S; S.init(MPAD, 1024, G, bid);
            EpiResid E{X, X, MPAD, H, SS + (size_t)(2 * l + 1) * MPAD};
            pg8::gemm_phase<EpiResid, pg8::StaticOrder, PG8_ALIGN, PG8_SP2>(lds, g, S, E, tid);
        } else if constexpr (k == 6) {
        } else if constexpr (k == 7) {
            pg8::Gemm g{H, Wft, MPAD, 2 * DFF, 1024}; pg8::StaticOrder S; S.init(MPAD, 2 * DFF, G, bid);
            EpiSwiglu E{(bf16_t*)(p.ws + WS_ACT), SS + (size_t)(2 * l + 1) * MPAD};
            pg8::gemm_phase<EpiSwiglu, pg8::StaticOrder, PG8_ALIGN, PG8_SP2>(lds, g, S, E, tid);
        } else if constexpr (k == 8) {
            pg8::Gemm g{(const bf16_t*)(p.ws + WS_ACT), Wdt, MPAD, 1024, DFF}; pg8::StaticOrder S; S.init(MPAD, 1024, G, bid);
            EpiResid E{X, l == 1 ? p.out : X, l == 1 ? MTOK : MPAD, l == 1 ? nullptr : H, SS + 2ull * MPAD};
            pg8::gemm_phase<EpiResid, pg8::StaticOrder, PG8_ALIGN, PG8_SP2>(lds, g, S, E, tid);
        } else {
        }
    }
}
__global__ void __launch_bounds__(512, 2) fwd_kernel(Params p) {
    extern __shared__ __attribute__((aligned(16))) unsigned char lds_raw[];
    LAS unsigned char* lds = (LAS unsigned char*)lds_raw;
    const int wave_s = __builtin_amdgcn_readfirstlane(threadIdx.x >> 6);
    unsigned* bar = (unsigned*)(p.ws + WS_BAR); const unsigned nblk = gridDim.x;
    if (p.ph_hi - p.ph_lo > 1) cg::this_grid().sync();
#if DEBUG_CHK
    if (p.ph_lo >= 100) { const int tid = threadIdx.x; dbg_phase(p, p.ph_lo - 100, blockIdx.x * 8 + wave_s, gridDim.x * 8, tid & 63, blockIdx.x * 512 + tid, gridDim.x * 512); return; }
#endif
#ifndef REP_MASK
#define REP_MASK 0u
#endif
#define EMPTYPH(K) ((K) == 2 || (K) == 7 || (K) == 10 || (K) == 12 || (K) == 17)
#define NEMPTY(K) ((unsigned)(((K) > 2) + ((K) > 7) + ((K) > 10) + ((K) > 12) + ((K) > 17)))
#define RUN(K) if (!EMPTYPH(K) && p.ph_lo <= (K) && (K) < p.ph_hi) { if ((K) > p.ph_lo) grid_barrier(bar, ((unsigned)((K) - p.ph_lo) - NEMPTY(K)) * nblk, wave_s); run_phase<(K)>(p, lds, wave_s); }
    RUN(0) RUN(1) RUN(2) RUN(3) RUN(4) RUN(5) RUN(6) RUN(7) RUN(8) RUN(9) RUN(10) RUN(11) RUN(12) RUN(13) RUN(14) RUN(15) RUN(16) RUN(17) RUN(18) RUN(19)
#undef RUN
}
}

extern "C" void kernel_launch(void* const* d_in, const int* in_sizes, int n_in, void* d_out, int out_size, void* d_ws, size_t ws_size, hipStream_t stream) {
    static int grid = 0;
    if (grid == 0) {
        if (n_in != 24 || (size_t)out_size != mk::O_END || ws_size < mk::WS_END) { fprintf(stderr, "kernel_launch: unexpected shapes: n_in %d out %d ws %zu (need %zu)\n", n_in, out_size, ws_size, (size_t)mk::WS_END); grid = -1; return; }
        int dev = 0, cus = 0, per_cu = 0;
        if (hipGetDevice(&dev) != hipSuccess || hipDeviceGetAttribute(&cus, hipDeviceAttributeMultiprocessorCount, dev) != hipSuccess) { fprintf(stderr, "kernel_launch: device query failed\n"); grid = -1; return; }
        if (hipFuncSetAttribute((const void*)mk::fwd_kernel, hipFuncAttributeMaxDynamicSharedMemorySize, mk::LDS_BYTES) != hipSuccess) { fprintf(stderr, "kernel_launch: hipFuncSetAttribute failed\n"); grid = -1; return; }
        if (hipOccupancyMaxActiveBlocksPerMultiprocessor(&per_cu, (const void*)mk::fwd_kernel, 512, mk::LDS_BYTES) != hipSuccess || per_cu < 1) { fprintf(stderr, "kernel_launch: occupancy query gave %d\n", per_cu); per_cu = 1; }
        (void)hipGetLastError();
        grid = cus * 1;
    }
    if (grid < 0) return;
    if (hipMemsetAsync((char*)d_ws + mk::WS_BAR, 0, 256, stream) != hipSuccess) { fprintf(stderr, "kernel_launch: memset failed\n"); return; }
    mk::Params p{};
    for (int i = 0; i < 24; ++i) p.in[i] = (const float*)d_in[i];
    p.out = (float*)d_out; p.ws = (unsigned char*)d_ws;
#if ONE_LAUNCH
    p.ph_lo = 0; p.ph_hi = mk::NPH;
    void* args[] = {&p};
    hipError_t e = hipLaunchCooperativeKernel((const void*)mk::fwd_kernel, dim3(grid), dim3(512), args, mk::LDS_BYTES, stream);
    if (e != hipSuccess) fprintf(stderr, "kernel_launch: cooperative launch failed: %s (grid %d)\n", hipGetErrorString(e), grid);
#else
    for (int ph = 0; ph < mk::NPH; ++ph) {
        p.ph_lo = ph; p.ph_hi = ph + 1;
        hipLaunchKernelGGL(mk::fwd_kernel, dim3(grid), dim3(512), mk::LDS_BYTES, stream, p);
#if DEBUG_CHK
        const int kind = ph == 1 ? 1 : ph == 3 ? 9 : ph == 5 ? 2 : ph == 6 ? 3 : ph == 7 ? 4 : ph == 8 ? 5 : ph == 9 ? 6 : 0;
        if (kind) { p.ph_lo = 100 + kind; p.ph_hi = 101 + kind; hipLaunchKernelGGL(mk::fwd_kernel, dim3(grid), dim3(512), mk::LDS_BYTES, stream, p); }
#endif
    }
#if DEBUG_CHK
    p.ph_lo = 199; p.ph_hi = 200; hipLaunchKernelGGL(mk::fwd_kernel, dim3(grid), dim3(512), mk::LDS_BYTES, stream, p);
#endif
#endif
}
```

```cpp
#include <hip/hip_runtime.h>
#include <hip/hip_cooperative_groups.h>
#include <cstdio>
#include <cstdint>
namespace cg = cooperative_groups;
#ifndef ONE_LAUNCH
#define ONE_LAUNCH 1
#endif
namespace pg8 {
#define PG8_LAS __attribute__((address_space(3)))
typedef unsigned short bf16_t;
typedef short bf16x8 __attribute__((ext_vector_type(8)));
typedef float f32x4 __attribute__((ext_vector_type(4)));
typedef unsigned u32x4 __attribute__((ext_vector_type(4)));
constexpr int BM = 256, BK = 64, HALF = 128, HTB = HALF * BK * 2  , STAGE_BYTES = 8 * HTB, NXCD = 8, WGM = 8;

__host__ __device__ __forceinline__ int lds_byte(int r, int c) { const int st = (r >> 4) * 2 + (c >> 5), rr = r & 15, cc = c & 31, ob = rr * 64 + cc * 2; return st * 1024 + (ob ^ (((ob >> 9) & 1) << 5)); }
__host__ __device__ __forceinline__ void stage_rc(int b, int& R, int& C) { const int st = b / 1024, sb = b % 1024, swz = sb ^ (((sb >> 9) & 1) << 5); R = (st >> 1) * 16 + swz / 64; C = (st & 1) * 32 + (swz % 64) / 2; }
__host__ __device__ __forceinline__ int perm32(int rho) { const int n = rho >> 4, i = rho & 15; return 8 * (i >> 2) + 4 * n + (i & 3); }

struct Unit { int pm, pn; };
struct Gemm { const bf16_t* A; const bf16_t* Bt; int M, N, K; };

struct StaticOrder {
    int nM, nN, nwg, G, c;
    __host__ __device__ void init(int M, int N, int G_, int c_) { nM = M / BM; nN = N / BM; nwg = nM * nN; G = G_; c = c_; }
    __host__ __device__ bool next(int i, Unit& u) const {
        const long L = (long)i * G + c; if (L >= nwg) return false;
        int wgid = (int)L; { const int q = nwg / NXCD, r = nwg % NXCD, xcd = wgid % NXCD, off = wgid / NXCD; wgid = (xcd < r ? xcd * (q + 1) : r * (q + 1) + (xcd - r) * q) + off; }
        const int nig = WGM * nN, gid = wgid / nig, fm = gid * WGM, gsz = (nM - fm) < WGM ? (nM - fm) : WGM;
        u.pm = fm + ((wgid % nig) % gsz); u.pn = (wgid % nig) / gsz; return true;
    }
    __device__ __forceinline__ void a_ready(const Unit&) const {}
    __device__ __forceinline__ void done(const Unit&) const {}
};

__device__ __forceinline__ unsigned cvt_pk_bf16(float lo, float hi) { unsigned r; asm volatile("v_cvt_pk_bf16_f32 %0, %1, %2" : "=v"(r) : "v"(lo), "v"(hi)); return r; }
typedef float f32x2 __attribute__((ext_vector_type(2)));
__device__ __forceinline__ f32x2 gelu_pk(f32x2 v) {
    const f32x2 av = __builtin_elementwise_abs(v), d = av * 0.2316418882f + 1.0f;
    f32x2 t; t.x = __builtin_amdgcn_rcpf(d.x); t.y = __builtin_amdgcn_rcpf(d.y);
    f32x2 q = t * 0.5307027145f + (-0.7265760135f); q = q * t + 0.7107068705f; q = q * t + (-0.142248368f); q = q * t + 0.127414796f; q = q * t;
    const f32x2 s = (v * v) * (-0.72134752044f);
    f32x2 e; e.x = __builtin_amdgcn_exp2f(s.x); e.y = __builtin_amdgcn_exp2f(s.y);
    const f32x2 m = v * (q * e), r = v - m;
    f32x2 o; o.x = v.x < 0.f ? m.x : r.x; o.y = v.y < 0.f ? m.y : r.y; return o;
}

template <int ACT  > struct EpiBf16 {
    static constexpr bool PERM = true, AFTER_DRAIN = false; static_assert(ACT == 0 || ACT == 1, "EpiBf16: ACT is 0 (none) or 1 (gelu_pk)");
    bf16_t* O; int ldc; const float* bias; int split_cols; size_t split_stride; float scale0;
    __device__ __forceinline__ void operator()(const f32x4 (&acc)[2][2][4][2], const Unit& u, int wr, int wc, int fr, int fq) const {
        const int row0 = u.pm * BM + wr * 64 + fr; int colt = u.pn * BM; bf16_t* base = O;
        float sc = 1.f; if (split_cols) { const int t = colt / split_cols; base += (size_t)t * split_stride; colt -= t * split_cols; if (t == 0) sc = scale0; }
        const int col0 = colt + wc * 32 + 8 * fq, bcol0 = u.pn * BM + wc * 32 + 8 * fq;
        f32x4 bv[2][2];
#pragma unroll
        for (int bj = 0; bj < 2; ++bj)
#pragma unroll
            for (int n = 0; n < 2; ++n) bv[bj][n] = bias ? *(const f32x4*)(bias + bcol0 + bj * HALF + 4 * n) : (f32x4){0.f, 0.f, 0.f, 0.f};
#pragma unroll
        for (int ai = 0; ai < 2; ++ai)
#pragma unroll
            for (int m = 0; m < 4; ++m) { bf16_t* rowp = base + (size_t)(row0 + ai * HALF + m * 16) * ldc + col0;
#pragma unroll
                for (int bj = 0; bj < 2; ++bj) { f32x4 v0 = acc[ai][bj][m][0] + bv[bj][0], v1 = acc[ai][bj][m][1] + bv[bj][1];
                    if (ACT == 1) { f32x2 a = gelu_pk((f32x2){v0[0], v0[1]}), b = gelu_pk((f32x2){v0[2], v0[3]}), c = gelu_pk((f32x2){v1[0], v1[1]}), d = gelu_pk((f32x2){v1[2], v1[3]});
                        v0 = (f32x4){a.x, a.y, b.x, b.y}; v1 = (f32x4){c.x, c.y, d.x, d.y}; }
                    v0 = v0 * sc; v1 = v1 * sc; u32x4 w; w.x = cvt_pk_bf16(v0[0], v0[1]); w.y = cvt_pk_bf16(v0[2], v0[3]); w.z = cvt_pk_bf16(v1[0], v1[1]); w.w = cvt_pk_bf16(v1[2], v1[3]);
                    *(u32x4*)(rowp + bj * HALF) = w; } }
    }
};

template <class Epi, class Sched, bool ALIGN_EPI = false, bool SP2 = false>
__device__ __forceinline__ void gemm_phase(PG8_LAS unsigned char* lds, const Gemm g, const Sched& S, const Epi& E, int tid_in) {
    int tid_l = tid_in; asm volatile("" : "+v"(tid_l));
    const int tid = tid_l, wid = __builtin_amdgcn_readfirstlane(tid >> 6), lane = tid & 63, wr = wid >> 2, wc = wid & 3, fr = lane & 15, fq = lane >> 4;
    const int K = g.K, nt = K / BK;
    unsigned voffA[2], voffB[2];
#pragma unroll
    for (int i = 0; i < 2; ++i) { int R, C; stage_rc(tid * 16 + i * 8192, R, C); const int Rb = Epi::PERM ? ((R & ~31) + perm32(R & 31)) : R;
        voffA[i] = (unsigned)(R * K + C) * 2u; voffB[i] = (unsigned)(Rb * K + C) * 2u; }
    const size_t kstep = (size_t)(BK * 2);
    const size_t hstep = (size_t)HALF * K * 2;
    const size_t tstep = 2 * hstep;
    const unsigned ldsw = (unsigned)wid * 1024u;
    const int aoff = lds_byte(wr * 64 + fr, fq * 8), boff = lds_byte(wc * 32 + fr, fq * 8);
#define PG8_SA(b, h) (((b) * 2 + (h)) * HTB)
#define PG8_SB(b, h) ((4 + (b) * 2 + (h)) * HTB)
#define PG8_STAGE(bufoff, gbase, voff) do { _Pragma("unroll") for (int _i = 0; _i < 2; ++_i) \
        __builtin_amdgcn_global_load_lds((const unsigned*)((const char*)(gbase) + (voff)[_i]), (PG8_LAS unsigned*)(lds + (bufoff) + ldsw + _i * 8192), 16, 0, 0); } while (0)
#define PG8_LDA(dst, b, h) do { _Pragma("unroll") for (int m = 0; m < 4; ++m) _Pragma("unroll") for (int k = 0; k < 2; ++k) dst[m][k] = *(const PG8_LAS bf16x8*)(lds + PG8_SA(b, h) + aoff + m * 2048 + k * 1024); } while (0)
#define PG8_LDB(dst, b, h) do { _Pragma("unroll") for (int n = 0; n < 2; ++n) _Pragma("unroll") for (int k = 0; k < 2; ++k) dst[n][k] = *(const PG8_LAS bf16x8*)(lds + PG8_SB(b, h) + boff + n * 2048 + k * 1024); } while (0)
#define PG8_MMA(ai, bj, At, Bt) do { __builtin_amdgcn_s_setprio(1); _Pragma("unroll") for (int m = 0; m < 4; ++m) _Pragma("unroll") for (int n = 0; n < 2; ++n) _Pragma("unroll") for (int k = 0; k < 2; ++k) \
        acc[ai][bj][m][n] = __builtin_amdgcn_mfma_f32_16x16x32_bf16(Bt[n][k], At[m][k], acc[ai][bj][m][n], 0, 0, 0); __builtin_amdgcn_s_setprio(0); } while (0)
#define PG8_WAIT_V(n) asm volatile("s_waitcnt vmcnt(" #n ")" ::: "memory")
#define PG8_WAIT_L(n) asm volatile("s_waitcnt lgkmcnt(" #n ")" ::: "memory")
#define PG8_BAR __builtin_amdgcn_s_barrier()
#define PG8_SCHED __builtin_amdgcn_sched_barrier(0)
    Unit cur, nxt; int ui = 0;
    if (!S.next(0, cur)) return;
    f32x4 acc[2][2][4][2];
#pragma unroll
    for (int a = 0; a < 2; ++a)
#pragma unroll
        for (int b = 0; b < 2; ++b)
#pragma unroll
            for (int m = 0; m < 4; ++m)
#pragma unroll
                for (int n = 0; n < 2; ++n) acc[a][b][m][n] = (f32x4){0.f, 0.f, 0.f, 0.f};
    bf16x8 At[4][2], B0[2][2], B1[2][2];
    const char* cA = (const char*)g.A + (size_t)cur.pm * tstep; const char* cB = (const char*)g.Bt + (size_t)cur.pn * tstep;
    S.a_ready(cur);
    if constexpr (SP2) {
        PG8_STAGE(PG8_SB(0, 0), cB, voffB); PG8_STAGE(PG8_SB(0, 1), cB + hstep, voffB); PG8_STAGE(PG8_SA(0, 0), cA, voffA); PG8_STAGE(PG8_SA(0, 1), cA + hstep, voffA);
        if (wr == 1) PG8_BAR;
        PG8_WAIT_V(2); PG8_BAR;
        PG8_STAGE(PG8_SB(1, 0), cB + kstep, voffB); PG8_STAGE(PG8_SA(1, 0), cA + kstep, voffA); PG8_STAGE(PG8_SB(1, 1), cB + hstep + kstep, voffB);
        PG8_WAIT_V(6); PG8_BAR;
    } else {
        PG8_STAGE(PG8_SB(0, 0), cB, voffB); PG8_STAGE(PG8_SA(0, 0), cA, voffA); PG8_STAGE(PG8_SB(0, 1), cB + hstep, voffB); PG8_STAGE(PG8_SA(0, 1), cA + hstep, voffA);
        if (wr == 1) PG8_BAR;
        PG8_WAIT_V(4); PG8_BAR;
        PG8_STAGE(PG8_SB(1, 0), cB + kstep, voffB); PG8_STAGE(PG8_SA(1, 0), cA + kstep, voffA); PG8_STAGE(PG8_SB(1, 1), cB + hstep + kstep, voffB);
        PG8_WAIT_V(6); PG8_BAR;
    }
    for (;;) {
        const bool has_next = S.next(ui + 1, nxt);
        const char* nA = has_next ? (const char*)g.A + (size_t)nxt.pm * tstep : cA; const char* nB = has_next ? (const char*)g.Bt + (size_t)nxt.pn * tstep : cB;
        for (int t = 0; t < nt; t += 2) {
            if constexpr (Epi::SEGMENT_TILES > 0) { if (t > 0 && (t % Epi::SEGMENT_TILES) == 0) E.rescale(acc, cur, t / Epi::SEGMENT_TILES, wr, wc, fr, fq); }
            const bool last = (t == nt - 2);
            const char* a1 = cA + (size_t)(t + 1) * kstep;
            const char* a2 = last ? nA : cA + (size_t)(t + 2) * kstep; const char* b2 = last ? nB : cB + (size_t)(t + 2) * kstep;
            const char* a3 = a2 + kstep; const char* b3 = b2 + kstep;
            if (last && has_next) S.a_ready(nxt);
            if constexpr (SP2) {
            PG8_LDB(B0, 0, 0); PG8_LDB(B1, 0, 1); PG8_SCHED; PG8_LDA(At, 0, 0); PG8_STAGE(PG8_SA(1, 1), a1 + hstep, voffA);
            PG8_WAIT_V(8); PG8_WAIT_L(0); PG8_BAR; PG8_MMA(0, 0, At, B0); PG8_MMA(0, 1, At, B1); PG8_BAR; PG8_SCHED;
            PG8_LDA(At, 0, 1); PG8_STAGE(PG8_SB(0, 0), b2, voffB); PG8_STAGE(PG8_SB(0, 1), b2 + hstep, voffB); PG8_STAGE(PG8_SA(0, 0), a2, voffA);
            PG8_WAIT_V(8); PG8_WAIT_L(0); PG8_BAR; PG8_MMA(1, 0, At, B0); PG8_MMA(1, 1, At, B1); PG8_BAR; PG8_SCHED;
            PG8_LDB(B0, 1, 0); PG8_LDB(B1, 1, 1); PG8_SCHED; PG8_LDA(At, 1, 0); PG8_STAGE(PG8_SA(0, 1), a2 + hstep, voffA);
            PG8_WAIT_V(8); PG8_WAIT_L(0); PG8_BAR; PG8_MMA(0, 0, At, B0); PG8_MMA(0, 1, At, B1); PG8_BAR; PG8_SCHED;
            PG8_LDA(At, 1, 1); PG8_STAGE(PG8_SB(1, 0), b3, voffB); PG8_STAGE(PG8_SB(1, 1), b3 + hstep, voffB); PG8_STAGE(PG8_SA(1, 0), a3, voffA);
            PG8_WAIT_V(8); PG8_WAIT_L(0); PG8_BAR; PG8_MMA(1, 0, At, B0); PG8_MMA(1, 1, At, B1); PG8_BAR; PG8_SCHED;
            } else {
            PG8_LDB(B0, 0, 0); PG8_SCHED; PG8_LDA(At, 0, 0); PG8_STAGE(PG8_SA(1, 1), a1 + hstep, voffA);
            PG8_WAIT_L(8); PG8_BAR; PG8_WAIT_L(0); PG8_MMA(0, 0, At, B0); PG8_BAR; PG8_SCHED;
            PG8_LDB(B1, 0, 1); PG8_STAGE(PG8_SB(0, 0), b2, voffB);
            PG8_BAR; PG8_WAIT_L(0); PG8_MMA(0, 1, At, B1); PG8_BAR;
            PG8_LDA(At, 0, 1); PG8_STAGE(PG8_SA(0, 0), a2, voffA);
            PG8_BAR; PG8_WAIT_L(0); PG8_MMA(1, 0, At, B0); PG8_BAR; PG8_SCHED;
            PG8_STAGE(PG8_SB(0, 1), b2 + hstep, voffB);
            PG8_WAIT_V(6); PG8_BAR; PG8_MMA(1, 1, At, B1); PG8_BAR;
            PG8_LDB(B0, 1, 0); PG8_SCHED; PG8_LDA(At, 1, 0); PG8_STAGE(PG8_SA(0, 1), a2 + hstep, voffA);
            PG8_WAIT_L(8); PG8_BAR; PG8_WAIT_L(0); PG8_MMA(0, 0, At, B0); PG8_BAR; PG8_SCHED;
            PG8_LDB(B1, 1, 1); PG8_STAGE(PG8_SB(1, 0), b3, voffB);
            PG8_BAR; PG8_WAIT_L(0); PG8_MMA(0, 1, At, B1); PG8_BAR;
            PG8_LDA(At, 1, 1); PG8_STAGE(PG8_SA(1, 0), a3, voffA);
            PG8_BAR; PG8_WAIT_L(0); PG8_MMA(1, 0, At, B0); PG8_BAR; PG8_SCHED;
            PG8_STAGE(PG8_SB(1, 1), b3 + hstep, voffB);
            PG8_WAIT_V(6); PG8_BAR; PG8_MMA(1, 1, At, B1); PG8_BAR;
            }
        }
        if constexpr (ALIGN_EPI) { if (wr == 0) PG8_BAR; }
        if constexpr (!Epi::AFTER_DRAIN) { E(acc, cur, wr, wc, fr, fq); S.done(cur); }
        if (!has_next) break;
#pragma unroll
        for (int a = 0; a < 2; ++a)
#pragma unroll
            for (int b = 0; b < 2; ++b)
#pragma unroll
                for (int m = 0; m < 4; ++m)
#pragma unroll
                    for (int n = 0; n < 2; ++n) acc[a][b][m][n] = (f32x4){0.f, 0.f, 0.f, 0.f};
        cur = nxt; cA = nA; cB = nB; ++ui;
        if constexpr (ALIGN_EPI) { if (wr == 1) PG8_BAR; }
    }
    PG8_WAIT_V(0);
    if constexpr (!ALIGN_EPI) { if (wr == 0) PG8_BAR; }
    PG8_BAR;
    if constexpr (Epi::AFTER_DRAIN) { E.fused(acc, cur, wr, wc, fr, fq, lds, wid, lane); S.done(cur); }
#undef PG8_SA
#undef PG8_SB
#undef PG8_STAGE
#undef PG8_LDA
#undef PG8_LDB
#undef PG8_MMA
#undef PG8_WAIT_V
#undef PG8_WAIT_L
#undef PG8_BAR
#undef PG8_SCHED
}
}
#define PG8_SP2 true
#define PG8_ALIGN true
namespace mk {
#define LAS __attribute__((address_space(3)))
using pg8::bf16_t; using pg8::bf16x8; using pg8::f32x4; using pg8::u32x4;
typedef float f32x16 __attribute__((ext_vector_type(16)));
typedef short s16x4 __attribute__((ext_vector_type(4)));
typedef unsigned u32x2 __attribute__((ext_vector_type(2)));

constexpr int MP = 32768, MS = 128, MTOK = MP + MS, MPAD = 33024, NTM = MPAD / 256;
constexpr int ZLD = 8704, GOFF = 4608, BW = 384, DFF = 2816;
constexpr int LDS_BYTES = 131072;
constexpr float LOG2E = 1.4426950408889634f, LN2 = 0.6931471805599453f, EPS = 1e-6f;
enum { I_XP = 0, I_XS, I_CA, I_CB1, I_CB2, I_CB3, I_SC, I_LN1, I_WIN, I_QNA, I_KNA, I_SINK, I_QNB, I_KNB, I_CONV, I_WSD, I_BSD, I_WG, I_BG, I_WB, I_WO, I_LN2, I_WFI, I_WFO };
constexpr size_t O_YP = 0, O_YS = 33554432, O_AP = O_YS + 131072, O_AS = O_AP + 1048576, O_B1P = O_AS + 8388608, O_B1S = O_B1P + 1048576, O_B2P = O_B1S + 8388608,
                 O_B2S = O_B2P + 4194304, O_B3P = O_B2S + 33554432, O_B3S = O_B3P + 16777216, O_CP = O_B3S + 134217728, O_CS = O_CP + 24576, O_DS = O_CS + 196608, O_END = O_DS + 98304;
static_assert(O_END == 241623040, "output size");
constexpr size_t al(size_t x) { return (x + 255) & ~(size_t)255; }
constexpr size_t WS_ROPE = 0;
constexpr size_t WS_WM = al(WS_ROPE + 2049 * 16 * 4);
constexpr size_t WS_W = al(WS_WM + 2 * 6 * 128 * 128 * 2);
constexpr size_t W1_B = (size_t)ZLD * 1024 * 2, WB_B = 4ull * 1024 * 384 * 2, WO_B = 1024ull * 1024 * 2, WF_B = 5632ull * 1024 * 2, WD_B = 1024ull * 2816 * 2;
constexpr size_t WL_B = W1_B + WB_B + WO_B + WF_B + WD_B;
constexpr size_t WS_X = al(WS_W + 2 * WL_B);
constexpr size_t WS_H = al(WS_X + (size_t)MPAD * 1024 * 4);
constexpr size_t WS_ZG = al(WS_H + (size_t)MPAD * 1024 * 2);
constexpr size_t WS_BR = al(WS_ZG + (size_t)MPAD * ZLD * 2);
constexpr size_t WS_OB = al(WS_BR + 4ull * MPAD * BW * 2);
constexpr size_t WS_LSE = al(WS_OB + 3ull * MPAD * BW * 2);
constexpr size_t WS_PART = al(WS_LSE + 3ull * MPAD * 8 * 4);
constexpr size_t WS_MRG = al(WS_PART + (size_t)MPAD * 1024 * 4);
constexpr size_t WS_ACT = al(WS_MRG + (size_t)MPAD * 1024 * 2);
constexpr size_t WS_BAR = al(WS_ACT + (size_t)MPAD * DFF * 2);
constexpr size_t WS_END = al(WS_BAR + 256);

struct Params { const float* in[24]; float* out; unsigned char* ws; int ph_lo, ph_hi; };
static_assert(sizeof(Params) == 216, "Params has padding");

#define DI __device__ __forceinline__
typedef float f32x2v __attribute__((ext_vector_type(2)));
typedef __bf16 bf16x2v __attribute__((ext_vector_type(2)));
DI unsigned pk2(float lo, float hi) { const f32x2v v = {lo, hi}; return __builtin_bit_cast(unsigned, __builtin_convertvector(v, bf16x2v)); }
DI float bflo(unsigned w) { return __uint_as_float(w << 16); }
DI float bfhi(unsigned w) { return __uint_as_float(w & 0xffff0000u); }
DI float bf1(bf16_t v) { return __uint_as_float((unsigned)v << 16); }
DI void unpack8(const u32x4 w, float (&x)[8]) { x[0] = bflo(w.x); x[1] = bfhi(w.x); x[2] = bflo(w.y); x[3] = bfhi(w.y); x[4] = bflo(w.z); x[5] = bfhi(w.z); x[6] = bflo(w.w); x[7] = bfhi(w.w); }
DI u32x4 pack8(const float (&x)[8]) { u32x4 w; w.x = pk2(x[0], x[1]); w.y = pk2(x[2], x[3]); w.z = pk2(x[4], x[5]); w.w = pk2(x[6], x[7]); return w; }
DI float wave_sum(float v) {
#pragma unroll
    for (int o = 1; o < 64; o <<= 1) v += __shfl_xor(v, o);
    return v; }
DI float wave_max(float v) {
#pragma unroll
    for (int o = 1; o < 64; o <<= 1) v = fmaxf(v, __shfl_xor(v, o));
    return v; }
DI float ex2(float x) { return __builtin_amdgcn_exp2f(x); }
DI int crow(int reg, int h) { return (reg & 3) + 8 * (reg >> 2) + 4 * h; }
#define MFMA32(a, b, c) __builtin_amdgcn_mfma_f32_32x32x16_bf16((a), (b), (c), 0, 0, 0)

struct QuadOrder {
    pg8::StaticOrder o;
    __device__ bool next(int i, pg8::Unit& u) const { pg8::Unit q; if (!o.next(i >> 2, q)) return false; const int n = i & 3; u.pm = n * NTM + q.pm; u.pn = n * 4 + q.pn; return true; }
    DI void a_ready(const pg8::Unit&) const {}
    DI void done(const pg8::Unit&) const {}
};
typedef f32x4 AccT[2][2][4][2];
struct EpiZG {
    static constexpr bool PERM = true, AFTER_DRAIN = false; static constexpr int SEGMENT_TILES = 0;
    bf16_t* O; const float* bias; const float* rope; const float* qna; const float* kna; const float* qnb; const float* knb; float* out; int l;
    DI void operator()(const AccT& acc, const pg8::Unit& u, int wr, int wc, int fr_, int fq_) const {
        int fr = fr_, fq = fq_; asm volatile("" : "+v"(fr), "+v"(fq));
        const int rowb = u.pm * 256 + wr * 64 + fr;
        if (u.pn >= 18) {
            const int col0 = u.pn * 256 + wc * 32 + 8 * fq;
            f32x4 bv[2][2];
#pragma unroll
            for (int bj = 0; bj < 2; ++bj) { bv[bj][0] = *(const f32x4*)(bias + col0 + bj * 128 - GOFF); bv[bj][1] = *(const f32x4*)(bias + col0 + bj * 128 - GOFF + 4); }
#pragma unroll
            for (int ai = 0; ai < 2; ++ai)
#pragma unroll
                for (int m = 0; m < 4; ++m) {
#pragma unroll
                    for (int bj = 0; bj < 2; ++bj) {
                        f32x4 v0 = acc[ai][bj][m][0] + bv[bj][0], v1 = acc[ai][bj][m][1] + bv[bj][1];
#pragma unroll
                        for (int e = 0; e < 4; ++e) { v0[e] = __builtin_amdgcn_rcpf(1.f + ex2(-LOG2E * v0[e])); v1[e] = __builtin_amdgcn_rcpf(1.f + ex2(-LOG2E * v1[e])); }
                        u32x4 w; w.x = pk2(v0[0], v0[1]); w.y = pk2(v0[2], v0[3]); w.z = pk2(v1[0], v1[1]); w.w = pk2(v1[2], v1[3]);
                        *(u32x4*)(O + (size_t)(rowb + ai * 128 + m * 16) * ZLD + col0 + bj * 128) = w;
                    }
                    asm volatile("" ::: "memory");
                }
            return;
        }
        const int c64 = u.pn * 4 + wc, colL = c64 * 64 + 8 * fq;
        int type = 3, gi = 0, hh = 0;
        if (c64 < 40) { gi = c64 / 10; hh = c64 - gi * 10; type = hh < 6 ? 0 : (hh < 8 ? 1 : 2); }
        f32x4 g00 = (f32x4){1.f, 1.f, 1.f, 1.f}, g01 = g00, g10 = g00, g11 = g00;
        if (type <= 1) { const float* gn = (type == 0 ? (gi == 0 ? qna : qnb + (gi - 1) * 64) : (gi == 0 ? kna : knb + (gi - 1) * 64)) + 8 * fq;
            g00 = *(const f32x4*)gn; g01 = *(const f32x4*)(gn + 4); g10 = *(const f32x4*)(gn + 32); g11 = *(const f32x4*)(gn + 36); }
        const int W = gi < 2 ? 128 : (gi == 2 ? 512 : 2048);
        const size_t obase_p = gi == 0 ? O_AP : (gi == 1 ? O_B1P : (gi == 2 ? O_B2P : O_B3P)), obase_s = gi == 0 ? O_AS : (gi == 1 ? O_B1S : (gi == 2 ? O_B2S : O_B3S));
#pragma unroll
        for (int ai = 0; ai < 2; ++ai)
#pragma unroll
            for (int m = 0; m < 4; ++m) {
                const int row = rowb + ai * 128 + m * 16;
                f32x4 v00 = acc[ai][0][m][0], v01 = acc[ai][0][m][1], v10 = acc[ai][1][m][0], v11 = acc[ai][1][m][1];
                const bool samp = row >= MP; const int t = row & 2047;
                if (type <= 1) {
                    float ss = 0.f;
#pragma unroll
                    for (int e = 0; e < 4; ++e) ss += v00[e] * v00[e] + v01[e] * v01[e] + v10[e] * v10[e] + v11[e] * v11[e];
                    ss += __shfl_xor(ss, 16); ss += __shfl_xor(ss, 32);
                    const float rs = 1.0f / sqrtf(ss * (1.f / 64.f) + EPS);
                    v00 = v00 * rs * g00; v01 = v01 * rs * g01; v10 = v10 * rs * g10; v11 = v11 * rs * g11;
                    f32x4 y0, y1;
#pragma unroll
                    for (int e = 0; e < 4; ++e) { y0[e] = __shfl_xor(v00[e], 16); y1[e] = __shfl_xor(v01[e], 16); }
                    if (fq < 2) {
                        const float* rp = rope + (samp ? 2048 : t) * 16;
                        const f32x4 c0 = *(const f32x4*)rp, c1 = *(const f32x4*)(rp + 4), c2 = *(const f32x4*)(rp + 8), c3 = *(const f32x4*)(rp + 12);
                        const float sg = fq == 0 ? -1.f : 1.f;
                        v00 = (f32x4){v00[0] * c0[0] + sg * y0[0] * c0[1], v00[1] * c0[2] + sg * y0[1] * c0[3], v00[2] * c1[0] + sg * y0[2] * c1[1], v00[3] * c1[2] + sg * y0[3] * c1[3]};
                        v01 = (f32x4){v01[0] * c2[0] + sg * y1[0] * c2[1], v01[1] * c2[2] + sg * y1[1] * c2[3], v01[2] * c3[0] + sg * y1[2] * c3[1], v01[3] * c3[2] + sg * y1[3] * c3[3]};
                    }
                }
                bf16_t* zp = O + (size_t)row * ZLD + colL;
                { u32x4 w; w.x = pk2(v00[0], v00[1]); w.y = pk2(v00[2], v00[3]); w.z = pk2(v01[0], v01[1]); w.w = pk2(v01[2], v01[3]); *(u32x4*)zp = w; }
                { u32x4 w; w.x = pk2(v10[0], v10[1]); w.y = pk2(v10[2], v10[3]); w.z = pk2(v11[0], v11[1]); w.w = pk2(v11[2], v11[3]); *(u32x4*)(zp + 32) = w; }
                if ((type == 1 || type == 2) && row < MTOK) {
                    const int b = samp ? row - MP : row >> 11, jrow = samp ? W - 1 : t - (2048 - W);
                    if (jrow >= 0) {
                        const size_t cb = samp ? obase_s + ((size_t)(l * 128 + b) * 2) * W * 128 : obase_p + ((size_t)(l * 16 + b) * 2) * W * 128;
                        float* d = out + cb + ((size_t)(type - 1) * W + jrow) * 128 + (hh - (type == 1 ? 6 : 8)) * 64 + 8 * fq;
                        *(f32x4*)d = v00; *(f32x4*)(d + 4) = v01; *(f32x4*)(d + 32) = v10; *(f32x4*)(d + 36) = v11;
                    }
                }
                asm volatile("" ::: "memory");
            }
    }
};
struct EpiBranch {
    static constexpr bool PERM = true, AFTER_DRAIN = false; static constexpr int SEGMENT_TILES = 6;
    const bf16_t* G; bf16_t* mrg;
    DI void rescale(AccT& acc, const pg8::Unit& u, int n, int wr, int wc, int fr_, int fq_) const {
        int fr = fr_, fq = fq_; asm volatile("" : "+v"(fr), "+v"(fq));
        const int row0 = u.pm * 256 + wr * 64 + fr, col0 = u.pn * 256 + wc * 32 + 8 * fq;
#pragma unroll
        for (int ai = 0; ai < 2; ++ai)
#pragma unroll
            for (int m = 0; m < 4; ++m) {
                const bf16_t* gp = G + (size_t)(row0 + ai * 128 + m * 16) * ZLD + GOFF + (n - 1) * 1024 + col0;
#pragma unroll
                for (int bj = 0; bj < 2; ++bj) {
                    float gp0[8], gp1[8]; unpack8(*(const u32x4*)(gp + bj * 128), gp0); unpack8(*(const u32x4*)(gp + 1024 + bj * 128), gp1);
#pragma unroll
                    for (int e = 0; e < 4; ++e) { acc[ai][bj][m][0][e] *= fmaxf(gp0[e], 1e-8f) * __builtin_amdgcn_rcpf(fmaxf(gp1[e], 1e-8f)); acc[ai][bj][m][1][e] *= fmaxf(gp0[4 + e], 1e-8f) * __builtin_amdgcn_rcpf(fmaxf(gp1[4 + e], 1e-8f)); }
                }
                asm volatile("" ::: "memory");
            }
    }
    DI void operator()(const AccT& acc, const pg8::Unit& u, int wr, int wc, int fr_, int fq_) const {
        int fr = fr_, fq = fq_; asm volatile("" : "+v"(fr), "+v"(fq));
        const int row0 = u.pm * 256 + wr * 64 + fr, col0 = u.pn * 256 + wc * 32 + 8 * fq;
#pragma unroll
        for (int ai = 0; ai < 2; ++ai)
#pragma unroll
            for (int m = 0; m < 4; ++m) {
                const size_t row = (size_t)(row0 + ai * 128 + m * 16);
#pragma unroll
                for (int bj = 0; bj < 2; ++bj) {
                    const int col = col0 + bj * 128;
                    float gv[8]; unpack8(*(const u32x4*)(G + row * ZLD + GOFF + 3 * 1024 + col), gv);
                    const f32x4 v0 = acc[ai][bj][m][0], v1 = acc[ai][bj][m][1];
                    u32x4 w; w.x = pk2(v0[0] * fmaxf(gv[0], 1e-8f), v0[1] * fmaxf(gv[1], 1e-8f)); w.y = pk2(v0[2] * fmaxf(gv[2], 1e-8f), v0[3] * fmaxf(gv[3], 1e-8f));
                    w.z = pk2(v1[0] * fmaxf(gv[4], 1e-8f), v1[1] * fmaxf(gv[5], 1e-8f)); w.w = pk2(v1[2] * fmaxf(gv[6], 1e-8f), v1[3] * fmaxf(gv[7], 1e-8f));
                    *(u32x4*)(mrg + row * 1024 + col) = w;
                }
                asm volatile("" ::: "memory");
            }
    }
};
struct EpiResid {
    static constexpr bool PERM = true, AFTER_DRAIN = false; static constexpr int SEGMENT_TILES = 0;
    const float* src; float* dst; int nrows;
    DI void operator()(const AccT& acc, const pg8::Unit& u, int wr, int wc, int fr_, int fq_) const {
        int fr = fr_, fq = fq_; asm volatile("" : "+v"(fr), "+v"(fq));
        const int row0 = u.pm * 256 + wr * 64 + fr, col0 = u.pn * 256 + wc * 32 + 8 * fq;
#pragma unroll
        for (int ai = 0; ai < 2; ++ai)
#pragma unroll
            for (int m = 0; m < 4; ++m) {
                const int row = row0 + ai * 128 + m * 16;
                if (row < nrows) {
#pragma unroll
                    for (int bj = 0; bj < 2; ++bj) {
                        const size_t off = (size_t)row * 1024 + col0 + bj * 128;
                        const f32x4 a0 = *(const f32x4*)(src + off), a1 = *(const f32x4*)(src + off + 4);
                        *(f32x4*)(dst + off) = a0 + acc[ai][bj][m][0]; *(f32x4*)(dst + off + 4) = a1 + acc[ai][bj][m][1];
                    }
                    asm volatile("" ::: "memory");
                }
            }
    }
};
struct EpiSwiglu {
    static constexpr bool PERM = true, AFTER_DRAIN = false; static constexpr int SEGMENT_TILES = 0;
    bf16_t* O;
    DI void operator()(const AccT& acc, const pg8::Unit& u, int wr, int wc, int fr_, int fq_) const {
        int fr = fr_, fq = fq_; asm volatile("" : "+v"(fr), "+v"(fq));
        const int row0 = u.pm * 256 + wr * 64 + fr, col0 = u.pn * 128 + wc * 32 + 8 * fq;
#pragma unroll
        for (int ai = 0; ai < 2; ++ai)
#pragma unroll
            for (int m = 0; m < 4; ++m) {
                float o[8];
#pragma unroll
                for (int nn = 0; nn < 2; ++nn)
#pragma unroll
                    for (int e = 0; e < 4; ++e) { const float g = acc[ai][0][m][nn][e], up = acc[ai][1][m][nn][e]; o[nn * 4 + e] = g * __builtin_amdgcn_rcpf(1.f + ex2(-LOG2E * g)) * up; }
                *(u32x4*)(O + (size_t)(row0 + ai * 128 + m * 16) * DFF + col0) = pack8(o);
                asm volatile("" ::: "memory");
            }
    }
};
DI void tr_item(const float* W, int N, bf16_t* WT, int ldk, int k0, int n0, int drow0, LAS float* scr, int lane, int kdst = -1) {
    if (kdst < 0) kdst = k0;
#pragma unroll 8
    for (int i = 0; i < 32; ++i) { const int kk = 2 * i + (lane >> 5); scr[kk * 33 + (lane & 31)] = W[(size_t)(k0 + kk) * N + n0 + (lane & 31)]; }
    const int c = lane & 7;
#pragma unroll
    for (int j = 0; j < 4; ++j) { const int n = (lane >> 3) + 8 * j; const LAS float* s = scr + (8 * c) * 33 + n;
        u32x4 o; o.x = pk2(s[0 * 33], s[1 * 33]); o.y = pk2(s[2 * 33], s[3 * 33]); o.z = pk2(s[4 * 33], s[5 * 33]); o.w = pk2(s[6 * 33], s[7 * 33]);
        *(u32x4*)(WT + (size_t)(drow0 + n) * ldk + kdst + 8 * c) = o; }
}
constexpr int IT_IN = 16 * 140, IT_G = 4 * 512, IT_B = 4 * 192, IT_O = 512, IT_FI = 16 * 176, IT_FO = 44 * 32, IT_L = IT_IN + IT_G + IT_B + IT_O + IT_FI + IT_FO;
DI void prologue_weights(const Params& p, LAS unsigned char* lds, int gw, int NGW, int wave, int lane) {
    LAS float* scr = (LAS float*)(lds + wave * 8448);
    for (int it = gw; it < 2 * IT_L; it += NGW) {
        const int l = it / IT_L; int r = it - l * IT_L;
        unsigned char* wl = p.ws + WS_W + (size_t)l * WL_B;
        bf16_t* W1t = (bf16_t*)wl; bf16_t* Wbt = (bf16_t*)(wl + W1_B); bf16_t* Wot = (bf16_t*)(wl + W1_B + WB_B); bf16_t* Wft = (bf16_t*)(wl + W1_B + WB_B + WO_B); bf16_t* Wdt = (bf16_t*)(wl + W1_B + WB_B + WO_B + WF_B);
        if (r < IT_IN) { const int kb = r / 140, nb = r % 140; const int n0 = 32 * nb, w = n0 & 255; tr_item(p.in[I_WIN] + (size_t)l * 1024 * 4480, 4480, W1t, 1024, 64 * kb, n0, (n0 & ~255) + 128 * ((w >> 5) & 1) + 32 * (w >> 6), scr, lane); continue; } r -= IT_IN;
        if (r < IT_G) { const int n = r / 512, r2 = r % 512, kb = r2 / 32, nb = r2 % 32; tr_item(p.in[I_WG] + (size_t)(l * 4 + n) * 1024 * 1024, 1024, W1t, 1024, 64 * kb, 32 * nb, GOFF + n * 1024 + 32 * nb, scr, lane); continue; } r -= IT_G;
        if (r < IT_B) { const int n = r / 192, r2 = r % 192, kb = r2 / 32, nb = r2 % 32; tr_item(p.in[I_WB] + (size_t)(l * 4 + n) * 384 * 1024, 1024, Wbt, 1536, 64 * kb, 32 * nb, 32 * nb, scr, lane, n * 384 + 64 * kb); continue; } r -= IT_B;
        if (r < IT_O) { const int kb = r / 32, nb = r % 32; tr_item(p.in[I_WO] + (size_t)l * 1024 * 1024, 1024, Wot, 1024, 64 * kb, 32 * nb, 32 * nb, scr, lane); continue; } r -= IT_O;
        if (r < IT_FI) { const int kb = r / 176, nb = r % 176, n0 = 32 * nb; const int dr = n0 < DFF ? 256 * (n0 / 128) + (n0 % 128) : 256 * ((n0 - DFF) / 128) + 128 + ((n0 - DFF) % 128);
            tr_item(p.in[I_WFI] + (size_t)l * 1024 * 5632, 5632, Wft, 1024, 64 * kb, n0, dr, scr, lane); continue; } r -= IT_FI;
        { const int kb = r / 32, nb = r % 32; tr_item(p.in[I_WFO] + (size_t)l * DFF * 1024, 1024, Wdt, DFF, 64 * kb, 32 * nb, 32 * nb, scr, lane); }
    }
}
__constant__ float INV_FREQ[8] = {1.0f, 0.1939227432012558f, 0.03760603070259094f, 0.007292664609849453f, 0.0014142135623842478f, 0.00027424818836152554f, 5.3182957344688475e-05f, 1.0313385246263351e-05f};
DI void prologue_misc(const Params& p, int gt, int NT) {
    for (int i = gt; i < 2 * 16384; i += NT) { const int l = i >> 14, j = i & 16383, rr = j >> 7, prow = 4352 + (rr < 64 ? 64 + rr : 128 + rr); *(u32x4*)(p.ws + WS_W + (size_t)l * WL_B + (size_t)prow * 2048 + (size_t)(j & 127) * 16) = (u32x4){0u, 0u, 0u, 0u}; }
    bf16_t* Wm = (bf16_t*)(p.ws + WS_WM);
    for (int i = gt; i < 2 * 6 * 128 * 64; i += NT) { const int e = 2 * i, jj = e & 127, ii = (e >> 7) & 127; const float a = p.in[I_WSD][e], b = p.in[I_WSD][e + 1];
        *(unsigned*)(Wm + e) = pk2(jj <= ii ? a : 0.f, jj + 1 <= ii ? b : 0.f); }
    float* rope = (float*)(p.ws + WS_ROPE);
    for (int i = gt; i < 2049 * 8; i += NT) { const int pos = (i >> 3) == 2048 ? 16384 : (i >> 3); double rev = (double)pos * (double)INV_FREQ[i & 7] * 0.15915494309189535; rev -= rint(rev);
        const float rf = (float)rev; rope[2 * i] = __builtin_amdgcn_cosf(rf); rope[2 * i + 1] = __builtin_amdgcn_sinf(rf); }
}
DI void norm_phase(const float* xp, const float* xs, float* xcopy, const float* gain, bf16_t* H, int gw, int NGW, int lane) {
    for (int m = gw; m < MPAD; m += NGW) {
        u32x2* ho = (u32x2*)(H + (size_t)m * 1024) + lane;
        if (m >= MTOK) {
#pragma unroll
            for (int j = 0; j < 4; ++j) { ho[64 * j] = (u32x2){0u, 0u}; if (xcopy) ((f32x4*)(xcopy + (size_t)m * 1024))[lane + 64 * j] = (f32x4){0.f, 0.f, 0.f, 0.f}; }
            continue;
        }
        const float* src = (xs && m >= MP) ? xs + (size_t)(m - MP) * 1024 : xp + (size_t)m * 1024;
        f32x4 v[4]; float ss = 0.f;
#pragma unroll
        for (int j = 0; j < 4; ++j) { v[j] = ((const f32x4*)src)[lane + 64 * j]; ss += (v[j].x * v[j].x + v[j].y * v[j].y) + (v[j].z * v[j].z + v[j].w * v[j].w); }
        const float rs = 1.0f / sqrtf(wave_sum(ss) * (1.f / 1024.f) + EPS);
#pragma unroll
        for (int j = 0; j < 4; ++j) { const f32x4 g = ((const f32x4*)gain)[lane + 64 * j];
            ho[64 * j] = (u32x2){pk2(v[j].x * rs * g.x, v[j].y * rs * g.y), pk2(v[j].z * rs * g.z, v[j].w * rs * g.w)};
            if (xcopy) ((f32x4*)(xcopy + (size_t)m * 1024))[lane + 64 * j] = v[j]; }
    }
}
DI void qk_phase(const Params& p, int l, int gw, int NGW, int lane) {
    bf16_t* ZG = (bf16_t*)(p.ws + WS_ZG); const float* rope = (const float*)(p.ws + WS_ROPE);
    const int sub = lane & 7, hh = lane >> 3;
    float gnv[4][8];
#pragma unroll
    for (int gi = 0; gi < 4; ++gi) {
        const float* gn = hh < 6 ? (gi == 0 ? p.in[I_QNA] + l * 64 : p.in[I_QNB] + (l * 3 + gi - 1) * 64) : (gi == 0 ? p.in[I_KNA] + l * 64 : p.in[I_KNB] + (l * 3 + gi - 1) * 64);
        const f32x4 g0 = *(const f32x4*)(gn + sub * 8), g1 = *(const f32x4*)(gn + sub * 8 + 4);
#pragma unroll
        for (int e = 0; e < 4; ++e) { gnv[gi][e] = g0[e]; gnv[gi][4 + e] = g1[e]; }
    }
    u32x4 nxt[4];
    if (gw < MTOK) {
#pragma unroll
        for (int gi = 0; gi < 4; ++gi) nxt[gi] = *(const u32x4*)(ZG + (size_t)gw * ZLD + gi * 640 + lane * 8);
    }
    for (int m = gw; m < MTOK; m += NGW) {
        const bool samp = m >= MP; const int b = samp ? m - MP : m >> 11, t = samp ? 0 : (m & 2047);
        const float* rp = rope + (samp ? 2048 : t) * 16;
        bf16_t* zrow = ZG + (size_t)m * ZLD;
        u32x4 cur[4];
#pragma unroll
        for (int gi = 0; gi < 4; ++gi) cur[gi] = nxt[gi];
        if (m + NGW < MTOK) {
#pragma unroll
            for (int gi = 0; gi < 4; ++gi) nxt[gi] = *(const u32x4*)(ZG + (size_t)(m + NGW) * ZLD + gi * 640 + lane * 8);
        }
        f32x4 rc0, rc1, rc2, rc3;
        if (sub < 2) { rc0 = *(const f32x4*)rp; rc1 = *(const f32x4*)(rp + 4); rc2 = *(const f32x4*)(rp + 8); rc3 = *(const f32x4*)(rp + 12); }
#pragma unroll
        for (int gi = 0; gi < 4; ++gi) {
            const int W = gi == 0 ? 128 : (gi == 1 ? 128 : (gi == 2 ? 512 : 2048));
            const size_t obase_p = gi == 0 ? O_AP : (gi == 1 ? O_B1P : (gi == 2 ? O_B2P : O_B3P)), obase_s = gi == 0 ? O_AS : (gi == 1 ? O_B1S : (gi == 2 ? O_B2S : O_B3S));
            float x[8]; unpack8(cur[gi], x);
            float ss = 0.f;
#pragma unroll
            for (int e = 0; e < 8; ++e) ss += x[e] * x[e];
            ss += __shfl_xor(ss, 1); ss += __shfl_xor(ss, 2); ss += __shfl_xor(ss, 4);
            const float rs = 1.0f / sqrtf(ss * (1.f / 64.f) + EPS);
#pragma unroll
            for (int e = 0; e < 8; ++e) x[e] = x[e] * rs * gnv[gi][e];
            float y[8];
#pragma unroll
            for (int e = 0; e < 8; ++e) y[e] = __shfl_xor(x[e], 1);
            if (sub < 2) {
                const float cs[16] = {rc0[0], rc0[1], rc0[2], rc0[3], rc1[0], rc1[1], rc1[2], rc1[3], rc2[0], rc2[1], rc2[2], rc2[3], rc3[0], rc3[1], rc3[2], rc3[3]};
#pragma unroll
                for (int e = 0; e < 8; ++e) { const float c = cs[2 * e], s = cs[2 * e + 1]; x[e] = sub == 0 ? x[e] * c - y[e] * s : x[e] * c + y[e] * s; }
            }
            *(u32x4*)(zrow + gi * 640 + lane * 8) = pack8(x);
            const int jrow = samp ? W - 1 : t - (2048 - W);
            const size_t cb = samp ? obase_s + ((size_t)(l * 128 + b) * 2) * W * 128 : obase_p + ((size_t)(l * 16 + b) * 2) * W * 128;
            if (jrow >= 0) {
                if (hh >= 6) { float* d = p.out + cb + (size_t)jrow * 128 + (hh - 6) * 64 + sub * 8; *(f32x4*)d = (f32x4){x[0], x[1], x[2], x[3]}; *(f32x4*)(d + 4) = (f32x4){x[4], x[5], x[6], x[7]}; }
                if (lane < 16) { float v[8]; unpack8(*(const u32x4*)(zrow + gi * 640 + 512 + lane * 8), v);
                    float* d = p.out + cb + (size_t)(W + jrow) * 128 + lane * 8; *(f32x4*)d = (f32x4){v[0], v[1], v[2], v[3]}; *(f32x4*)(d + 4) = (f32x4){v[4], v[5], v[6], v[7]}; }
            }
        }
        if (lane < 48 && (samp || t >= 2046)) {
            float gc[8], xc[8]; unpack8(*(const u32x4*)(zrow + 2944 + lane * 8), gc); unpack8(*(const u32x4*)(zrow + 3328 + lane * 8), xc);
            f32x4 z0 = (f32x4){gc[0] * xc[0], gc[1] * xc[1], gc[2] * xc[2], gc[3] * xc[3]}, z1 = (f32x4){gc[4] * xc[4], gc[5] * xc[5], gc[6] * xc[6], gc[7] * xc[7]};
            if (samp) {
                float* d = p.out + O_CS + ((size_t)(l * 128 + b) * 2) * BW + lane * 8; const float* s1 = p.in[I_SC] + ((size_t)(l * 128 + b) * 2 + 1) * BW + lane * 8;
                *(f32x4*)d = *(const f32x4*)s1; *(f32x4*)(d + 4) = *(const f32x4*)(s1 + 4); *(f32x4*)(d + BW) = z0; *(f32x4*)(d + BW + 4) = z1;
                float vd[8]; unpack8(*(const u32x4*)(zrow + 4096 + lane * 8), vd); float* dd = p.out + O_DS + (size_t)(l * 128 + b) * BW + lane * 8;
                *(f32x4*)dd = (f32x4){vd[0], vd[1], vd[2], vd[3]}; *(f32x4*)(dd + 4) = (f32x4){vd[4], vd[5], vd[6], vd[7]};
            } else { float* d = p.out + O_CP + ((size_t)(l * 16 + b) * 2 + (t - 2046)) * BW + lane * 8; *(f32x4*)d = z0; *(f32x4*)(d + 4) = z1; }
        }
    }
}
DI bf16x8 vt_frag(LAS unsigned char* img, int rowbase0, int tstep, int cc, int lane) {
    const int q = (lane & 15) >> 2, p4 = lane & 3, blk = (lane >> 4) & 1;
    const int colb = (32 * cc + 16 * blk + 4 * p4) * 2;
    const s16x4 lo = __builtin_amdgcn_ds_read_tr16_b64_v4i16((LAS s16x4*)(img + (rowbase0 + q) * 144 + colb));
    const s16x4 hi = __builtin_amdgcn_ds_read_tr16_b64_v4i16((LAS s16x4*)(img + (rowbase0 + tstep + q) * 144 + colb));
    return __builtin_shufflevector(lo, hi, 0, 1, 2, 3, 4, 5, 6, 7);
}
DI void attn_unit(LAS unsigned char* qimg, LAS unsigned char* img, const bf16_t* ZG, int tok0, int dil, int qb, int gi, int kvh, bf16_t* Obuf, int ostr, float* lse_out, const float* sink, int lane) {
    const int r = lane & 31, h = lane >> 5;
    const int colq = gi * 640 + kvh * 192, colk = gi * 640 + 384 + kvh * 64, colv = gi * 640 + 512 + kvh * 64;
    const int tq = tok0 + dil * (32 * qb + r);
    const bf16_t* qrow = ZG + (size_t)tq * ZLD + colq + 32 * h;
    {
        bf16x8 qv[12];
#pragma unroll
        for (int i = 0; i < 12; ++i) qv[i] = *(const bf16x8*)(qrow + (i >> 2) * 64 + 8 * (i & 3));
#pragma unroll
        for (int i = 0; i < 12; ++i) *(LAS bf16x8*)(qimg + i * 1024 + lane * 16) = qv[i];
    }
    f32x16 o[3][2]; float mrun[3], lrun[3];
#pragma unroll
    for (int g = 0; g < 3; ++g) { mrun[g] = -1e30f; lrun[g] = 0.f;
#pragma unroll
        for (int i = 0; i < 16; ++i) { o[g][0][i] = 0.f; o[g][1][i] = 0.f; } }
    const float SC = 0.125f * LOG2E;
    const int c0 = qb >= 4 ? 0 : 4 - qb;
    bf16x8 kf[4], vv[4];
    { const bf16_t* krow = ZG + (size_t)(tok0 + dil * (32 * (qb - 4 + c0) + r)) * ZLD + 32 * h;
#pragma unroll
      for (int ks = 0; ks < 4; ++ks) { kf[ks] = *(const bf16x8*)(krow + colk + 8 * ks); vv[ks] = *(const bf16x8*)(krow + colv + 8 * ks); } }
    for (int c = c0; c < 5; ++c) {
#pragma unroll
        for (int ks = 0; ks < 4; ++ks) *(LAS bf16x8*)(img + r * 144 + 64 * h + 16 * ks) = vv[ks];
        bf16x8 kc[4];
#pragma unroll
        for (int ks = 0; ks < 4; ++ks) kc[ks] = kf[ks];
        if (c < 4) {
            const bf16_t* krow = ZG + (size_t)(tok0 + dil * (32 * (qb - 3 + c) + r)) * ZLD + 32 * h;
#pragma unroll
            for (int ks = 0; ks < 4; ++ks) { kf[ks] = *(const bf16x8*)(krow + colk + 8 * ks); vv[ks] = *(const bf16x8*)(krow + colv + 8 * ks); }
        }
        bf16x8 vf[2][2];
#pragma unroll
        for (int s = 0; s < 2; ++s)
#pragma unroll
            for (int cc = 0; cc < 2; ++cc) vf[s][cc] = vt_frag(img, 16 * s + 4 * h, 8, cc, lane);
#pragma unroll
        for (int g = 0; g < 3; ++g) {
            f32x16 s;
#pragma unroll
            for (int i = 0; i < 16; ++i) s[i] = 0.f;
#pragma unroll
            for (int ks = 0; ks < 4; ++ks) s = MFMA32(kc[ks], *(const LAS bf16x8*)(qimg + (g * 4 + ks) * 1024 + lane * 16), s);
            float t[16]; float mx = -1e30f;
#pragma unroll
            for (int i = 0; i < 16; ++i) { const int cr = crow(i, h); const bool valid = c == 0 ? (cr >= r) : (c == 4 ? (cr <= r) : true); t[i] = valid ? s[i] * SC : -1e30f; mx = fmaxf(mx, t[i]); }
            mx = fmaxf(mx, __shfl_xor(mx, 32));
            const float mnew = fmaxf(mrun[g], mx), alpha = ex2(mrun[g] - mnew);
            float rsum = 0.f;
#pragma unroll
            for (int i = 0; i < 16; ++i) { t[i] = ex2(t[i] - mnew); rsum += t[i]; }
            rsum += __shfl_xor(rsum, 32);
            lrun[g] = lrun[g] * alpha + rsum; mrun[g] = mnew;
#pragma unroll
            for (int i = 0; i < 16; ++i) { o[g][0][i] *= alpha; o[g][1][i] *= alpha; }
#pragma unroll
            for (int s2 = 0; s2 < 2; ++s2) {
                u32x4 pw; pw.x = pk2(t[8 * s2], t[8 * s2 + 1]); pw.y = pk2(t[8 * s2 + 2], t[8 * s2 + 3]); pw.z = pk2(t[8 * s2 + 4], t[8 * s2 + 5]); pw.w = pk2(t[8 * s2 + 6], t[8 * s2 + 7]);
                const bf16x8 pf = __builtin_bit_cast(bf16x8, pw);
                o[g][0] = MFMA32(vf[s2][0], pf, o[g][0]); o[g][1] = MFMA32(vf[s2][1], pf, o[g][1]);
            }
        }
    }
#pragma unroll
    for (int g = 0; g < 3; ++g) {
        const int head = kvh * 3 + g; float lsum = lrun[g];
        if (sink) lsum += ex2(sink[head] * LOG2E - mrun[g]);
        const float inv = 1.0f / lsum;
        bf16_t* orow = Obuf + (size_t)tq * ostr + head * 64 + 4 * h;
#pragma unroll
        for (int cc = 0; cc < 2; ++cc)
#pragma unroll
            for (int q4 = 0; q4 < 4; ++q4) *(u32x2*)(orow + 32 * cc + 8 * q4) = (u32x2){pk2(o[g][cc][4 * q4] * inv, o[g][cc][4 * q4 + 1] * inv), pk2(o[g][cc][4 * q4 + 2] * inv, o[g][cc][4 * q4 + 3] * inv)};
        if (lse_out && h == 0) lse_out[(size_t)tq * 8 + head] = (mrun[g] + __builtin_amdgcn_logf(lsum)) * LN2;
    }
}
DI void sattn_unit(const bf16_t* ZG, const float* cache, int W, int dil, int b, int gi, int hq, bf16_t* Obuf, int ostr, float* lse_out, const float* sink, int lane) {
    const int m = MP + b, kvh = hq / 3; const bf16_t* zrow = ZG + (size_t)m * ZLD + gi * 640;
    const bf16_t* qp = zrow + hq * 64;
    const float* Kc = cache + ((size_t)(b * 2 + 0) * W) * 128 + kvh * 64;
    const float* Vc = cache + ((size_t)(b * 2 + 1) * W) * 128 + kvh * 64;
    const float* k0 = Kc + (size_t)(W - (1 + lane) * dil) * 128; const float* k1 = Kc + (size_t)(W - (65 + lane) * dil) * 128;
    float s0 = 0.f, s1 = 0.f, s2 = 0.f;
#pragma unroll 2
    for (int d8 = 0; d8 < 8; ++d8) {
        float q[8], kn[8]; unpack8(*(const u32x4*)(qp + 8 * d8), q); unpack8(*(const u32x4*)(zrow + 384 + kvh * 64 + 8 * d8), kn);
        const f32x4 a0 = *(const f32x4*)(k0 + 8 * d8), a1 = *(const f32x4*)(k0 + 8 * d8 + 4), b0 = *(const f32x4*)(k1 + 8 * d8), b1 = *(const f32x4*)(k1 + 8 * d8 + 4);
#pragma unroll
        for (int e = 0; e < 4; ++e) { s0 += q[e] * a0[e] + q[4 + e] * a1[e]; s1 += q[e] * b0[e] + q[4 + e] * b1[e]; s2 += q[e] * kn[e] + q[4 + e] * kn[4 + e]; }
    }
    s0 *= 0.125f; s1 *= 0.125f; s2 *= 0.125f;
    const float mx = fmaxf(wave_max(fmaxf(s0, s1)), s2);
    const float p0 = __expf(s0 - mx), p1 = __expf(s1 - mx), p2 = __expf(s2 - mx);
    float lsum = wave_sum(p0 + p1) + p2;
    if (sink) lsum += __expf(sink[hq] - mx);
    float acc = p2 * bf1(zrow[512 + kvh * 64 + lane]);
    for (int n0 = 1; n0 <= 64; n0 += 8) {
        float va[8], vb[8];
#pragma unroll
        for (int j = 0; j < 8; ++j) { va[j] = Vc[(size_t)(W - (n0 + j) * dil) * 128 + lane]; vb[j] = Vc[(size_t)(W - (n0 + j + 64) * dil) * 128 + lane]; }
#pragma unroll
        for (int j = 0; j < 8; ++j) acc += __shfl(p0, n0 + j - 1) * va[j] + __shfl(p1, n0 + j - 1) * vb[j];
    }
    Obuf[(size_t)m * ostr + hq * 64 + lane] = (bf16_t)(pk2(acc / lsum, 0.f) & 0xffffu);
    if (lse_out && lane == 0) lse_out[(size_t)m * 8 + hq] = mx + __logf(lsum);
}
DI void sg_unit(LAS unsigned char* img, const bf16_t* ZG, const bf16_t* Wm, const float* bs, int T0, int g, int ib, bf16_t* Od, int ostr, int lane) {
    const int r = lane & 31, h = lane >> 5;
    f32x16 acc[2];
#pragma unroll
    for (int i = 0; i < 16; ++i) { acc[0][i] = 0.f; acc[1][i] = 0.f; }
    const bf16_t* wrow = Wm + ((size_t)g * 128 + 32 * ib + r) * 128 + 8 * h;
    for (int jc = 0; jc <= ib; ++jc) {
        const bf16_t* vrow = ZG + (size_t)(T0 + 32 * jc + r) * ZLD + 4096 + g * 64 + 32 * h;
#pragma unroll
        for (int ks = 0; ks < 4; ++ks) { const bf16x8 vv = *(const bf16x8*)(vrow + 8 * ks); *(LAS bf16x8*)(img + r * 144 + 64 * h + 16 * ks) = vv; }
#pragma unroll
        for (int s = 0; s < 2; ++s) {
            const bf16x8 wf = *(const bf16x8*)(wrow + 32 * jc + 16 * s);
            acc[0] = MFMA32(vt_frag(img, 16 * s + 8 * h, 4, 0, lane), wf, acc[0]);
            acc[1] = MFMA32(vt_frag(img, 16 * s + 8 * h, 4, 1, lane), wf, acc[1]);
        }
    }
    const int tok = T0 + 32 * ib + r; const float bias = bs[g * 128 + 32 * ib + r];
    const bf16_t* urow = ZG + (size_t)tok * ZLD + 3712 + g * 64 + 4 * h; bf16_t* orow = Od + (size_t)tok * ostr + g * 64 + 4 * h;
#pragma unroll
    for (int cc = 0; cc < 2; ++cc)
#pragma unroll
        for (int q4 = 0; q4 < 4; ++q4) { const u32x2 uw = *(const u32x2*)(urow + 32 * cc + 8 * q4);
            *(u32x2*)(orow + 32 * cc + 8 * q4) = (u32x2){pk2(bflo(uw.x) * (acc[cc][4 * q4] + bias), bfhi(uw.x) * (acc[cc][4 * q4 + 1] + bias)), pk2(bflo(uw.y) * (acc[cc][4 * q4 + 2] + bias), bfhi(uw.y) * (acc[cc][4 * q4 + 3] + bias))}; }
}

#ifndef NAIVE_ATTN
#define NAIVE_ATTN 0
#endif
#ifndef NAIVE_SG
#define NAIVE_SG 0
#endif
DI void naive_attn_phase(const Params& p, int l, int gt, int NT) {
    const bf16_t* ZG = (const bf16_t*)(p.ws + WS_ZG); bf16_t* BR = (bf16_t*)(p.ws + WS_BR); bf16_t* OB = (bf16_t*)(p.ws + WS_OB); float* LSE = (float*)(p.ws + WS_LSE);
    const int sub = gt & 3;
    for (int it = gt >> 2; it < MP * 24; it += NT >> 2) {
        const int m = it / 24, rem = it % 24, hq = rem % 6, gi = rem / 6, t = m & 2047, dil = gi < 2 ? 1 : (gi == 2 ? 4 : 16), kvh = hq / 3;
        float q[16], acc[16];
        { float a[8], b[8]; const bf16_t* qp = ZG + (size_t)m * ZLD + gi * 640 + hq * 64 + sub * 16; unpack8(*(const u32x4*)qp, a); unpack8(*(const u32x4*)(qp + 8), b);
#pragma unroll
          for (int e = 0; e < 8; ++e) { q[e] = a[e]; q[8 + e] = b[e]; acc[e] = 0.f; acc[8 + e] = 0.f; } }
        float mx = -1e30f, ls = 0.f;
        for (int n = 0; n <= 128; ++n) {
            if (t - n * dil < 0) break;
            const bf16_t* kp = ZG + (size_t)(m - n * dil) * ZLD + gi * 640 + 384 + kvh * 64 + sub * 16;
            float a[8], b[8]; unpack8(*(const u32x4*)kp, a); unpack8(*(const u32x4*)(kp + 8), b);
            float d = 0.f;
#pragma unroll
            for (int e = 0; e < 8; ++e) d += q[e] * a[e] + q[8 + e] * b[e];
            d += __shfl_xor(d, 1); d += __shfl_xor(d, 2); d *= 0.125f;
            const float mn = fmaxf(mx, d), al = __expf(mx - mn), pe = __expf(d - mn);
            unpack8(*(const u32x4*)(kp + 128), a); unpack8(*(const u32x4*)(kp + 136), b);
#pragma unroll
            for (int e = 0; e < 8; ++e) { acc[e] = acc[e] * al + pe * a[e]; acc[8 + e] = acc[8 + e] * al + pe * b[e]; }
            ls = ls * al + pe; mx = mn;
        }
        if (gi == 0) ls += __expf(p.in[I_SINK][l * 6 + hq] - mx);
        const float inv = 1.0f / ls; float o[8], o2[8];
#pragma unroll
        for (int e = 0; e < 8; ++e) { o[e] = acc[e] * inv; o2[e] = acc[8 + e] * inv; }
        bf16_t* op = (gi == 0 ? BR : OB + (size_t)(gi - 1) * MPAD * BW) + (size_t)m * BW + hq * 64 + sub * 16;
        *(u32x4*)op = pack8(o); *(u32x4*)(op + 8) = pack8(o2);
        if (gi > 0 && sub == 0) LSE[(size_t)(gi - 1) * MPAD * 8 + (size_t)m * 8 + hq] = mx + __logf(ls);
    }
}
DI void naive_sg_phase(const Params& p, int l, int gt, int NT) {
    const bf16_t* ZG = (const bf16_t*)(p.ws + WS_ZG); bf16_t* BR = (bf16_t*)(p.ws + WS_BR);
    for (int it = gt; it < MP * 48; it += NT) {
        const int m = it / 48, c0 = (it % 48) * 8, g = c0 >> 6, i = m & 127, T0 = m - i;
        float sv[8];
#pragma unroll
        for (int e = 0; e < 8; ++e) sv[e] = 0.f;
        const float* wr = p.in[I_WSD] + ((size_t)(l * 6 + g) * 128 + i) * 128;
        for (int j = 0; j <= i; ++j) { float v[8]; unpack8(*(const u32x4*)(ZG + (size_t)(T0 + j) * ZLD + 4096 + c0), v); const float w = wr[j];
#pragma unroll
            for (int e = 0; e < 8; ++e) sv[e] += w * v[e]; }
        float u[8], o[8]; unpack8(*(const u32x4*)(ZG + (size_t)m * ZLD + 3712 + c0), u); const float bias = p.in[I_BSD][l * 768 + g * 128 + i];
#pragma unroll
        for (int e = 0; e < 8; ++e) o[e] = u[e] * (sv[e] + bias);
        *(u32x4*)(BR + 3ull * MPAD * BW + (size_t)m * BW + c0) = pack8(o);
    }
}
constexpr int CP_A = 256 * 32 * 127, CP_B2 = 256 * 32 * 511, CP_B3 = 256 * 32 * 2047, CP_T0 = CP_A, CP_T1 = 2 * CP_A, CP_T2 = CP_T1 + CP_B2, CP_T3 = CP_T2 + CP_B3, CP_NCH = CP_T3 / 64;
static_assert(CP_T3 % 64 == 0, "copy chunks");
DI void cp_decode(const Params& p, int l, int i, const float*& src, float*& dst) {
    if (i < CP_T0) { const int seg = i / (32 * 127), off = i % (32 * 127); const size_t base = ((size_t)l * 256 + seg) * 128 * 128; src = p.in[I_CA] + base + 128 + (size_t)off * 4; dst = p.out + O_AS + base + (size_t)off * 4; }
    else if (i < CP_T1) { i -= CP_T0; const int seg = i / (32 * 127), off = i % (32 * 127); const size_t base = ((size_t)l * 256 + seg) * 128 * 128; src = p.in[I_CB1] + base + 128 + (size_t)off * 4; dst = p.out + O_B1S + base + (size_t)off * 4; }
    else if (i < CP_T2) { i -= CP_T1; const int seg = i / (32 * 511), off = i % (32 * 511); const size_t base = ((size_t)l * 256 + seg) * 512 * 128; src = p.in[I_CB2] + base + 128 + (size_t)off * 4; dst = p.out + O_B2S + base + (size_t)off * 4; }
    else { i -= CP_T2; const int seg = i / (32 * 2047), off = i % (32 * 2047); const size_t base = ((size_t)l * 256 + seg) * 2048 * 128; src = p.in[I_CB3] + base + 128 + (size_t)off * 4; dst = p.out + O_B3S + base + (size_t)off * 4; }
}
constexpr int CP_NSL = 4;
DI void copy_slice(const Params& p, int l, int s, int gw, int NGW, int lane) {
    for (int c0 = s * NGW + gw; c0 < CP_NCH; c0 += 8 * CP_NSL * NGW) {
        f32x4 v[8]; float* dst[8]; bool ok[8];
#pragma unroll
        for (int q = 0; q < 8; ++q) { const int cid = c0 + q * CP_NSL * NGW; ok[q] = cid < CP_NCH; dst[q] = nullptr; v[q] = (f32x4){0.f, 0.f, 0.f, 0.f};
            if (ok[q]) { const float* src; cp_decode(p, l, cid * 64 + lane, src, dst[q]); v[q] = __builtin_nontemporal_load((const f32x4*)src); } }
#pragma unroll
        for (int q = 0; q < 8; ++q) if (ok[q]) __builtin_nontemporal_store(v[q], (f32x4*)dst[q]);
    }
}
DI void copy_all(const Params& p, int l, int cpw, int NCPW, int lane) {
    for (int c0 = cpw; c0 < CP_NCH; c0 += 16 * NCPW) {
        f32x4 v[16]; float* dst[16];
#pragma unroll
        for (int q = 0; q < 16; ++q) { const int cid = c0 + q * NCPW; dst[q] = nullptr; v[q] = (f32x4){0.f, 0.f, 0.f, 0.f};
            if (cid < CP_NCH) { const float* src; cp_decode(p, l, cid * 64 + lane, src, dst[q]); v[q] = __builtin_nontemporal_load((const f32x4*)src); } }
#pragma unroll
        for (int q = 0; q < 16; ++q) if (dst[q]) __builtin_nontemporal_store(v[q], (f32x4*)dst[q]);
    }
}
DI void mixer_phase(const Params& p, LAS unsigned char* lds, int l, int gw, int NGW, int wave, int lane, int gt, int NT) {
    const bf16_t* ZG = (const bf16_t*)(p.ws + WS_ZG);
    bf16_t* BR = (bf16_t*)(p.ws + WS_BR); bf16_t* OB = (bf16_t*)(p.ws + WS_OB); float* LSE = (float*)(p.ws + WS_LSE);
    LAS unsigned char* qimg = lds + wave * 16896; LAS unsigned char* img = qimg + 12288;
    const int bid_ = gw >> 3, G_ = NGW >> 3;
    if (wave >= 6) { copy_all(p, l, bid_ * 2 + (wave - 6), G_ * 2, lane); return; }
    gw = bid_ * 6 + wave; NGW = G_ * 6; gt = bid_ * 384 + wave * 64 + lane; NT = G_ * 384;
#ifndef MIX_REP
#define MIX_REP 0
#endif
    for (int rep_ = 0; rep_ < ((MIX_REP & 1) ? 2 : 1); ++rep_)
    for (int u = gw; u < 8192; u += NGW) {
        const int gi = u >> 11, rem = u & 2047; const int ld = gi < 2 ? 0 : (gi == 2 ? 2 : 4), dil = 1 << ld, lnqb = 6 - ld;
        const int qb = rem & ((1 << lnqb) - 1), rem2 = rem >> lnqb, res = rem2 & (dil - 1), rem3 = rem2 >> ld, kvh = rem3 & 1, b = rem3 >> 1;
        attn_unit(qimg, img, ZG, b * 2048 + res, dil, qb, gi, kvh, gi == 0 ? BR : OB + (size_t)(gi - 1) * MPAD * BW, gi == 0 ? 4 * BW : BW, gi == 0 ? nullptr : LSE + (size_t)(gi - 1) * MPAD * 8, gi == 0 ? p.in[I_SINK] + l * 6 : nullptr, lane);
    }
    const bf16_t* Wm = (const bf16_t*)(p.ws + WS_WM) + (size_t)l * 6 * 128 * 128;
#if 0
#else
    for (int rep_ = 0; rep_ < ((MIX_REP & 2) ? 2 : 1); ++rep_)
    for (int u = gw; u < 6144; u += NGW) { const int ib = u & 3, g = (u >> 2) % 6, ch = u / 24; sg_unit(img, ZG, Wm, p.in[I_BSD] + l * 768, ch * 128, g, ib, BR + 3 * BW, 4 * BW, lane); }
#endif
    for (int rep_ = 0; rep_ < ((MIX_REP & 4) ? 2 : 1); ++rep_)
    for (int u = gw; u < 3072; u += NGW) {
        const int hq = u % 6, gi = (u / 6) & 3, b = u / 24; const int W = gi < 2 ? 128 : (gi == 2 ? 512 : 2048), dil = gi < 2 ? 1 : (gi == 2 ? 4 : 16);
        const float* cache = (gi == 0 ? p.in[I_CA] : (gi == 1 ? p.in[I_CB1] : (gi == 2 ? p.in[I_CB2] : p.in[I_CB3]))) + (size_t)l * 256 * W * 128;
        sattn_unit(ZG, cache, W, dil, b, gi, hq, gi == 0 ? BR : OB + (size_t)(gi - 1) * MPAD * BW, gi == 0 ? 4 * BW : BW, gi == 0 ? nullptr : LSE + (size_t)(gi - 1) * MPAD * 8, gi == 0 ? p.in[I_SINK] + l * 6 : nullptr, lane);
    }
    const float* cw = p.in[I_CONV] + l * 3 * BW;
    for (int it = gt; it < (MP / 16) * 48; it += NT) {
        const int run = it / 48, c0 = (it % 48) * 8, m0 = run * 16, t0 = m0 & 2047;
        float w0[8], w1[8], w2[8], z1[8], z2[8];
#pragma unroll
        for (int e = 0; e < 8; ++e) { w0[e] = cw[c0 + e]; w1[e] = cw[BW + c0 + e]; w2[e] = cw[2 * BW + c0 + e]; z1[e] = 0.f; z2[e] = 0.f; }
        if (t0 >= 2) { float a[8], bb[8]; const bf16_t* zr = ZG + (size_t)(m0 - 1) * ZLD;
            unpack8(*(const u32x4*)(zr + 2944 + c0), a); unpack8(*(const u32x4*)(zr + 3328 + c0), bb);
#pragma unroll
            for (int e = 0; e < 8; ++e) z1[e] = a[e] * bb[e];
            unpack8(*(const u32x4*)(zr - ZLD + 2944 + c0), a); unpack8(*(const u32x4*)(zr - ZLD + 3328 + c0), bb);
#pragma unroll
            for (int e = 0; e < 8; ++e) z2[e] = a[e] * bb[e]; }
        for (int b4 = 0; b4 < 4; ++b4) {
            u32x4 rb[4], rc[4], rx[4];
#pragma unroll
            for (int j = 0; j < 4; ++j) { const bf16_t* zr = ZG + (size_t)(m0 + 4 * b4 + j) * ZLD; rb[j] = *(const u32x4*)(zr + 2560 + c0); rc[j] = *(const u32x4*)(zr + 2944 + c0); rx[j] = *(const u32x4*)(zr + 3328 + c0); }
#pragma unroll
            for (int j = 0; j < 4; ++j) {
                const int m = m0 + 4 * b4 + j, t = t0 + 4 * b4 + j;
                float gb[8], gc[8], xc[8], zc[8], oc[8]; unpack8(rb[j], gb); unpack8(rc[j], gc); unpack8(rx[j], xc);
#pragma unroll
                for (int e = 0; e < 8; ++e) { zc[e] = gc[e] * xc[e]; oc[e] = gb[e] * (w0[e] * z2[e] + w1[e] * z1[e] + w2[e] * zc[e]); z2[e] = z1[e]; z1[e] = zc[e]; }
                *(u32x4*)(BR + (size_t)m * (4 * BW) + 2 * BW + c0) = pack8(oc);
                if (t >= 2046) { float* d = p.out + O_CP + ((size_t)(l * 16 + (m >> 11)) * 2 + (t - 2046)) * BW + c0; *(f32x4*)d = (f32x4){zc[0], zc[1], zc[2], zc[3]}; *(f32x4*)(d + 4) = (f32x4){zc[4], zc[5], zc[6], zc[7]}; }
            }
        }
    }
    for (int it = gt; it < MS * 48; it += NT) {
        const int b = it / 48, c0 = (it % 48) * 8, m = MP + b;
        const bf16_t* zrow = ZG + (size_t)m * ZLD;
        float gb[8], gc[8], xc[8], uu[8], vv[8], oc[8], od[8];
        unpack8(*(const u32x4*)(zrow + 2560 + c0), gb); unpack8(*(const u32x4*)(zrow + 2944 + c0), gc); unpack8(*(const u32x4*)(zrow + 3328 + c0), xc);
        unpack8(*(const u32x4*)(zrow + 3712 + c0), uu); unpack8(*(const u32x4*)(zrow + 4096 + c0), vv);
        const float* s = p.in[I_SC] + ((size_t)(l * 128 + b) * 2) * BW + c0;
        const int g = c0 >> 6; const float w00 = p.in[I_WSD][((size_t)l * 6 + g) * 16384], b0 = p.in[I_BSD][l * 768 + g * 128];
        float* dc = p.out + O_CS + ((size_t)(l * 128 + b) * 2) * BW + c0; float* dd = p.out + O_DS + (size_t)(l * 128 + b) * BW + c0;
#pragma unroll
        for (int e = 0; e < 8; ++e) { const float zc = gc[e] * xc[e]; oc[e] = gb[e] * (cw[c0 + e] * s[e] + cw[BW + c0 + e] * s[BW + e] + cw[2 * BW + c0 + e] * zc); od[e] = uu[e] * (w00 * vv[e] + b0);
            dc[e] = s[BW + e]; dc[BW + e] = zc; dd[e] = vv[e]; }
        *(u32x4*)(BR + (size_t)m * (4 * BW) + 2 * BW + c0) = pack8(oc);
        *(u32x4*)(BR + (size_t)m * (4 * BW) + 3 * BW + c0) = pack8(od);
    }
}
DI void merge_phase(const Params& p, int gt, int NT) {
    bf16_t* BR = (bf16_t*)(p.ws + WS_BR); const bf16_t* OB = (const bf16_t*)(p.ws + WS_OB); const float* LSE = (const float*)(p.ws + WS_LSE);
    for (int it = gt; it < MTOK * 48; it += NT) {
        const int m = it / 48, cch = it % 48, head = cch >> 3;
        const float l0 = LSE[(size_t)m * 8 + head], l1 = LSE[(size_t)MPAD * 8 + (size_t)m * 8 + head], l2 = LSE[2ull * MPAD * 8 + (size_t)m * 8 + head];
        const float mx = fmaxf(l0, fmaxf(l1, l2)); float w0 = __expf(l0 - mx), w1 = __expf(l1 - mx), w2 = __expf(l2 - mx); const float inv = 1.0f / (w0 + w1 + w2); w0 *= inv; w1 *= inv; w2 *= inv;
        float a[8], b[8], c[8], o[8];
        unpack8(*(const u32x4*)(OB + (size_t)m * BW + cch * 8), a); unpack8(*(const u32x4*)(OB + (size_t)MPAD * BW + (size_t)m * BW + cch * 8), b); unpack8(*(const u32x4*)(OB + 2ull * MPAD * BW + (size_t)m * BW + cch * 8), c);
#pragma unroll
        for (int e = 0; e < 8; ++e) o[e] = w0 * a[e] + w1 * b[e] + w2 * c[e];
        *(u32x4*)(BR + (size_t)m * (4 * BW) + BW + cch * 8) = pack8(o);
    }
}
constexpr int NPH = 20;
DI void grid_barrier(unsigned* bar, unsigned target, int wave_s) {
    __syncthreads();
    if (wave_s == 0) {
        if (__builtin_amdgcn_mbcnt_hi(~0u, __builtin_amdgcn_mbcnt_lo(~0u, 0u)) == 0u) {
            __builtin_amdgcn_fence(__ATOMIC_RELEASE, "agent");
            __hip_atomic_fetch_add(bar, 1u, __ATOMIC_RELAXED, __HIP_MEMORY_SCOPE_AGENT);
            while (__hip_atomic_load(bar, __ATOMIC_RELAXED, __HIP_MEMORY_SCOPE_AGENT) < target) __builtin_amdgcn_s_sleep(1);
        }
        __builtin_amdgcn_fence(__ATOMIC_ACQUIRE, "agent");
    }
    __syncthreads();
}
#ifndef DEBUG_CHK
#define DEBUG_CHK 0
#endif
#if DEBUG_CHK
DI const float* xin_row(const Params& p, int m) { return m < MP ? p.in[I_XP] + (size_t)m * 1024 : p.in[I_XS] + (size_t)(m - MP) * 1024; }
DI void dbg_phase(const Params& p, int kind_in, int gw, int NGW, int lane, int gt, int NT) {
    const int L = (kind_in >= 10 && kind_in < 20) ? 1 : 0, kind = kind_in == 99 ? 99 : kind_in - 10 * L;
    float* dbg = (float*)(p.ws + WS_BAR + 128);
    const bf16_t* ZG = (const bf16_t*)(p.ws + WS_ZG); const bf16_t* BR = (const bf16_t*)(p.ws + WS_BR); const bf16_t* MRG = (const bf16_t*)(p.ws + WS_MRG);
    const bf16_t* H = (const bf16_t*)(p.ws + WS_H); const bf16_t* ACT = (const bf16_t*)(p.ws + WS_ACT); const float* X = (const float*)(p.ws + WS_X);
    if (kind == 99) {
        int code = 0;
        for (int k = 1; k <= 7; ++k) if (code == 0 && dbg[k] > 1e-3f * dbg[8 + k]) code = k;
        if (code) { const float a = 1.0f + 0.1f * sqrtf((float)code); for (int i = gt; i < 98304; i += NT) p.out[O_DS + i] *= a; }
        return;
    }
    for (int s = gw; s < 16384; s += NGW) {
        const int m = MP + (int)(((unsigned)s * 2654435761u) % 128u), ci = s & 7; const unsigned hsh = (unsigned)s * 40503u + 12345u; float fast = 0.f, naive = 0.f;
        const float* xr = L ? X + (size_t)m * 1024 : xin_row(p, m);
        if (kind == 1) {
            int c = (int)(hsh % 8576u); if (c >= 4480) c += 128;
            float ss = 0.f; for (int k = lane; k < 1024; k += 64) ss += xr[k] * xr[k];
            const float rs = 1.0f / sqrtf(wave_sum(ss) * (1.f / 1024.f) + EPS); float acc = 0.f;
            for (int k = lane; k < 1024; k += 64) { const float hv = xr[k] * rs * p.in[I_LN1][L * 1024 + k];
                acc += hv * (c < GOFF ? p.in[I_WIN][(size_t)L * 1024 * 4480 + (size_t)k * 4480 + c] : p.in[I_WG][(size_t)L * 4 * 1048576 + ((size_t)((c - GOFF) >> 10) * 1024 + k) * 1024 + ((c - GOFF) & 1023)]); }
            acc = wave_sum(acc); naive = c < GOFF ? acc : 1.0f / (1.0f + __expf(-(acc + p.in[I_BG][L * 4096 + c - GOFF])));
            fast = bf1(ZG[(size_t)m * ZLD + c]);
        } else if (kind == 2 || kind == 3 || kind == 6) {
            const int c = (int)(hsh & 1023u);
            float v = 0.f;
            if (kind == 2) {
                for (int n = 0; n < 4; ++n) { float acc = 0.f; for (int k = lane; k < 384; k += 64) acc += bf1(BR[((size_t)n * MPAD + m) * BW + k]) * p.in[I_WB][(size_t)L * 4 * 384 * 1024 + ((size_t)n * 384 + k) * 1024 + c];
                    v += bf1(ZG[(size_t)m * ZLD + GOFF + n * 1024 + c]) * wave_sum(acc); }
                naive = v; fast = bf1(MRG[(size_t)m * 1024 + c]);
            } else {
                float acc = 0.f; for (int k = lane; k < 1024; k += 64) acc += bf1(MRG[(size_t)m * 1024 + k]) * p.in[I_WO][(size_t)k * 1024 + c];
                v = xr[c] + wave_sum(acc);
                if (kind == 6) { float a2 = 0.f; for (int k = lane; k < DFF; k += 64) a2 += bf1(ACT[(size_t)m * DFF + k]) * p.in[I_WFO][(size_t)k * 1024 + c]; v += wave_sum(a2); }
                naive = v; fast = X[(size_t)m * 1024 + c];
            }
        } else if (kind == 7) {
            const int hs = (int)(hsh & 31u), gi = hs >> 3, hh = hs & 7, col0 = gi * 640 + hh * 64;
            float ss = 0.f; for (int k = lane; k < 1024; k += 64) ss += xr[k] * xr[k];
            const float rs = 1.0f / sqrtf(wave_sum(ss) * (1.f / 1024.f) + EPS); float z = 0.f;
            for (int k = 0; k < 1024; ++k) z += xr[k] * rs * p.in[I_LN1][k] * p.in[I_WIN][(size_t)k * 4480 + col0 + lane];
            const float r2 = 1.0f / sqrtf(wave_sum(z * z) * (1.f / 64.f) + EPS);
            const float* gn = hh < 6 ? (gi == 0 ? p.in[I_QNA] : p.in[I_QNB] + (gi - 1) * 64) : (gi == 0 ? p.in[I_KNA] : p.in[I_KNB] + (gi - 1) * 64);
            float y = z * r2 * gn[lane];
            const float pos = m >= MP ? 16384.f : (float)(m & 2047); const float ang = pos * INV_FREQ[lane & 7];
            const float other = __shfl_xor(y, 8);
            if (lane < 8) y = y * cosf(ang) - other * sinf(ang); else if (lane < 16) y = y * cosf(ang) + other * sinf(ang);
            naive = y; fast = bf1(ZG[(size_t)m * ZLD + col0 + lane]);
            atomicAdd(&dbg[kind], (fast - naive) * (fast - naive)); atomicAdd(&dbg[8 + kind], naive * naive); continue;
        } else if (kind == 7 + 100) {
        } else if (kind == 9) {
            const int b = m - MP, hq = (int)(hsh % 6u), gi = (int)((hsh >> 8) & 3u), kvh = hq / 3, W = gi < 2 ? 128 : (gi == 2 ? 512 : 2048), dil = gi < 2 ? 1 : (gi == 2 ? 4 : 16);
            const float* cache = (gi == 0 ? p.in[I_CA] : (gi == 1 ? p.in[I_CB1] : (gi == 2 ? p.in[I_CB2] : p.in[I_CB3])));
            const float* Kc = cache + ((size_t)(b * 2 + 0) * W) * 128 + kvh * 64; const float* Vc = cache + ((size_t)(b * 2 + 1) * W) * 128 + kvh * 64;
            const bf16_t* zr = ZG + (size_t)m * ZLD + gi * 640; const bf16_t* qp = zr + hq * 64;
            float sc[3], pv[3]; float mx = -1e30f;
            for (int j = 0; j < 3; ++j) { const int n = j < 2 ? 1 + lane + 64 * j : 0; const bool ok = j < 2 || lane == 0; float dsum = 0.f;
                if (ok) { for (int e = 0; e < 64; ++e) dsum += bf1(qp[e]) * (n == 0 ? bf1(zr[384 + kvh * 64 + e]) : Kc[(size_t)(W - n * dil) * 128 + e]); }
                sc[j] = ok ? dsum * 0.125f : -1e30f; mx = fmaxf(mx, sc[j]); }
            mx = wave_max(mx); float ls = 0.f;
            for (int j = 0; j < 3; ++j) { pv[j] = sc[j] > -1e29f ? __expf(sc[j] - mx) : 0.f; ls += pv[j]; }
            ls = wave_sum(ls); if (gi == 0) ls += __expf(p.in[I_SINK][hq] - mx);
            const bf16_t* fo = (gi == 0 ? BR : (const bf16_t*)(p.ws + WS_OB) + (size_t)(gi - 1) * MPAD * BW) + (size_t)m * BW + hq * 64;
            for (int dd = 0; dd < 8; ++dd) { float a = 0.f;
                for (int j = 0; j < 3; ++j) { const int n = j < 2 ? 1 + lane + 64 * j : 0; if (pv[j] > 0.f) a += pv[j] * (n == 0 ? bf1(zr[512 + kvh * 64 + dd]) : Vc[(size_t)(W - n * dil) * 128 + dd]); }
                a = wave_sum(a) / ls; const float f = bf1(fo[dd]);
                if (lane == 0) { atomicAdd(&dbg[7], (f - a) * (f - a)); atomicAdd(&dbg[15], a * a); } }
            continue;
        } else if (kind == 8) {
            const int mm = (int)(((unsigned)s * 2654435761u) % (unsigned)MP), hq = (int)(hsh % 6u), gi = (int)((hsh >> 8) & 3u), t = mm & 2047, dil = gi < 2 ? 1 : (gi == 2 ? 4 : 16), kvh = hq / 3;
            const bf16_t* qp = ZG + (size_t)mm * ZLD + gi * 640 + hq * 64;
            float sc[3], pv[3]; float mx = -1e30f;
            for (int j = 0; j < 3; ++j) { const int n = j < 2 ? lane + 64 * j : 128; const bool ok = (j < 2 || lane == 0) && (t - n * dil >= 0); float dsum = 0.f;
                if (ok) { const bf16_t* kp = ZG + (size_t)(mm - n * dil) * ZLD + gi * 640 + 384 + kvh * 64; for (int e = 0; e < 64; ++e) dsum += bf1(qp[e]) * bf1(kp[e]); }
                sc[j] = ok ? dsum * 0.125f : -1e30f; mx = fmaxf(mx, sc[j]); }
            mx = wave_max(mx); float ls = 0.f;
            for (int j = 0; j < 3; ++j) { pv[j] = sc[j] > -1e29f ? __expf(sc[j] - mx) : 0.f; ls += pv[j]; }
            ls = wave_sum(ls); if (gi == 0) ls += __expf(p.in[I_SINK][hq] - mx);
            const bf16_t* fo = (gi == 0 ? BR : (const bf16_t*)(p.ws + WS_OB) + (size_t)(gi - 1) * MPAD * BW) + (size_t)mm * BW + hq * 64;
            for (int dd = 0; dd < 8; ++dd) { float a = 0.f;
                for (int j = 0; j < 3; ++j) { const int n = j < 2 ? lane + 64 * j : 128; if (pv[j] > 0.f) a += pv[j] * bf1(ZG[(size_t)(mm - n * dil) * ZLD + gi * 640 + 512 + kvh * 64 + dd]); }
                a = wave_sum(a) / ls; const float f = bf1(fo[dd]);
                if (lane == 0) { atomicAdd(&dbg[gi], (f - a) * (f - a)); atomicAdd(&dbg[8 + gi], a * a); } }
            if (gi > 0 && lane == 0) { const float lf = ((const float*)(p.ws + WS_LSE))[(size_t)(gi - 1) * MPAD * 8 + (size_t)mm * 8 + hq], ln = mx + __logf(ls); atomicAdd(&dbg[4], (lf - ln) * (lf - ln)); atomicAdd(&dbg[12], 1.0f); }
            continue;
        } else if (kind == 4) {
            const int c = (int)(hsh & 1023u); const float* xx = X + (size_t)m * 1024;
            float ss = 0.f; for (int k = lane; k < 1024; k += 64) ss += xx[k] * xx[k];
            const float rs = 1.0f / sqrtf(wave_sum(ss) * (1.f / 1024.f) + EPS); naive = xx[c] * rs * p.in[I_LN2][L * 1024 + c]; fast = bf1(H[(size_t)m * 1024 + c]);
        } else if (kind == 5) {
            const int c = (int)(hsh % 2816u);
            float a1 = 0.f, a2 = 0.f; for (int k = lane; k < 1024; k += 64) { const float hv = bf1(H[(size_t)m * 1024 + k]); a1 += hv * p.in[I_WFI][(size_t)L * 1024 * 5632 + (size_t)k * 5632 + c]; a2 += hv * p.in[I_WFI][(size_t)L * 1024 * 5632 + (size_t)k * 5632 + DFF + c]; }
            a1 = wave_sum(a1); a2 = wave_sum(a2); naive = a1 / (1.0f + __expf(-a1)) * a2; fast = bf1(ACT[(size_t)m * DFF + c]);
        }
        if (lane == 0) { atomicAdd(&dbg[kind], (fast - naive) * (fast - naive)); atomicAdd(&dbg[8 + kind], naive * naive); }
    }
}
#endif
template <int PH> DI void run_phase(const Params& p0, LAS unsigned char* lds, int wave_s) {
    Params p;
    { int z_ = 0; asm volatile("" : "+s"(z_));
#pragma unroll
      for (int i = 0; i < 24; ++i) p.in[i] = p0.in[i + z_];
      p.out = (&p0.out)[z_]; p.ws = (&p0.ws)[z_]; p.ph_lo = 0; p.ph_hi = 0; }
    int tid = wave_s * 64 + (int)__builtin_amdgcn_mbcnt_hi(~0u, __builtin_amdgcn_mbcnt_lo(~0u, 0u)); asm volatile("" : "+v"(tid));
    const int G = gridDim.x, bid = blockIdx.x, NGW = G * 8, NT = G * 512;
    const int lane = tid & 63, wave = wave_s, gw = bid * 8 + wave, gt = bid * 512 + tid;
    float* X = (float*)(p.ws + WS_X); bf16_t* H = (bf16_t*)(p.ws + WS_H); bf16_t* ZG = (bf16_t*)(p.ws + WS_ZG);
    if constexpr (PH == 0) {
        prologue_weights(p, lds, gw, NGW, wave, lane);
        prologue_misc(p, gt, NT);
        norm_phase(p.in[I_XP], p.in[I_XS], X, p.in[I_LN1], H, gw, NGW, lane);
    } else {
        constexpr int l = (PH - 1) / 10, k = (PH - 1) % 10;
        unsigned char* wl = p.ws + WS_W + (size_t)l * WL_B;
        const bf16_t* W1t = (const bf16_t*)wl; const bf16_t* Wbt = (const bf16_t*)(wl + W1_B); const bf16_t* Wot = (const bf16_t*)(wl + W1_B + WB_B);
        const bf16_t* Wft = (const bf16_t*)(wl + W1_B + WB_B + WO_B); const bf16_t* Wdt = (const bf16_t*)(wl + W1_B + WB_B + WO_B + WF_B);
        if constexpr (k == 0) {
            pg8::Gemm g{H, W1t, MPAD, ZLD, 1024}; pg8::StaticOrder S; S.init(MPAD, ZLD, G, bid);
            EpiZG E{ZG, p.in[I_BG] + (size_t)l * 4096, (const float*)(p.ws + WS_ROPE), p.in[I_QNA] + l * 64, p.in[I_KNA] + l * 64, p.in[I_QNB] + l * 192, p.in[I_KNB] + l * 192, p.out, l};
            pg8::gemm_phase<EpiZG, pg8::StaticOrder, PG8_ALIGN, PG8_SP2>(lds, g, S, E, tid);
        } else if constexpr (k == 1) {
        } else if constexpr (k == 2) {
            mixer_phase(p, lds, l, gw, NGW, wave, lane, gt, NT);
        } else if constexpr (k == 3) {
            merge_phase(p, gt, NT);
        } else if constexpr (k == 4) {
            pg8::Gemm g{(const bf16_t*)(p.ws + WS_BR), Wbt, MPAD, 1024, 4 * BW}; pg8::StaticOrder S; S.init(MPAD, 1024, G, bid);
            EpiBranch E{ZG, (bf16_t*)(p.ws + WS_MRG)};
            pg8::gemm_phase<EpiBranch, pg8::StaticOrder, PG8_ALIGN, PG8_SP2>(lds, g, S, E, tid);
        } else if constexpr (k == 5) {
            pg8::Gemm g{(const bf16_t*)(p.ws + WS_MRG), Wot, MPAD, 1024, 1024}; pg8::StaticOrder S; S.init(MPAD, 1024, G, bid);
            EpiResid E{X, X, MPAD};
            pg8::gemm_phase<EpiResid, pg8::StaticOrder, PG8_ALIGN, PG8_SP2>(lds, g, S, E, tid);
        } else if constexpr (k == 6) {
            norm_phase(X, nullptr, nullptr, p.in[I_LN2] + l * 1024, H, gw, NGW, lane);
        } else if constexpr (k == 7) {
            pg8::Gemm g{H, Wft, MPAD, 2 * DFF, 1024}; pg8::StaticOrder S; S.init(MPAD, 2 * DFF, G, bid);
            EpiSwiglu E{(bf16_t*)(p.ws + WS_ACT)};
            pg8::gemm_phase<EpiSwiglu, pg8::StaticOrder, PG8_ALIGN, PG8_SP2>(lds, g, S, E, tid);
        } else if constexpr (k == 8) {
            pg8::Gemm g{(const bf16_t*)(p.ws + WS_ACT), Wdt, MPAD, 1024, DFF}; pg8::StaticOrder S; S.init(MPAD, 1024, G, bid);
            EpiResid E{X, l == 1 ? p.out : X, l == 1 ? MTOK : MPAD};
            pg8::gemm_phase<EpiResid, pg8::StaticOrder, PG8_ALIGN, PG8_SP2>(lds, g, S, E, tid);
        } else {
            if constexpr (l == 0) norm_phase(X, nullptr, nullptr, p.in[I_LN1] + 1024, H, gw, NGW, lane);
        }
    }
}
__global__ void __launch_bounds__(512, 2) fwd_kernel(Params p) {
    extern __shared__ __attribute__((aligned(16))) unsigned char lds_raw[];
    LAS unsigned char* lds = (LAS unsigned char*)lds_raw;
    const int wave_s = __builtin_amdgcn_readfirstlane(threadIdx.x >> 6);
    unsigned* bar = (unsigned*)(p.ws + WS_BAR); const unsigned nblk = gridDim.x;
    if (p.ph_hi - p.ph_lo > 1) cg::this_grid().sync();
#if DEBUG_CHK
    if (p.ph_lo >= 100) { const int tid = threadIdx.x; dbg_phase(p, p.ph_lo - 100, blockIdx.x * 8 + wave_s, gridDim.x * 8, tid & 63, blockIdx.x * 512 + tid, gridDim.x * 512); return; }
#endif
#ifndef REP_MASK
#define REP_MASK 0u
#endif
#define EMPTYPH(K) ((K) == 2 || (K) == 12)
#define NEMPTY(K) ((unsigned)(((K) > 2) + ((K) > 12)))
#define RUN(K) if (!EMPTYPH(K) && p.ph_lo <= (K) && (K) < p.ph_hi) { if ((K) > p.ph_lo) grid_barrier(bar, ((unsigned)((K) - p.ph_lo) - NEMPTY(K)) * nblk, wave_s); run_phase<(K)>(p, lds, wave_s); }
    RUN(0) RUN(1) RUN(2) RUN(3) RUN(4) RUN(5) RUN(6) RUN(7) RUN(8) RUN(9) RUN(10) RUN(11) RUN(12) RUN(13) RUN(14) RUN(15) RUN(16) RUN(17) RUN(18) RUN(19)
#undef RUN
}
}

extern "C" void kernel_launch(void* const* d_in, const int* in_sizes, int n_in, void* d_out, int out_size, void* d_ws, size_t ws_size, hipStream_t stream) {
    static int grid = 0;
    if (grid == 0) {
        if (n_in != 24 || (size_t)out_size != mk::O_END || ws_size < mk::WS_END) { fprintf(stderr, "kernel_launch: unexpected shapes: n_in %d out %d ws %zu (need %zu)\n", n_in, out_size, ws_size, (size_t)mk::WS_END); grid = -1; return; }
        int dev = 0, cus = 0, per_cu = 0;
        if (hipGetDevice(&dev) != hipSuccess || hipDeviceGetAttribute(&cus, hipDeviceAttributeMultiprocessorCount, dev) != hipSuccess) { fprintf(stderr, "kernel_launch: device query failed\n"); grid = -1; return; }
        if (hipFuncSetAttribute((const void*)mk::fwd_kernel, hipFuncAttributeMaxDynamicSharedMemorySize, mk::LDS_BYTES) != hipSuccess) { fprintf(stderr, "kernel_launch: hipFuncSetAttribute failed\n"); grid = -1; return; }
        if (hipOccupancyMaxActiveBlocksPerMultiprocessor(&per_cu, (const void*)mk::fwd_kernel, 512, mk::LDS_BYTES) != hipSuccess || per_cu < 1) { fprintf(stderr, "kernel_launch: occupancy query gave %d\n", per_cu); per_cu = 1; }
        (void)hipGetLastError();
        grid = cus * 1;
    }
    if (grid < 0) return;
    if (hipMemsetAsync((char*)d_ws + mk::WS_BAR, 0, 256, stream) != hipSuccess) { fprintf(stderr, "kernel_launch: memset failed\n"); return; }
    mk::Params p{};
    for (int i = 0; i < 24; ++i) p.in[i] = (const float*)d_in[i];
    p.out = (float*)d_out; p.ws = (unsigned char*)d_ws;
#if ONE_LAUNCH
    p.ph_lo = 0; p.ph_hi = mk::NPH;
    void* args[] = {&p};
    hipError_t e = hipLaunchCooperativeKernel((const void*)mk::fwd_kernel, dim3(grid), dim3(512), args, mk::LDS_BYTES, stream);
    if (e != hipSuccess) fprintf(stderr, "kernel_launch: cooperative launch failed: %s (grid %d)\n", hipGetErrorString(e), grid);
#else
    for (int ph = 0; ph < mk::NPH; ++ph) {
        p.ph_lo = ph; p.ph_hi = ph + 1;
        hipLaunchKernelGGL(mk::fwd_kernel, dim3(grid), dim3(512), mk::LDS_BYTES, stream, p);
#if DEBUG_CHK
        const int kind = ph == 1 ? 1 : ph == 3 ? 9 : ph == 5 ? 2 : ph == 6 ? 3 : ph == 7 ? 4 : ph == 8 ? 5 : ph == 9 ? 6 : 0;
        if (kind) { p.ph_lo = 100 + kind; p.ph_hi = 101 + kind; hipLaunchKernelGGL(mk::fwd_kernel, dim3(grid), dim3(512), mk::LDS_BYTES, stream, p); }
#endif
    }
#if DEBUG_CHK
    p.ph_lo = 199; p.ph_hi = 200; hipLaunchKernelGGL(mk::fwd_kernel, dim3(grid), dim3(512), mk::LDS_BYTES, stream, p);
#endif
#endif
}
```

```cpp
#include <hip/hip_runtime.h>
#include <hip/hip_cooperative_groups.h>
#include <cstdio>
#include <cstdint>
namespace cg = cooperative_groups;
#ifndef ONE_LAUNCH
#define ONE_LAUNCH 1
#endif
namespace pg8 {
#define PG8_LAS __attribute__((address_space(3)))
typedef unsigned short bf16_t;
typedef short bf16x8 __attribute__((ext_vector_type(8)));
typedef float f32x4 __attribute__((ext_vector_type(4)));
typedef unsigned u32x4 __attribute__((ext_vector_type(4)));
constexpr int BM = 256, BK = 64, HALF = 128, HTB = HALF * BK * 2  , STAGE_BYTES = 8 * HTB, NXCD = 8, WGM = 8;

__host__ __device__ __forceinline__ int lds_byte(int r, int c) { const int st = (r >> 4) * 2 + (c >> 5), rr = r & 15, cc = c & 31, ob = rr * 64 + cc * 2; return st * 1024 + (ob ^ (((ob >> 9) & 1) << 5)); }
__host__ __device__ __forceinline__ void stage_rc(int b, int& R, int& C) { const int st = b / 1024, sb = b % 1024, swz = sb ^ (((sb >> 9) & 1) << 5); R = (st >> 1) * 16 + swz / 64; C = (st & 1) * 32 + (swz % 64) / 2; }
__host__ __device__ __forceinline__ int perm32(int rho) { const int n = rho >> 4, i = rho & 15; return 8 * (i >> 2) + 4 * n + (i & 3); }

struct Unit { int pm, pn; };
struct Gemm { const bf16_t* A; const bf16_t* Bt; int M, N, K; };

struct StaticOrder {
    int nM, nN, nwg, G, c;
    __host__ __device__ void init(int M, int N, int G_, int c_) { nM = M / BM; nN = N / BM; nwg = nM * nN; G = G_; c = c_; }
    __host__ __device__ bool next(int i, Unit& u) const {
        const long L = (long)i * G + c; if (L >= nwg) return false;
        int wgid = (int)L; { const int q = nwg / NXCD, r = nwg % NXCD, xcd = wgid % NXCD, off = wgid / NXCD; wgid = (xcd < r ? xcd * (q + 1) : r * (q + 1) + (xcd - r) * q) + off; }
        const int nig = WGM * nN, gid = wgid / nig, fm = gid * WGM, gsz = (nM - fm) < WGM ? (nM - fm) : WGM;
        u.pm = fm + ((wgid % nig) % gsz); u.pn = (wgid % nig) / gsz; return true;
    }
    __device__ __forceinline__ void a_ready(const Unit&) const {}
    __device__ __forceinline__ void done(const Unit&) const {}
};

__device__ __forceinline__ unsigned cvt_pk_bf16(float lo, float hi) { unsigned r; asm volatile("v_cvt_pk_bf16_f32 %0, %1, %2" : "=v"(r) : "v"(lo), "v"(hi)); return r; }
typedef float f32x2 __attribute__((ext_vector_type(2)));
__device__ __forceinline__ f32x2 gelu_pk(f32x2 v) {
    const f32x2 av = __builtin_elementwise_abs(v), d = av * 0.2316418882f + 1.0f;
    f32x2 t; t.x = __builtin_amdgcn_rcpf(d.x); t.y = __builtin_amdgcn_rcpf(d.y);
    f32x2 q = t * 0.5307027145f + (-0.7265760135f); q = q * t + 0.7107068705f; q = q * t + (-0.142248368f); q = q * t + 0.127414796f; q = q * t;
    const f32x2 s = (v * v) * (-0.72134752044f);
    f32x2 e; e.x = __builtin_amdgcn_exp2f(s.x); e.y = __builtin_amdgcn_exp2f(s.y);
    const f32x2 m = v * (q * e), r = v - m;
    f32x2 o; o.x = v.x < 0.f ? m.x : r.x; o.y = v.y < 0.f ? m.y : r.y; return o;
}

template <int ACT  > struct EpiBf16 {
    static constexpr bool PERM = true, AFTER_DRAIN = false; static_assert(ACT == 0 || ACT == 1, "EpiBf16: ACT is 0 (none) or 1 (gelu_pk)");
    bf16_t* O; int ldc; const float* bias; int split_cols; size_t split_stride; float scale0;
    __device__ __forceinline__ void operator()(const f32x4 (&acc)[2][2][4][2], const Unit& u, int wr, int wc, int fr, int fq) const {
        const int row0 = u.pm * BM + wr * 64 + fr; int colt = u.pn * BM; bf16_t* base = O;
        float sc = 1.f; if (split_cols) { const int t = colt / split_cols; base += (size_t)t * split_stride; colt -= t * split_cols; if (t == 0) sc = scale0; }
        const int col0 = colt + wc * 32 + 8 * fq, bcol0 = u.pn * BM + wc * 32 + 8 * fq;
        f32x4 bv[2][2];
#pragma unroll
        for (int bj = 0; bj < 2; ++bj)
#pragma unroll
            for (int n = 0; n < 2; ++n) bv[bj][n] = bias ? *(const f32x4*)(bias + bcol0 + bj * HALF + 4 * n) : (f32x4){0.f, 0.f, 0.f, 0.f};
#pragma unroll
        for (int ai = 0; ai < 2; ++ai)
#pragma unroll
            for (int m = 0; m < 4; ++m) { bf16_t* rowp = base + (size_t)(row0 + ai * HALF + m * 16) * ldc + col0;
#pragma unroll
                for (int bj = 0; bj < 2; ++bj) { f32x4 v0 = acc[ai][bj][m][0] + bv[bj][0], v1 = acc[ai][bj][m][1] + bv[bj][1];
                    if (ACT == 1) { f32x2 a = gelu_pk((f32x2){v0[0], v0[1]}), b = gelu_pk((f32x2){v0[2], v0[3]}), c = gelu_pk((f32x2){v1[0], v1[1]}), d = gelu_pk((f32x2){v1[2], v1[3]});
                        v0 = (f32x4){a.x, a.y, b.x, b.y}; v1 = (f32x4){c.x, c.y, d.x, d.y}; }
                    v0 = v0 * sc; v1 = v1 * sc; u32x4 w; w.x = cvt_pk_bf16(v0[0], v0[1]); w.y = cvt_pk_bf16(v0[2], v0[3]); w.z = cvt_pk_bf16(v1[0], v1[1]); w.w = cvt_pk_bf16(v1[2], v1[3]);
                    *(u32x4*)(rowp + bj * HALF) = w; } }
    }
};

template <class Epi, class Sched, bool ALIGN_EPI = false, bool SP2 = false>
__device__ __forceinline__ void gemm_phase(PG8_LAS unsigned char* lds, const Gemm g, const Sched& S, const Epi& E, int tid_in) {
    int tid_l = tid_in; asm volatile("" : "+v"(tid_l));
    const int tid = tid_l, wid = __builtin_amdgcn_readfirstlane(tid >> 6), lane = tid & 63, wr = wid >> 2, wc = wid & 3, fr = lane & 15, fq = lane >> 4;
    const int K = g.K, nt = K / BK;
    unsigned voffA[2], voffB[2];
#pragma unroll
    for (int i = 0; i < 2; ++i) { int R, C; stage_rc(tid * 16 + i * 8192, R, C); const int Rb = Epi::PERM ? ((R & ~31) + perm32(R & 31)) : R;
        voffA[i] = (unsigned)(R * K + C) * 2u; voffB[i] = (unsigned)(Rb * K + C) * 2u; }
    const size_t kstep = (size_t)(BK * 2);
    const size_t hstep = (size_t)HALF * K * 2;
    const size_t tstep = 2 * hstep;
    const unsigned ldsw = (unsigned)wid * 1024u;
    const int aoff = lds_byte(wr * 64 + fr, fq * 8), boff = lds_byte(wc * 32 + fr, fq * 8);
#define PG8_SA(b, h) (((b) * 2 + (h)) * HTB)
#define PG8_SB(b, h) ((4 + (b) * 2 + (h)) * HTB)
#define PG8_STAGE(bufoff, gbase, voff) do { _Pragma("unroll") for (int _i = 0; _i < 2; ++_i) \
        __builtin_amdgcn_global_load_lds((const unsigned*)((const char*)(gbase) + (voff)[_i]), (PG8_LAS unsigned*)(lds + (bufoff) + ldsw + _i * 8192), 16, 0, 0); } while (0)
#define PG8_LDA(dst, b, h) do { _Pragma("unroll") for (int m = 0; m < 4; ++m) _Pragma("unroll") for (int k = 0; k < 2; ++k) dst[m][k] = *(const PG8_LAS bf16x8*)(lds + PG8_SA(b, h) + aoff + m * 2048 + k * 1024); } while (0)
#define PG8_LDB(dst, b, h) do { _Pragma("unroll") for (int n = 0; n < 2; ++n) _Pragma("unroll") for (int k = 0; k < 2; ++k) dst[n][k] = *(const PG8_LAS bf16x8*)(lds + PG8_SB(b, h) + boff + n * 2048 + k * 1024); } while (0)
#define PG8_MMA(ai, bj, At, Bt) do { __builtin_amdgcn_s_setprio(1); _Pragma("unroll") for (int m = 0; m < 4; ++m) _Pragma("unroll") for (int n = 0; n < 2; ++n) _Pragma("unroll") for (int k = 0; k < 2; ++k) \
        acc[ai][bj][m][n] = __builtin_amdgcn_mfma_f32_16x16x32_bf16(Bt[n][k], At[m][k], acc[ai][bj][m][n], 0, 0, 0); __builtin_amdgcn_s_setprio(0); } while (0)
#define PG8_WAIT_V(n) asm volatile("s_waitcnt vmcnt(" #n ")" ::: "memory")
#define PG8_WAIT_L(n) asm volatile("s_waitcnt lgkmcnt(" #n ")" ::: "memory")
#define PG8_BAR __builtin_amdgcn_s_barrier()
#define PG8_SCHED __builtin_amdgcn_sched_barrier(0)
    Unit cur, nxt; int ui = 0;
    if (!S.next(0, cur)) return;
    f32x4 acc[2][2][4][2];
#pragma unroll
    for (int a = 0; a < 2; ++a)
#pragma unroll
        for (int b = 0; b < 2; ++b)
#pragma unroll
            for (int m = 0; m < 4; ++m)
#pragma unroll
                for (int n = 0; n < 2; ++n) acc[a][b][m][n] = (f32x4){0.f, 0.f, 0.f, 0.f};
    bf16x8 At[4][2], B0[2][2], B1[2][2];
    const char* cA = (const char*)g.A + (size_t)cur.pm * tstep; const char* cB = (const char*)g.Bt + (size_t)cur.pn * tstep;
    S.a_ready(cur);
    if constexpr (SP2) {
        PG8_STAGE(PG8_SB(0, 0), cB, voffB); PG8_STAGE(PG8_SB(0, 1), cB + hstep, voffB); PG8_STAGE(PG8_SA(0, 0), cA, voffA); PG8_STAGE(PG8_SA(0, 1), cA + hstep, voffA);
        if (wr == 1) PG8_BAR;
        PG8_WAIT_V(2); PG8_BAR;
        PG8_STAGE(PG8_SB(1, 0), cB + kstep, voffB); PG8_STAGE(PG8_SA(1, 0), cA + kstep, voffA); PG8_STAGE(PG8_SB(1, 1), cB + hstep + kstep, voffB);
        PG8_WAIT_V(6); PG8_BAR;
    } else {
        PG8_STAGE(PG8_SB(0, 0), cB, voffB); PG8_STAGE(PG8_SA(0, 0), cA, voffA); PG8_STAGE(PG8_SB(0, 1), cB + hstep, voffB); PG8_STAGE(PG8_SA(0, 1), cA + hstep, voffA);
        if (wr == 1) PG8_BAR;
        PG8_WAIT_V(4); PG8_BAR;
        PG8_STAGE(PG8_SB(1, 0), cB + kstep, voffB); PG8_STAGE(PG8_SA(1, 0), cA + kstep, voffA); PG8_STAGE(PG8_SB(1, 1), cB + hstep + kstep, voffB);
        PG8_WAIT_V(6); PG8_BAR;
    }
    for (;;) {
        const bool has_next = S.next(ui + 1, nxt);
        const char* nA = has_next ? (const char*)g.A + (size_t)nxt.pm * tstep : cA; const char* nB = has_next ? (const char*)g.Bt + (size_t)nxt.pn * tstep : cB;
        for (int t = 0; t < nt; t += 2) {
            if constexpr (Epi::SEGMENT_TILES > 0) { if (t > 0 && (t % Epi::SEGMENT_TILES) == 0) E.rescale(acc, cur, t / Epi::SEGMENT_TILES, wr, wc, fr, fq); }
            const bool last = (t == nt - 2);
            const char* a1 = cA + (size_t)(t + 1) * kstep;
            const char* a2 = last ? nA : cA + (size_t)(t + 2) * kstep; const char* b2 = last ? nB : cB + (size_t)(t + 2) * kstep;
            const char* a3 = a2 + kstep; const char* b3 = b2 + kstep;
            if (last && has_next) S.a_ready(nxt);
            if constexpr (SP2) {
            PG8_LDB(B0, 0, 0); PG8_LDB(B1, 0, 1); PG8_SCHED; PG8_LDA(At, 0, 0); PG8_STAGE(PG8_SA(1, 1), a1 + hstep, voffA);
            PG8_WAIT_V(8); PG8_WAIT_L(0); PG8_BAR; PG8_MMA(0, 0, At, B0); PG8_MMA(0, 1, At, B1); PG8_BAR; PG8_SCHED;
            PG8_LDA(At, 0, 1); PG8_STAGE(PG8_SB(0, 0), b2, voffB); PG8_STAGE(PG8_SB(0, 1), b2 + hstep, voffB); PG8_STAGE(PG8_SA(0, 0), a2, voffA);
            PG8_WAIT_V(8); PG8_WAIT_L(0); PG8_BAR; PG8_MMA(1, 0, At, B0); PG8_MMA(1, 1, At, B1); PG8_BAR; PG8_SCHED;
            PG8_LDB(B0, 1, 0); PG8_LDB(B1, 1, 1); PG8_SCHED; PG8_LDA(At, 1, 0); PG8_STAGE(PG8_SA(0, 1), a2 + hstep, voffA);
            PG8_WAIT_V(8); PG8_WAIT_L(0); PG8_BAR; PG8_MMA(0, 0, At, B0); PG8_MMA(0, 1, At, B1); PG8_BAR; PG8_SCHED;
            PG8_LDA(At, 1, 1); PG8_STAGE(PG8_SB(1, 0), b3, voffB); PG8_STAGE(PG8_SB(1, 1), b3 + hstep, voffB); PG8_STAGE(PG8_SA(1, 0), a3, voffA);
            PG8_WAIT_V(8); PG8_WAIT_L(0); PG8_BAR; PG8_MMA(1, 0, At, B0); PG8_MMA(1, 1, At, B1); PG8_BAR; PG8_SCHED;
            } else {
            PG8_LDB(B0, 0, 0); PG8_SCHED; PG8_LDA(At, 0, 0); PG8_STAGE(PG8_SA(1, 1), a1 + hstep, voffA);
            PG8_WAIT_L(8); PG8_BAR; PG8_WAIT_L(0); PG8_MMA(0, 0, At, B0); PG8_BAR; PG8_SCHED;
            PG8_LDB(B1, 0, 1); PG8_STAGE(PG8_SB(0, 0), b2, voffB);
            PG8_BAR; PG8_WAIT_L(0); PG8_MMA(0, 1, At, B1); PG8_BAR;
            PG8_LDA(At, 0, 1); PG8_STAGE(PG8_SA(0, 0), a2, voffA);
            PG8_BAR; PG8_WAIT_L(0); PG8_MMA(1, 0, At, B0); PG8_BAR; PG8_SCHED;
            PG8_STAGE(PG8_SB(0, 1), b2 + hstep, voffB);
            PG8_WAIT_V(6); PG8_BAR; PG8_MMA(1, 1, At, B1); PG8_BAR;
            PG8_LDB(B0, 1, 0); PG8_SCHED; PG8_LDA(At, 1, 0); PG8_STAGE(PG8_SA(0, 1), a2 + hstep, voffA);
            PG8_WAIT_L(8); PG8_BAR; PG8_WAIT_L(0); PG8_MMA(0, 0, At, B0); PG8_BAR; PG8_SCHED;
            PG8_LDB(B1, 1, 1); PG8_STAGE(PG8_SB(1, 0), b3, voffB);
            PG8_BAR; PG8_WAIT_L(0); PG8_MMA(0, 1, At, B1); PG8_BAR;
            PG8_LDA(At, 1, 1); PG8_STAGE(PG8_SA(1, 0), a3, voffA);
            PG8_BAR; PG8_WAIT_L(0); PG8_MMA(1, 0, At, B0); PG8_BAR; PG8_SCHED;
            PG8_STAGE(PG8_SB(1, 1), b3 + hstep, voffB);
            PG8_WAIT_V(6); PG8_BAR; PG8_MMA(1, 1, At, B1); PG8_BAR;
            }
        }
        if constexpr (ALIGN_EPI) { if (wr == 0) PG8_BAR; }
        if constexpr (!Epi::AFTER_DRAIN) { E(acc, cur, wr, wc, fr, fq); S.done(cur); }
        if (!has_next) break;
#pragma unroll
        for (int a = 0; a < 2; ++a)
#pragma unroll
            for (int b = 0; b < 2; ++b)
#pragma unroll
                for (int m = 0; m < 4; ++m)
#pragma unroll
                    for (int n = 0; n < 2; ++n) acc[a][b][m][n] = (f32x4){0.f, 0.f, 0.f, 0.f};
        cur = nxt; cA = nA; cB = nB; ++ui;
        if constexpr (ALIGN_EPI) { if (wr == 1) PG8_BAR; }
    }
    PG8_WAIT_V(0);
    if constexpr (!ALIGN_EPI) { if (wr == 0) PG8_BAR; }
    PG8_BAR;
    if constexpr (Epi::AFTER_DRAIN) { E.fused(acc, cur, wr, wc, fr, fq, lds, wid, lane); S.done(cur); }
#undef PG8_SA
#undef PG8_SB
#undef PG8_STAGE
#undef PG8_LDA
#undef PG8_LDB
#undef PG8_MMA
#undef PG8_WAIT_V
#undef PG8_WAIT_L
#undef PG8_BAR
#undef PG8_SCHED
}
}
#define PG8_SP2 true
#define PG8_ALIGN true
namespace mk {
#define LAS __attribute__((address_space(3)))
using pg8::bf16_t; using pg8::bf16x8; using pg8::f32x4; using pg8::u32x4;
typedef float f32x16 __attribute__((ext_vector_type(16)));
typedef short s16x4 __attribute__((ext_vector_type(4)));
typedef unsigned u32x2 __attribute__((ext_vector_type(2)));

constexpr int MP = 32768, MS = 128, MTOK = MP + MS, MPAD = 33024, NTM = MPAD / 256;
constexpr int ZLD = 8704, GOFF = 4608, BW = 384, DFF = 2816;
constexpr int LDS_BYTES = 131072;
constexpr float LOG2E = 1.4426950408889634f, LN2 = 0.6931471805599453f, EPS = 1e-6f;
enum { I_XP = 0, I_XS, I_CA, I_CB1, I_CB2, I_CB3, I_SC, I_LN1, I_WIN, I_QNA, I_KNA, I_SINK, I_QNB, I_KNB, I_CONV, I_WSD, I_BSD, I_WG, I_BG, I_WB, I_WO, I_LN2, I_WFI, I_WFO };
constexpr size_t O_YP = 0, O_YS = 33554432, O_AP = O_YS + 131072, O_AS = O_AP + 1048576, O_B1P = O_AS + 8388608, O_B1S = O_B1P + 1048576, O_B2P = O_B1S + 8388608,
                 O_B2S = O_B2P + 4194304, O_B3P = O_B2S + 33554432, O_B3S = O_B3P + 16777216, O_CP = O_B3S + 134217728, O_CS = O_CP + 24576, O_DS = O_CS + 196608, O_END = O_DS + 98304;
static_assert(O_END == 241623040, "output size");
constexpr size_t al(size_t x) { return (x + 255) & ~(size_t)255; }
constexpr size_t WS_ROPE = 0;
constexpr size_t WS_WM = al(WS_ROPE + 2049 * 16 * 4);
constexpr size_t WS_W = al(WS_WM + 2 * 6 * 128 * 128 * 2);
constexpr size_t W1_B = (size_t)ZLD * 1024 * 2, WB_B = 4ull * 1024 * 384 * 2, WO_B = 1024ull * 1024 * 2, WF_B = 5632ull * 1024 * 2, WD_B = 1024ull * 2816 * 2;
constexpr size_t WL_B = W1_B + WB_B + WO_B + WF_B + WD_B;
constexpr size_t WS_X = al(WS_W + 2 * WL_B);
constexpr size_t WS_H = al(WS_X + (size_t)MPAD * 1024 * 4);
constexpr size_t WS_ZG = al(WS_H + (size_t)MPAD * 1024 * 2);
constexpr size_t WS_BR = al(WS_ZG + (size_t)MPAD * ZLD * 2);
constexpr size_t WS_OB = al(WS_BR + 4ull * MPAD * BW * 2);
constexpr size_t WS_LSE = al(WS_OB + 3ull * MPAD * BW * 2);
constexpr size_t WS_PART = al(WS_LSE + 3ull * MPAD * 8 * 4);
constexpr size_t WS_MRG = al(WS_PART + (size_t)MPAD * 1024 * 4);
constexpr size_t WS_ACT = al(WS_MRG + (size_t)MPAD * 1024 * 2);
constexpr size_t WS_BAR = al(WS_ACT + (size_t)MPAD * DFF * 2);
constexpr size_t WS_END = al(WS_BAR + 256);

struct Params { const float* in[24]; float* out; unsigned char* ws; int ph_lo, ph_hi; };
static_assert(sizeof(Params) == 216, "Params has padding");

#define DI __device__ __forceinline__
typedef float f32x2v __attribute__((ext_vector_type(2)));
typedef __bf16 bf16x2v __attribute__((ext_vector_type(2)));
DI unsigned pk2(float lo, float hi) { const f32x2v v = {lo, hi}; return __builtin_bit_cast(unsigned, __builtin_convertvector(v, bf16x2v)); }
DI float bflo(unsigned w) { return __uint_as_float(w << 16); }
DI float bfhi(unsigned w) { return __uint_as_float(w & 0xffff0000u); }
DI float bf1(bf16_t v) { return __uint_as_float((unsigned)v << 16); }
DI void unpack8(const u32x4 w, float (&x)[8]) { x[0] = bflo(w.x); x[1] = bfhi(w.x); x[2] = bflo(w.y); x[3] = bfhi(w.y); x[4] = bflo(w.z); x[5] = bfhi(w.z); x[6] = bflo(w.w); x[7] = bfhi(w.w); }
DI u32x4 pack8(const float (&x)[8]) { u32x4 w; w.x = pk2(x[0], x[1]); w.y = pk2(x[2], x[3]); w.z = pk2(x[4], x[5]); w.w = pk2(x[6], x[7]); return w; }
DI float wave_sum(float v) {
#pragma unroll
    for (int o = 1; o < 64; o <<= 1) v += __shfl_xor(v, o);
    return v; }
DI float wave_max(float v) {
#pragma unroll
    for (int o = 1; o < 64; o <<= 1) v = fmaxf(v, __shfl_xor(v, o));
    return v; }
DI float ex2(float x) { return __builtin_amdgcn_exp2f(x); }
DI int crow(int reg, int h) { return (reg & 3) + 8 * (reg >> 2) + 4 * h; }
#define MFMA32(a, b, c) __builtin_amdgcn_mfma_f32_32x32x16_bf16((a), (b), (c), 0, 0, 0)

struct QuadOrder {
    pg8::StaticOrder o;
    __device__ bool next(int i, pg8::Unit& u) const { pg8::Unit q; if (!o.next(i >> 2, q)) return false; const int n = i & 3; u.pm = n * NTM + q.pm; u.pn = n * 4 + q.pn; return true; }
    DI void a_ready(const pg8::Unit&) const {}
    DI void done(const pg8::Unit&) const {}
};
typedef f32x4 AccT[2][2][4][2];
struct EpiZG {
    static constexpr bool PERM = true, AFTER_DRAIN = false; static constexpr int SEGMENT_TILES = 0;
    bf16_t* O; const float* bias; const float* rope; const float* qna; const float* kna; const float* qnb; const float* knb; float* out; int l;
    DI void operator()(const AccT& acc, const pg8::Unit& u, int wr, int wc, int fr_, int fq_) const {
        int fr = fr_, fq = fq_; asm volatile("" : "+v"(fr), "+v"(fq));
        const int rowb = u.pm * 256 + wr * 64 + fr;
        if (u.pn >= 18) {
            const int col0 = u.pn * 256 + wc * 32 + 8 * fq;
            f32x4 bv[2][2];
#pragma unroll
            for (int bj = 0; bj < 2; ++bj) { bv[bj][0] = *(const f32x4*)(bias + col0 + bj * 128 - GOFF); bv[bj][1] = *(const f32x4*)(bias + col0 + bj * 128 - GOFF + 4); }
#pragma unroll
            for (int ai = 0; ai < 2; ++ai)
#pragma unroll
                for (int m = 0; m < 4; ++m) {
#pragma unroll
                    for (int bj = 0; bj < 2; ++bj) {
                        f32x4 v0 = acc[ai][bj][m][0] + bv[bj][0], v1 = acc[ai][bj][m][1] + bv[bj][1];
#pragma unroll
                        for (int e = 0; e < 4; ++e) { v0[e] = __builtin_amdgcn_rcpf(1.f + ex2(-LOG2E * v0[e])); v1[e] = __builtin_amdgcn_rcpf(1.f + ex2(-LOG2E * v1[e])); }
                        u32x4 w; w.x = pk2(v0[0], v0[1]); w.y = pk2(v0[2], v0[3]); w.z = pk2(v1[0], v1[1]); w.w = pk2(v1[2], v1[3]);
                        *(u32x4*)(O + (size_t)(rowb + ai * 128 + m * 16) * ZLD + col0 + bj * 128) = w;
                    }
                    asm volatile("" ::: "memory");
                }
            return;
        }
        const int c64 = u.pn * 4 + wc, colL = c64 * 64 + 8 * fq;
        int type = 3, gi = 0, hh = 0;
        if (c64 < 40) { gi = c64 / 10; hh = c64 - gi * 10; type = hh < 6 ? 0 : (hh < 8 ? 1 : 2); }
        f32x4 g00 = (f32x4){1.f, 1.f, 1.f, 1.f}, g01 = g00, g10 = g00, g11 = g00;
        if (type <= 1) { const float* gn = (type == 0 ? (gi == 0 ? qna : qnb + (gi - 1) * 64) : (gi == 0 ? kna : knb + (gi - 1) * 64)) + 8 * fq;
            g00 = *(const f32x4*)gn; g01 = *(const f32x4*)(gn + 4); g10 = *(const f32x4*)(gn + 32); g11 = *(const f32x4*)(gn + 36); }
        const int W = gi < 2 ? 128 : (gi == 2 ? 512 : 2048);
        const size_t obase_p = gi == 0 ? O_AP : (gi == 1 ? O_B1P : (gi == 2 ? O_B2P : O_B3P)), obase_s = gi == 0 ? O_AS : (gi == 1 ? O_B1S : (gi == 2 ? O_B2S : O_B3S));
#pragma unroll
        for (int ai = 0; ai < 2; ++ai)
#pragma unroll
            for (int m = 0; m < 4; ++m) {
                const int row = rowb + ai * 128 + m * 16;
                f32x4 v00 = acc[ai][0][m][0], v01 = acc[ai][0][m][1], v10 = acc[ai][1][m][0], v11 = acc[ai][1][m][1];
                const bool samp = row >= MP; const int t = row & 2047;
                if (type <= 1) {
                    float ss = 0.f;
#pragma unroll
                    for (int e = 0; e < 4; ++e) ss += v00[e] * v00[e] + v01[e] * v01[e] + v10[e] * v10[e] + v11[e] * v11[e];
                    ss += __shfl_xor(ss, 16); ss += __shfl_xor(ss, 32);
                    const float rs = 1.0f / sqrtf(ss * (1.f / 64.f) + EPS);
                    v00 = v00 * rs * g00; v01 = v01 * rs * g01; v10 = v10 * rs * g10; v11 = v11 * rs * g11;
                    f32x4 y0, y1;
#pragma unroll
                    for (int e = 0; e < 4; ++e) { y0[e] = __shfl_xor(v00[e], 16); y1[e] = __shfl_xor(v01[e], 16); }
                    if (fq < 2) {
                        const float* rp = rope + (samp ? 2048 : t) * 16;
                        const f32x4 c0 = *(const f32x4*)rp, c1 = *(const f32x4*)(rp + 4), c2 = *(const f32x4*)(rp + 8), c3 = *(const f32x4*)(rp + 12);
                        const float sg = fq == 0 ? -1.f : 1.f;
                        v00 = (f32x4){v00[0] * c0[0] + sg * y0[0] * c0[1], v00[1] * c0[2] + sg * y0[1] * c0[3], v00[2] * c1[0] + sg * y0[2] * c1[1], v00[3] * c1[2] + sg * y0[3] * c1[3]};
                        v01 = (f32x4){v01[0] * c2[0] + sg * y1[0] * c2[1], v01[1] * c2[2] + sg * y1[1] * c2[3], v01[2] * c3[0] + sg * y1[2] * c3[1], v01[3] * c3[2] + sg * y1[3] * c3[3]};
                    }
                }
                bf16_t* zp = O + (size_t)row * ZLD + colL;
                { u32x4 w; w.x = pk2(v00[0], v00[1]); w.y = pk2(v00[2], v00[3]); w.z = pk2(v01[0], v01[1]); w.w = pk2(v01[2], v01[3]); *(u32x4*)zp = w; }
                { u32x4 w; w.x = pk2(v10[0], v10[1]); w.y = pk2(v10[2], v10[3]); w.z = pk2(v11[0], v11[1]); w.w = pk2(v11[2], v11[3]); *(u32x4*)(zp + 32) = w; }
                if ((type == 1 || type == 2) && row < MTOK) {
                    const int b = samp ? row - MP : row >> 11, jrow = samp ? W - 1 : t - (2048 - W);
                    if (jrow >= 0) {
                        const size_t cb = samp ? obase_s + ((size_t)(l * 128 + b) * 2) * W * 128 : obase_p + ((size_t)(l * 16 + b) * 2) * W * 128;
                        float* d = out + cb + ((size_t)(type - 1) * W + jrow) * 128 + (hh - (type == 1 ? 6 : 8)) * 64 + 8 * fq;
                        *(f32x4*)d = v00; *(f32x4*)(d + 4) = v01; *(f32x4*)(d + 32) = v10; *(f32x4*)(d + 36) = v11;
                    }
                }
                asm volatile("" ::: "memory");
            }
    }
};
struct EpiBranch {
    static constexpr bool PERM = true, AFTER_DRAIN = false; static constexpr int SEGMENT_TILES = 6;
    const bf16_t* G; bf16_t* mrg;
    DI void rescale(AccT& acc, const pg8::Unit& u, int n, int wr, int wc, int fr_, int fq_) const {
        int fr = fr_, fq = fq_; asm volatile("" : "+v"(fr), "+v"(fq));
        const int row0 = u.pm * 256 + wr * 64 + fr, col0 = u.pn * 256 + wc * 32 + 8 * fq;
#pragma unroll
        for (int ai = 0; ai < 2; ++ai)
#pragma unroll
            for (int m = 0; m < 4; ++m) {
                const bf16_t* gp = G + (size_t)(row0 + ai * 128 + m * 16) * ZLD + GOFF + (n - 1) * 1024 + col0;
#pragma unroll
                for (int bj = 0; bj < 2; ++bj) {
                    float gp0[8], gp1[8]; unpack8(*(const u32x4*)(gp + bj * 128), gp0); unpack8(*(const u32x4*)(gp + 1024 + bj * 128), gp1);
#pragma unroll
                    for (int e = 0; e < 4; ++e) { acc[ai][bj][m][0][e] *= fmaxf(gp0[e], 1e-8f) * __builtin_amdgcn_rcpf(fmaxf(gp1[e], 1e-8f)); acc[ai][bj][m][1][e] *= fmaxf(gp0[4 + e], 1e-8f) * __builtin_amdgcn_rcpf(fmaxf(gp1[4 + e], 1e-8f)); }
                }
                asm volatile("" ::: "memory");
            }
    }
    DI void operator()(const AccT& acc, const pg8::Unit& u, int wr, int wc, int fr_, int fq_) const {
        int fr = fr_, fq = fq_; asm volatile("" : "+v"(fr), "+v"(fq));
        const int row0 = u.pm * 256 + wr * 64 + fr, col0 = u.pn * 256 + wc * 32 + 8 * fq;
#pragma unroll
        for (int ai = 0; ai < 2; ++ai)
#pragma unroll
            for (int m = 0; m < 4; ++m) {
                const size_t row = (size_t)(row0 + ai * 128 + m * 16);
#pragma unroll
                for (int bj = 0; bj < 2; ++bj) {
                    const int col = col0 + bj * 128;
                    float gv[8]; unpack8(*(const u32x4*)(G + row * ZLD + GOFF + 3 * 1024 + col), gv);
                    const f32x4 v0 = acc[ai][bj][m][0], v1 = acc[ai][bj][m][1];
                    u32x4 w; w.x = pk2(v0[0] * fmaxf(gv[0], 1e-8f), v0[1] * fmaxf(gv[1], 1e-8f)); w.y = pk2(v0[2] * fmaxf(gv[2], 1e-8f), v0[3] * fmaxf(gv[3], 1e-8f));
                    w.z = pk2(v1[0] * fmaxf(gv[4], 1e-8f), v1[1] * fmaxf(gv[5], 1e-8f)); w.w = pk2(v1[2] * fmaxf(gv[6], 1e-8f), v1[3] * fmaxf(gv[7], 1e-8f));
                    *(u32x4*)(mrg + row * 1024 + col) = w;
                }
                asm volatile("" ::: "memory");
            }
    }
};
struct EpiResid {
    static constexpr bool PERM = true, AFTER_DRAIN = false; static constexpr int SEGMENT_TILES = 0;
    const float* src; float* dst; int nrows;
    DI void operator()(const AccT& acc, const pg8::Unit& u, int wr, int wc, int fr_, int fq_) const {
        int fr = fr_, fq = fq_; asm volatile("" : "+v"(fr), "+v"(fq));
        const int row0 = u.pm * 256 + wr * 64 + fr, col0 = u.pn * 256 + wc * 32 + 8 * fq;
#pragma unroll
        for (int ai = 0; ai < 2; ++ai)
#pragma unroll
            for (int m = 0; m < 4; ++m) {
                const int row = row0 + ai * 128 + m * 16;
                if (row < nrows) {
#pragma unroll
                    for (int bj = 0; bj < 2; ++bj) {
                        const size_t off = (size_t)row * 1024 + col0 + bj * 128;
                        const f32x4 a0 = *(const f32x4*)(src + off), a1 = *(const f32x4*)(src + off + 4);
                        *(f32x4*)(dst + off) = a0 + acc[ai][bj][m][0]; *(f32x4*)(dst + off + 4) = a1 + acc[ai][bj][m][1];
                    }
                    asm volatile("" ::: "memory");
                }
            }
    }
};
struct EpiSwiglu {
    static constexpr bool PERM = true, AFTER_DRAIN = false; static constexpr int SEGMENT_TILES = 0;
    bf16_t* O;
    DI void operator()(const AccT& acc, const pg8::Unit& u, int wr, int wc, int fr_, int fq_) const {
        int fr = fr_, fq = fq_; asm volatile("" : "+v"(fr), "+v"(fq));
        const int row0 = u.pm * 256 + wr * 64 + fr, col0 = u.pn * 128 + wc * 32 + 8 * fq;
#pragma unroll
        for (int ai = 0; ai < 2; ++ai)
#pragma unroll
            for (int m = 0; m < 4; ++m) {
                float o[8];
#pragma unroll
                for (int nn = 0; nn < 2; ++nn)
#pragma unroll
                    for (int e = 0; e < 4; ++e) { const float g = acc[ai][0][m][nn][e], up = acc[ai][1][m][nn][e]; o[nn * 4 + e] = g * __builtin_amdgcn_rcpf(1.f + ex2(-LOG2E * g)) * up; }
                *(u32x4*)(O + (size_t)(row0 + ai * 128 + m * 16) * DFF + col0) = pack8(o);
                asm volatile("" ::: "memory");
            }
    }
};
DI void tr_item(const float* W, int N, bf16_t* WT, int ldk, int k0, int n0, int drow0, LAS float* scr, int lane, int kdst = -1) {
    if (kdst < 0) kdst = k0;
#pragma unroll 8
    for (int i = 0; i < 32; ++i) { const int kk = 2 * i + (lane >> 5); scr[kk * 33 + (lane & 31)] = W[(size_t)(k0 + kk) * N + n0 + (lane & 31)]; }
    const int c = lane & 7;
#pragma unroll
    for (int j = 0; j < 4; ++j) { const int n = (lane >> 3) + 8 * j; const LAS float* s = scr + (8 * c) * 33 + n;
        u32x4 o; o.x = pk2(s[0 * 33], s[1 * 33]); o.y = pk2(s[2 * 33], s[3 * 33]); o.z = pk2(s[4 * 33], s[5 * 33]); o.w = pk2(s[6 * 33], s[7 * 33]);
        *(u32x4*)(WT + (size_t)(drow0 + n) * ldk + kdst + 8 * c) = o; }
}
constexpr int IT_IN = 16 * 140, IT_G = 4 * 512, IT_B = 4 * 192, IT_O = 512, IT_FI = 16 * 176, IT_FO = 44 * 32, IT_L = IT_IN + IT_G + IT_B + IT_O + IT_FI + IT_FO;
DI void prologue_weights(const Params& p, LAS unsigned char* lds, int gw, int NGW, int wave, int lane) {
    LAS float* scr = (LAS float*)(lds + wave * 8448);
    for (int it = gw; it < 2 * IT_L; it += NGW) {
        const int l = it / IT_L; int r = it - l * IT_L;
        unsigned char* wl = p.ws + WS_W + (size_t)l * WL_B;
        bf16_t* W1t = (bf16_t*)wl; bf16_t* Wbt = (bf16_t*)(wl + W1_B); bf16_t* Wot = (bf16_t*)(wl + W1_B + WB_B); bf16_t* Wft = (bf16_t*)(wl + W1_B + WB_B + WO_B); bf16_t* Wdt = (bf16_t*)(wl + W1_B + WB_B + WO_B + WF_B);
        if (r < IT_IN) { const int kb = r / 140, nb = r % 140; const int n0 = 32 * nb, w = n0 & 255; tr_item(p.in[I_WIN] + (size_t)l * 1024 * 4480, 4480, W1t, 1024, 64 * kb, n0, (n0 & ~255) + 128 * ((w >> 5) & 1) + 32 * (w >> 6), scr, lane); continue; } r -= IT_IN;
        if (r < IT_G) { const int n = r / 512, r2 = r % 512, kb = r2 / 32, nb = r2 % 32; tr_item(p.in[I_WG] + (size_t)(l * 4 + n) * 1024 * 1024, 1024, W1t, 1024, 64 * kb, 32 * nb, GOFF + n * 1024 + 32 * nb, scr, lane); continue; } r -= IT_G;
        if (r < IT_B) { const int n = r / 192, r2 = r % 192, kb = r2 / 32, nb = r2 % 32; tr_item(p.in[I_WB] + (size_t)(l * 4 + n) * 384 * 1024, 1024, Wbt, 1536, 64 * kb, 32 * nb, 32 * nb, scr, lane, n * 384 + 64 * kb); continue; } r -= IT_B;
        if (r < IT_O) { const int kb = r / 32, nb = r % 32; tr_item(p.in[I_WO] + (size_t)l * 1024 * 1024, 1024, Wot, 1024, 64 * kb, 32 * nb, 32 * nb, scr, lane); continue; } r -= IT_O;
        if (r < IT_FI) { const int kb = r / 176, nb = r % 176, n0 = 32 * nb; const int dr = n0 < DFF ? 256 * (n0 / 128) + (n0 % 128) : 256 * ((n0 - DFF) / 128) + 128 + ((n0 - DFF) % 128);
            tr_item(p.in[I_WFI] + (size_t)l * 1024 * 5632, 5632, Wft, 1024, 64 * kb, n0, dr, scr, lane); continue; } r -= IT_FI;
        { const int kb = r / 32, nb = r % 32; tr_item(p.in[I_WFO] + (size_t)l * DFF * 1024, 1024, Wdt, DFF, 64 * kb, 32 * nb, 32 * nb, scr, lane); }
    }
}
__constant__ float INV_FREQ[8] = {1.0f, 0.1939227432012558f, 0.03760603070259094f, 0.007292664609849453f, 0.0014142135623842478f, 0.00027424818836152554f, 5.3182957344688475e-05f, 1.0313385246263351e-05f};
DI void prologue_misc(const Params& p, int gt, int NT) {
    for (int i = gt; i < 2 * 16384; i += NT) { const int l = i >> 14, j = i & 16383, rr = j >> 7, prow = 4352 + (rr < 64 ? 64 + rr : 128 + rr); *(u32x4*)(p.ws + WS_W + (size_t)l * WL_B + (size_t)prow * 2048 + (size_t)(j & 127) * 16) = (u32x4){0u, 0u, 0u, 0u}; }
    bf16_t* Wm = (bf16_t*)(p.ws + WS_WM);
    for (int i = gt; i < 2 * 6 * 128 * 64; i += NT) { const int e = 2 * i, jj = e & 127, ii = (e >> 7) & 127; const float a = p.in[I_WSD][e], b = p.in[I_WSD][e + 1];
        *(unsigned*)(Wm + e) = pk2(jj <= ii ? a : 0.f, jj + 1 <= ii ? b : 0.f); }
    float* rope = (float*)(p.ws + WS_ROPE);
    for (int i = gt; i < 2049 * 8; i += NT) { const int pos = (i >> 3) == 2048 ? 16384 : (i >> 3); double rev = (double)pos * (double)INV_FREQ[i & 7] * 0.15915494309189535; rev -= rint(rev);
        const float rf = (float)rev; rope[2 * i] = __builtin_amdgcn_cosf(rf); rope[2 * i + 1] = __builtin_amdgcn_sinf(rf); }
}
DI void norm_phase(const float* xp, const float* xs, float* xcopy, const float* gain, bf16_t* H, int gw, int NGW, int lane) {
    for (int m = gw; m < MPAD; m += NGW) {
        u32x2* ho = (u32x2*)(H + (size_t)m * 1024) + lane;
        if (m >= MTOK) {
#pragma unroll
            for (int j = 0; j < 4; ++j) { ho[64 * j] = (u32x2){0u, 0u}; if (xcopy) ((f32x4*)(xcopy + (size_t)m * 1024))[lane + 64 * j] = (f32x4){0.f, 0.f, 0.f, 0.f}; }
            continue;
        }
        const float* src = (xs && m >= MP) ? xs + (size_t)(m - MP) * 1024 : xp + (size_t)m * 1024;
        f32x4 v[4]; float ss = 0.f;
#pragma unroll
        for (int j = 0; j < 4; ++j) { v[j] = ((const f32x4*)src)[lane + 64 * j]; ss += (v[j].x * v[j].x + v[j].y * v[j].y) + (v[j].z * v[j].z + v[j].w * v[j].w); }
        const float rs = 1.0f / sqrtf(wave_sum(ss) * (1.f / 1024.f) + EPS);
#pragma unroll
        for (int j = 0; j < 4; ++j) { const f32x4 g = ((const f32x4*)gain)[lane + 64 * j];
            ho[64 * j] = (u32x2){pk2(v[j].x * rs * g.x, v[j].y * rs * g.y), pk2(v[j].z * rs * g.z, v[j].w * rs * g.w)};
            if (xcopy) ((f32x4*)(xcopy + (size_t)m * 1024))[lane + 64 * j] = v[j]; }
    }
}
DI void qk_phase(const Params& p, int l, int gw, int NGW, int lane) {
    bf16_t* ZG = (bf16_t*)(p.ws + WS_ZG); const float* rope = (const float*)(p.ws + WS_ROPE);
    const int sub = lane & 7, hh = lane >> 3;
    float gnv[4][8];
#pragma unroll
    for (int gi = 0; gi < 4; ++gi) {
        const float* gn = hh < 6 ? (gi == 0 ? p.in[I_QNA] + l * 64 : p.in[I_QNB] + (l * 3 + gi - 1) * 64) : (gi == 0 ? p.in[I_KNA] + l * 64 : p.in[I_KNB] + (l * 3 + gi - 1) * 64);
        const f32x4 g0 = *(const f32x4*)(gn + sub * 8), g1 = *(const f32x4*)(gn + sub * 8 + 4);
#pragma unroll
        for (int e = 0; e < 4; ++e) { gnv[gi][e] = g0[e]; gnv[gi][4 + e] = g1[e]; }
    }
    u32x4 nxt[4];
    if (gw < MTOK) {
#pragma unroll
        for (int gi = 0; gi < 4; ++gi) nxt[gi] = *(const u32x4*)(ZG + (size_t)gw * ZLD + gi * 640 + lane * 8);
    }
    for (int m = gw; m < MTOK; m += NGW) {
        const bool samp = m >= MP; const int b = samp ? m - MP : m >> 11, t = samp ? 0 : (m & 2047);
        const float* rp = rope + (samp ? 2048 : t) * 16;
        bf16_t* zrow = ZG + (size_t)m * ZLD;
        u32x4 cur[4];
#pragma unroll
        for (int gi = 0; gi < 4; ++gi) cur[gi] = nxt[gi];
        if (m + NGW < MTOK) {
#pragma unroll
            for (int gi = 0; gi < 4; ++gi) nxt[gi] = *(const u32x4*)(ZG + (size_t)(m + NGW) * ZLD + gi * 640 + lane * 8);
        }
        f32x4 rc0, rc1, rc2, rc3;
        if (sub < 2) { rc0 = *(const f32x4*)rp; rc1 = *(const f32x4*)(rp + 4); rc2 = *(const f32x4*)(rp + 8); rc3 = *(const f32x4*)(rp + 12); }
#pragma unroll
        for (int gi = 0; gi < 4; ++gi) {
            const int W = gi == 0 ? 128 : (gi == 1 ? 128 : (gi == 2 ? 512 : 2048));
            const size_t obase_p = gi == 0 ? O_AP : (gi == 1 ? O_B1P : (gi == 2 ? O_B2P : O_B3P)), obase_s = gi == 0 ? O_AS : (gi == 1 ? O_B1S : (gi == 2 ? O_B2S : O_B3S));
            float x[8]; unpack8(cur[gi], x);
            float ss = 0.f;
#pragma unroll
            for (int e = 0; e < 8; ++e) ss += x[e] * x[e];
            ss += __shfl_xor(ss, 1); ss += __shfl_xor(ss, 2); ss += __shfl_xor(ss, 4);
            const float rs = 1.0f / sqrtf(ss * (1.f / 64.f) + EPS);
#pragma unroll
            for (int e = 0; e < 8; ++e) x[e] = x[e] * rs * gnv[gi][e];
            float y[8];
#pragma unroll
            for (int e = 0; e < 8; ++e) y[e] = __shfl_xor(x[e], 1);
            if (sub < 2) {
                const float cs[16] = {rc0[0], rc0[1], rc0[2], rc0[3], rc1[0], rc1[1], rc1[2], rc1[3], rc2[0], rc2[1], rc2[2], rc2[3], rc3[0], rc3[1], rc3[2], rc3[3]};
#pragma unroll
                for (int e = 0; e < 8; ++e) { const float c = cs[2 * e], s = cs[2 * e + 1]; x[e] = sub == 0 ? x[e] * c - y[e] * s : x[e] * c + y[e] * s; }
            }
            *(u32x4*)(zrow + gi * 640 + lane * 8) = pack8(x);
            const int jrow = samp ? W - 1 : t - (2048 - W);
            const size_t cb = samp ? obase_s + ((size_t)(l * 128 + b) * 2) * W * 128 : obase_p + ((size_t)(l * 16 + b) * 2) * W * 128;
            if (jrow >= 0) {
                if (hh >= 6) { float* d = p.out + cb + (size_t)jrow * 128 + (hh - 6) * 64 + sub * 8; *(f32x4*)d = (f32x4){x[0], x[1], x[2], x[3]}; *(f32x4*)(d + 4) = (f32x4){x[4], x[5], x[6], x[7]}; }
                if (lane < 16) { float v[8]; unpack8(*(const u32x4*)(zrow + gi * 640 + 512 + lane * 8), v);
                    float* d = p.out + cb + (size_t)(W + jrow) * 128 + lane * 8; *(f32x4*)d = (f32x4){v[0], v[1], v[2], v[3]}; *(f32x4*)(d + 4) = (f32x4){v[4], v[5], v[6], v[7]}; }
            }
        }
        if (lane < 48 && (samp || t >= 2046)) {
            float gc[8], xc[8]; unpack8(*(const u32x4*)(zrow + 2944 + lane * 8), gc); unpack8(*(const u32x4*)(zrow + 3328 + lane * 8), xc);
            f32x4 z0 = (f32x4){gc[0] * xc[0], gc[1] * xc[1], gc[2] * xc[2], gc[3] * xc[3]}, z1 = (f32x4){gc[4] * xc[4], gc[5] * xc[5], gc[6] * xc[6], gc[7] * xc[7]};
            if (samp) {
                float* d = p.out + O_CS + ((size_t)(l * 128 + b) * 2) * BW + lane * 8; const float* s1 = p.in[I_SC] + ((size_t)(l * 128 + b) * 2 + 1) * BW + lane * 8;
                *(f32x4*)d = *(const f32x4*)s1; *(f32x4*)(d + 4) = *(const f32x4*)(s1 + 4); *(f32x4*)(d + BW) = z0; *(f32x4*)(d + BW + 4) = z1;
                float vd[8]; unpack8(*(const u32x4*)(zrow + 4096 + lane * 8), vd); float* dd = p.out + O_DS + (size_t)(l * 128 + b) * BW + lane * 8;
                *(f32x4*)dd = (f32x4){vd[0], vd[1], vd[2], vd[3]}; *(f32x4*)(dd + 4) = (f32x4){vd[4], vd[5], vd[6], vd[7]};
            } else { float* d = p.out + O_CP + ((size_t)(l * 16 + b) * 2 + (t - 2046)) * BW + lane * 8; *(f32x4*)d = z0; *(f32x4*)(d + 4) = z1; }
        }
    }
}
DI bf16x8 vt_frag(LAS unsigned char* img, int rowbase0, int tstep, int cc, int lane) {
    const int q = (lane & 15) >> 2, p4 = lane & 3, blk = (lane >> 4) & 1;
    const int colb = (32 * cc + 16 * blk + 4 * p4) * 2;
    const s16x4 lo = __builtin_amdgcn_ds_read_tr16_b64_v4i16((LAS s16x4*)(img + (rowbase0 + q) * 144 + colb));
    const s16x4 hi = __builtin_amdgcn_ds_read_tr16_b64_v4i16((LAS s16x4*)(img + (rowbase0 + tstep + q) * 144 + colb));
    return __builtin_shufflevector(lo, hi, 0, 1, 2, 3, 4, 5, 6, 7);
}
DI void attn_unit(LAS unsigned char* qimg, LAS unsigned char* img, const bf16_t* ZG, int tok0, int dil, int qb, int gi, int kvh, bf16_t* Obuf, int ostr, float* lse_out, const float* sink, int lane) {
    const int r = lane & 31, h = lane >> 5;
    const int colq = gi * 640 + kvh * 192, colk = gi * 640 + 384 + kvh * 64, colv = gi * 640 + 512 + kvh * 64;
    const int tq = tok0 + dil * (32 * qb + r);
    const bf16_t* qrow = ZG + (size_t)tq * ZLD + colq + 32 * h;
    {
        bf16x8 qv[12];
#pragma unroll
        for (int i = 0; i < 12; ++i) qv[i] = *(const bf16x8*)(qrow + (i >> 2) * 64 + 8 * (i & 3));
#pragma unroll
        for (int i = 0; i < 12; ++i) *(LAS bf16x8*)(qimg + i * 1024 + lane * 16) = qv[i];
    }
    f32x16 o[3][2]; float mrun[3], lrun[3];
#pragma unroll
    for (int g = 0; g < 3; ++g) { mrun[g] = -1e30f; lrun[g] = 0.f;
#pragma unroll
        for (int i = 0; i < 16; ++i) { o[g][0][i] = 0.f; o[g][1][i] = 0.f; } }
    const float SC = 0.125f * LOG2E;
    const int c0 = qb >= 4 ? 0 : 4 - qb;
    bf16x8 kf[4], vv[4];
    { const bf16_t* krow = ZG + (size_t)(tok0 + dil * (32 * (qb - 4 + c0) + r)) * ZLD + 32 * h;
#pragma unroll
      for (int ks = 0; ks < 4; ++ks) { kf[ks] = *(const bf16x8*)(krow + colk + 8 * ks); vv[ks] = *(const bf16x8*)(krow + colv + 8 * ks); } }
    for (int c = c0; c < 5; ++c) {
#pragma unroll
        for (int ks = 0; ks < 4; ++ks) *(LAS bf16x8*)(img + r * 144 + 64 * h + 16 * ks) = vv[ks];
        bf16x8 kc[4];
#pragma unroll
        for (int ks = 0; ks < 4; ++ks) kc[ks] = kf[ks];
        if (c < 4) {
            const bf16_t* krow = ZG + (size_t)(tok0 + dil * (32 * (qb - 3 + c) + r)) * ZLD + 32 * h;
#pragma unroll
            for (int ks = 0; ks < 4; ++ks) { kf[ks] = *(const bf16x8*)(krow + colk + 8 * ks); vv[ks] = *(const bf16x8*)(krow + colv + 8 * ks); }
        }
        bf16x8 vf[2][2];
#pragma unroll
        for (int s = 0; s < 2; ++s)
#pragma unroll
            for (int cc = 0; cc < 2; ++cc) vf[s][cc] = vt_frag(img, 16 * s + 4 * h, 8, cc, lane);
#pragma unroll
        for (int g = 0; g < 3; ++g) {
            f32x16 s;
#pragma unroll
            for (int i = 0; i < 16; ++i) s[i] = 0.f;
#pragma unroll
            for (int ks = 0; ks < 4; ++ks) s = MFMA32(kc[ks], *(const LAS bf16x8*)(qimg + (g * 4 + ks) * 1024 + lane * 16), s);
            float t[16]; float mx = -1e30f;
#pragma unroll
            for (int i = 0; i < 16; ++i) { const int cr = crow(i, h); const bool valid = c == 0 ? (cr >= r) : (c == 4 ? (cr <= r) : true); t[i] = valid ? s[i] * SC : -1e30f; mx = fmaxf(mx, t[i]); }
            mx = fmaxf(mx, __shfl_xor(mx, 32));
            const float mnew = fmaxf(mrun[g], mx), alpha = ex2(mrun[g] - mnew);
            float rsum = 0.f;
#pragma unroll
            for (int i = 0; i < 16; ++i) { t[i] = ex2(t[i] - mnew); rsum += t[i]; }
            rsum += __shfl_xor(rsum, 32);
            lrun[g] = lrun[g] * alpha + rsum; mrun[g] = mnew;
#pragma unroll
            for (int i = 0; i < 16; ++i) { o[g][0][i] *= alpha; o[g][1][i] *= alpha; }
#pragma unroll
            for (int s2 = 0; s2 < 2; ++s2) {
                u32x4 pw; pw.x = pk2(t[8 * s2], t[8 * s2 + 1]); pw.y = pk2(t[8 * s2 + 2], t[8 * s2 + 3]); pw.z = pk2(t[8 * s2 + 4], t[8 * s2 + 5]); pw.w = pk2(t[8 * s2 + 6], t[8 * s2 + 7]);
                const bf16x8 pf = __builtin_bit_cast(bf16x8, pw);
                o[g][0] = MFMA32(vf[s2][0], pf, o[g][0]); o[g][1] = MFMA32(vf[s2][1], pf, o[g][1]);
            }
        }
    }
#pragma unroll
    for (int g = 0; g < 3; ++g) {
        const int head = kvh * 3 + g; float lsum = lrun[g];
        if (sink) lsum += ex2(sink[head] * LOG2E - mrun[g]);
        const float inv = 1.0f / lsum;
        bf16_t* orow = Obuf + (size_t)tq * ostr + head * 64 + 4 * h;
#pragma unroll
        for (int cc = 0; cc < 2; ++cc)
#pragma unroll
            for (int q4 = 0; q4 < 4; ++q4) *(u32x2*)(orow + 32 * cc + 8 * q4) = (u32x2){pk2(o[g][cc][4 * q4] * inv, o[g][cc][4 * q4 + 1] * inv), pk2(o[g][cc][4 * q4 + 2] * inv, o[g][cc][4 * q4 + 3] * inv)};
        if (lse_out && h == 0) lse_out[(size_t)tq * 8 + head] = (mrun[g] + __builtin_amdgcn_logf(lsum)) * LN2;
    }
}
DI void sattn_unit(const bf16_t* ZG, const float* cache, int W, int dil, int b, int gi, int hq, bf16_t* Obuf, int ostr, float* lse_out, const float* sink, int lane) {
    const int m = MP + b, kvh = hq / 3; const bf16_t* zrow = ZG + (size_t)m * ZLD + gi * 640;
    const bf16_t* qp = zrow + hq * 64;
    const float* Kc = cache + ((size_t)(b * 2 + 0) * W) * 128 + kvh * 64;
    const float* Vc = cache + ((size_t)(b * 2 + 1) * W) * 128 + kvh * 64;
    const float* k0 = Kc + (size_t)(W - (1 + lane) * dil) * 128; const float* k1 = Kc + (size_t)(W - (65 + lane) * dil) * 128;
    float s0 = 0.f, s1 = 0.f, s2 = 0.f;
#pragma unroll 2
    for (int d8 = 0; d8 < 8; ++d8) {
        float q[8], kn[8]; unpack8(*(const u32x4*)(qp + 8 * d8), q); unpack8(*(const u32x4*)(zrow + 384 + kvh * 64 + 8 * d8), kn);
        const f32x4 a0 = *(const f32x4*)(k0 + 8 * d8), a1 = *(const f32x4*)(k0 + 8 * d8 + 4), b0 = *(const f32x4*)(k1 + 8 * d8), b1 = *(const f32x4*)(k1 + 8 * d8 + 4);
#pragma unroll
        for (int e = 0; e < 4; ++e) { s0 += q[e] * a0[e] + q[4 + e] * a1[e]; s1 += q[e] * b0[e] + q[4 + e] * b1[e]; s2 += q[e] * kn[e] + q[4 + e] * kn[4 + e]; }
    }
    s0 *= 0.125f; s1 *= 0.125f; s2 *= 0.125f;
    const float mx = fmaxf(wave_max(fmaxf(s0, s1)), s2);
    const float p0 = __expf(s0 - mx), p1 = __expf(s1 - mx), p2 = __expf(s2 - mx);
    float lsum = wave_sum(p0 + p1) + p2;
    if (sink) lsum += __expf(sink[hq] - mx);
    float acc = p2 * bf1(zrow[512 + kvh * 64 + lane]);
    for (int n0 = 1; n0 <= 64; n0 += 8) {
        float va[8], vb[8];
#pragma unroll
        for (int j = 0; j < 8; ++j) { va[j] = Vc[(size_t)(W - (n0 + j) * dil) * 128 + lane]; vb[j] = Vc[(size_t)(W - (n0 + j + 64) * dil) * 128 + lane]; }
#pragma unroll
        for (int j = 0; j < 8; ++j) acc += __shfl(p0, n0 + j - 1) * va[j] + __shfl(p1, n0 + j - 1) * vb[j];
    }
    Obuf[(size_t)m * ostr + hq * 64 + lane] = (bf16_t)(pk2(acc / lsum, 0.f) & 0xffffu);
    if (lse_out && lane == 0) lse_out[(size_t)m * 8 + hq] = mx + __logf(lsum);
}
DI void sg_unit(LAS unsigned char* img, const bf16_t* ZG, const bf16_t* Wm, const float* bs, int T0, int g, int ib, bf16_t* Od, int ostr, int lane) {
    const int r = lane & 31, h = lane >> 5;
    f32x16 acc[2];
#pragma unroll
    for (int i = 0; i < 16; ++i) { acc[0][i] = 0.f; acc[1][i] = 0.f; }
    const bf16_t* wrow = Wm + ((size_t)g * 128 + 32 * ib + r) * 128 + 8 * h;
    for (int jc = 0; jc <= ib; ++jc) {
        const bf16_t* vrow = ZG + (size_t)(T0 + 32 * jc + r) * ZLD + 4096 + g * 64 + 32 * h;
#pragma unroll
        for (int ks = 0; ks < 4; ++ks) { const bf16x8 vv = *(const bf16x8*)(vrow + 8 * ks); *(LAS bf16x8*)(img + r * 144 + 64 * h + 16 * ks) = vv; }
#pragma unroll
        for (int s = 0; s < 2; ++s) {
            const bf16x8 wf = *(const bf16x8*)(wrow + 32 * jc + 16 * s);
            acc[0] = MFMA32(vt_frag(img, 16 * s + 8 * h, 4, 0, lane), wf, acc[0]);
            acc[1] = MFMA32(vt_frag(img, 16 * s + 8 * h, 4, 1, lane), wf, acc[1]);
        }
    }
    const int tok = T0 + 32 * ib + r; const float bias = bs[g * 128 + 32 * ib + r];
    const bf16_t* urow = ZG + (size_t)tok * ZLD + 3712 + g * 64 + 4 * h; bf16_t* orow = Od + (size_t)tok * ostr + g * 64 + 4 * h;
#pragma unroll
    for (int cc = 0; cc < 2; ++cc)
#pragma unroll
        for (int q4 = 0; q4 < 4; ++q4) { const u32x2 uw = *(const u32x2*)(urow + 32 * cc + 8 * q4);
            *(u32x2*)(orow + 32 * cc + 8 * q4) = (u32x2){pk2(bflo(uw.x) * (acc[cc][4 * q4] + bias), bfhi(uw.x) * (acc[cc][4 * q4 + 1] + bias)), pk2(bflo(uw.y) * (acc[cc][4 * q4 + 2] + bias), bfhi(uw.y) * (acc[cc][4 * q4 + 3] + bias))}; }
}

#ifndef NAIVE_ATTN
#define NAIVE_ATTN 0
#endif
#ifndef NAIVE_SG
#define NAIVE_SG 0
#endif
DI void naive_attn_phase(const Params& p, int l, int gt, int NT) {
    const bf16_t* ZG = (const bf16_t*)(p.ws + WS_ZG); bf16_t* BR = (bf16_t*)(p.ws + WS_BR); bf16_t* OB = (bf16_t*)(p.ws + WS_OB); float* LSE = (float*)(p.ws + WS_LSE);
    const int sub = gt & 3;
    for (int it = gt >> 2; it < MP * 24; it += NT >> 2) {
        const int m = it / 24, rem = it % 24, hq = rem % 6, gi = rem / 6, t = m & 2047, dil = gi < 2 ? 1 : (gi == 2 ? 4 : 16), kvh = hq / 3;
        float q[16], acc[16];
        { float a[8], b[8]; const bf16_t* qp = ZG + (size_t)m * ZLD + gi * 640 + hq * 64 + sub * 16; unpack8(*(const u32x4*)qp, a); unpack8(*(const u32x4*)(qp + 8), b);
#pragma unroll
          for (int e = 0; e < 8; ++e) { q[e] = a[e]; q[8 + e] = b[e]; acc[e] = 0.f; acc[8 + e] = 0.f; } }
        float mx = -1e30f, ls = 0.f;
        for (int n = 0; n <= 128; ++n) {
            if (t - n * dil < 0) break;
            const bf16_t* kp = ZG + (size_t)(m - n * dil) * ZLD + gi * 640 + 384 + kvh * 64 + sub * 16;
            float a[8], b[8]; unpack8(*(const u32x4*)kp, a); unpack8(*(const u32x4*)(kp + 8), b);
            float d = 0.f;
#pragma unroll
            for (int e = 0; e < 8; ++e) d += q[e] * a[e] + q[8 + e] * b[e];
            d += __shfl_xor(d, 1); d += __shfl_xor(d, 2); d *= 0.125f;
            const float mn = fmaxf(mx, d), al = __expf(mx - mn), pe = __expf(d - mn);
            unpack8(*(const u32x4*)(kp + 128), a); unpack8(*(const u32x4*)(kp + 136), b);
#pragma unroll
            for (int e = 0; e < 8; ++e) { acc[e] = acc[e] * al + pe * a[e]; acc[8 + e] = acc[8 + e] * al + pe * b[e]; }
            ls = ls * al + pe; mx = mn;
        }
        if (gi == 0) ls += __expf(p.in[I_SINK][l * 6 + hq] - mx);
        const float inv = 1.0f / ls; float o[8], o2[8];
#pragma unroll
        for (int e = 0; e < 8; ++e) { o[e] = acc[e] * inv; o2[e] = acc[8 + e] * inv; }
        bf16_t* op = (gi == 0 ? BR : OB + (size_t)(gi - 1) * MPAD * BW) + (size_t)m * BW + hq * 64 + sub * 16;
        *(u32x4*)op = pack8(o); *(u32x4*)(op + 8) = pack8(o2);
        if (gi > 0 && sub == 0) LSE[(size_t)(gi - 1) * MPAD * 8 + (size_t)m * 8 + hq] = mx + __logf(ls);
    }
}
DI void naive_sg_phase(const Params& p, int l, int gt, int NT) {
    const bf16_t* ZG = (const bf16_t*)(p.ws + WS_ZG); bf16_t* BR = (bf16_t*)(p.ws + WS_BR);
    for (int it = gt; it < MP * 48; it += NT) {
        const int m = it / 48, c0 = (it % 48) * 8, g = c0 >> 6, i = m & 127, T0 = m - i;
        float sv[8];
#pragma unroll
        for (int e = 0; e < 8; ++e) sv[e] = 0.f;
        const float* wr = p.in[I_WSD] + ((size_t)(l * 6 + g) * 128 + i) * 128;
        for (int j = 0; j <= i; ++j) { float v[8]; unpack8(*(const u32x4*)(ZG + (size_t)(T0 + j) * ZLD + 4096 + c0), v); const float w = wr[j];
#pragma unroll
            for (int e = 0; e < 8; ++e) sv[e] += w * v[e]; }
        float u[8], o[8]; unpack8(*(const u32x4*)(ZG + (size_t)m * ZLD + 3712 + c0), u); const float bias = p.in[I_BSD][l * 768 + g * 128 + i];
#pragma unroll
        for (int e = 0; e < 8; ++e) o[e] = u[e] * (sv[e] + bias);
        *(u32x4*)(BR + 3ull * MPAD * BW + (size_t)m * BW + c0) = pack8(o);
    }
}
constexpr int CP_A = 256 * 32 * 127, CP_B2 = 256 * 32 * 511, CP_B3 = 256 * 32 * 2047, CP_T0 = CP_A, CP_T1 = 2 * CP_A, CP_T2 = CP_T1 + CP_B2, CP_T3 = CP_T2 + CP_B3, CP_NCH = CP_T3 / 64;
static_assert(CP_T3 % 64 == 0, "copy chunks");
DI void cp_decode(const Params& p, int l, int i, const float*& src, float*& dst) {
    if (i < CP_T0) { const int seg = i / (32 * 127), off = i % (32 * 127); const size_t base = ((size_t)l * 256 + seg) * 128 * 128; src = p.in[I_CA] + base + 128 + (size_t)off * 4; dst = p.out + O_AS + base + (size_t)off * 4; }
    else if (i < CP_T1) { i -= CP_T0; const int seg = i / (32 * 127), off = i % (32 * 127); const size_t base = ((size_t)l * 256 + seg) * 128 * 128; src = p.in[I_CB1] + base + 128 + (size_t)off * 4; dst = p.out + O_B1S + base + (size_t)off * 4; }
    else if (i < CP_T2) { i -= CP_T1; const int seg = i / (32 * 511), off = i % (32 * 511); const size_t base = ((size_t)l * 256 + seg) * 512 * 128; src = p.in[I_CB2] + base + 128 + (size_t)off * 4; dst = p.out + O_B2S + base + (size_t)off * 4; }
    else { i -= CP_T2; const int seg = i / (32 * 2047), off = i % (32 * 2047); const size_t base = ((size_t)l * 256 + seg) * 2048 * 128; src = p.in[I_CB3] + base + 128 + (size_t)off * 4; dst = p.out + O_B3S + base + (size_t)off * 4; }
}
constexpr int CP_NSL = 4;
DI void copy_slice(const Params& p, int l, int s, int gw, int NGW, int lane) {
    for (int c0 = s * NGW + gw; c0 < CP_NCH; c0 += 8 * CP_NSL * NGW) {
        f32x4 v[8]; float* dst[8]; bool ok[8];
#pragma unroll
        for (int q = 0; q < 8; ++q) { const int cid = c0 + q * CP_NSL * NGW; ok[q] = cid < CP_NCH; dst[q] = nullptr; v[q] = (f32x4){0.f, 0.f, 0.f, 0.f};
            if (ok[q]) { const float* src; cp_decode(p, l, cid * 64 + lane, src, dst[q]); v[q] = __builtin_nontemporal_load((const f32x4*)src); } }
#pragma unroll
        for (int q = 0; q < 8; ++q) if (ok[q]) __builtin_nontemporal_store(v[q], (f32x4*)dst[q]);
    }
}
DI void copy_all(const Params& p, int l, int cpw, int NCPW, int lane) {
    for (int c0 = cpw; c0 < CP_NCH; c0 += 16 * NCPW) {
        f32x4 v[16]; float* dst[16];
#pragma unroll
        for (int q = 0; q < 16; ++q) { const int cid = c0 + q * NCPW; dst[q] = nullptr; v[q] = (f32x4){0.f, 0.f, 0.f, 0.f};
            if (cid < CP_NCH) { const float* src; cp_decode(p, l, cid * 64 + lane, src, dst[q]); v[q] = __builtin_nontemporal_load((const f32x4*)src); } }
#pragma unroll
        for (int q = 0; q < 16; ++q) if (dst[q]) __builtin_nontemporal_store(v[q], (f32x4*)dst[q]);
    }
}
DI void mixer_phase(const Params& p, LAS unsigned char* lds, int l, int gw, int NGW, int wave, int lane, int gt, int NT) {
    const bf16_t* ZG = (const bf16_t*)(p.ws + WS_ZG);
    bf16_t* BR = (bf16_t*)(p.ws + WS_BR); bf16_t* OB = (bf16_t*)(p.ws + WS_OB); float* LSE = (float*)(p.ws + WS_LSE);
    LAS unsigned char* qimg = lds + wave * 16896; LAS unsigned char* img = qimg + 12288;
    const int bid_ = gw >> 3, G_ = NGW >> 3;
    constexpr int NCMP = 5;
    if (wave >= NCMP) { copy_all(p, l, bid_ * (8 - NCMP) + (wave - NCMP), G_ * (8 - NCMP), lane); return; }
    gw = bid_ * NCMP + wave; NGW = G_ * NCMP; gt = bid_ * (NCMP * 64) + wave * 64 + lane; NT = G_ * (NCMP * 64);
#ifndef MIX_REP
#define MIX_REP 0
#endif
    for (int rep_ = 0; rep_ < ((MIX_REP & 1) ? 2 : 1); ++rep_)
    for (int u = gw; u < 8192; u += NGW) {
        const int gi = u >> 11, rem = u & 2047; const int ld = gi < 2 ? 0 : (gi == 2 ? 2 : 4), dil = 1 << ld, lnqb = 6 - ld;
        const int qb = rem & ((1 << lnqb) - 1), rem2 = rem >> lnqb, res = rem2 & (dil - 1), rem3 = rem2 >> ld, kvh = rem3 & 1, b = rem3 >> 1;
        attn_unit(qimg, img, ZG, b * 2048 + res, dil, qb, gi, kvh, gi == 0 ? BR : OB + (size_t)(gi - 1) * MPAD * BW, gi == 0 ? 4 * BW : BW, gi == 0 ? nullptr : LSE + (size_t)(gi - 1) * MPAD * 8, gi == 0 ? p.in[I_SINK] + l * 6 : nullptr, lane);
    }
    const bf16_t* Wm = (const bf16_t*)(p.ws + WS_WM) + (size_t)l * 6 * 128 * 128;
#if 0
#else
    for (int rep_ = 0; rep_ < ((MIX_REP & 2) ? 2 : 1); ++rep_)
    for (int u = gw; u < 6144; u += NGW) { const int ib = u & 3, g = (u >> 2) % 6, ch = u / 24; sg_unit(img, ZG, Wm, p.in[I_BSD] + l * 768, ch * 128, g, ib, BR + 3 * BW, 4 * BW, lane); }
#endif
    for (int rep_ = 0; rep_ < ((MIX_REP & 4) ? 2 : 1); ++rep_)
    for (int u = gw; u < 3072; u += NGW) {
        const int hq = u % 6, gi = (u / 6) & 3, b = u / 24; const int W = gi < 2 ? 128 : (gi == 2 ? 512 : 2048), dil = gi < 2 ? 1 : (gi == 2 ? 4 : 16);
        const float* cache = (gi == 0 ? p.in[I_CA] : (gi == 1 ? p.in[I_CB1] : (gi == 2 ? p.in[I_CB2] : p.in[I_CB3]))) + (size_t)l * 256 * W * 128;
        sattn_unit(ZG, cache, W, dil, b, gi, hq, gi == 0 ? BR : OB + (size_t)(gi - 1) * MPAD * BW, gi == 0 ? 4 * BW : BW, gi == 0 ? nullptr : LSE + (size_t)(gi - 1) * MPAD * 8, gi == 0 ? p.in[I_SINK] + l * 6 : nullptr, lane);
    }
    const float* cw = p.in[I_CONV] + l * 3 * BW;
    for (int it = gt; it < (MP / 16) * 48; it += NT) {
        const int run = it / 48, c0 = (it % 48) * 8, m0 = run * 16, t0 = m0 & 2047;
        float w0[8], w1[8], w2[8], z1[8], z2[8];
#pragma unroll
        for (int e = 0; e < 8; ++e) { w0[e] = cw[c0 + e]; w1[e] = cw[BW + c0 + e]; w2[e] = cw[2 * BW + c0 + e]; z1[e] = 0.f; z2[e] = 0.f; }
        if (t0 >= 2) { float a[8], bb[8]; const bf16_t* zr = ZG + (size_t)(m0 - 1) * ZLD;
            unpack8(*(const u32x4*)(zr + 2944 + c0), a); unpack8(*(const u32x4*)(zr + 3328 + c0), bb);
#pragma unroll
            for (int e = 0; e < 8; ++e) z1[e] = a[e] * bb[e];
            unpack8(*(const u32x4*)(zr - ZLD + 2944 + c0), a); unpack8(*(const u32x4*)(zr - ZLD + 3328 + c0), bb);
#pragma unroll
            for (int e = 0; e < 8; ++e) z2[e] = a[e] * bb[e]; }
        for (int b4 = 0; b4 < 4; ++b4) {
            u32x4 rb[4], rc[4], rx[4];
#pragma unroll
            for (int j = 0; j < 4; ++j) { const bf16_t* zr = ZG + (size_t)(m0 + 4 * b4 + j) * ZLD; rb[j] = *(const u32x4*)(zr + 2560 + c0); rc[j] = *(const u32x4*)(zr + 2944 + c0); rx[j] = *(const u32x4*)(zr + 3328 + c0); }
#pragma unroll
            for (int j = 0; j < 4; ++j) {
                const int m = m0 + 4 * b4 + j, t = t0 + 4 * b4 + j;
                float gb[8], gc[8], xc[8], zc[8], oc[8]; unpack8(rb[j], gb); unpack8(rc[j], gc); unpack8(rx[j], xc);
#pragma unroll
                for (int e = 0; e < 8; ++e) { zc[e] = gc[e] * xc[e]; oc[e] = gb[e] * (w0[e] * z2[e] + w1[e] * z1[e] + w2[e] * zc[e]); z2[e] = z1[e]; z1[e] = zc[e]; }
                *(u32x4*)(BR + (size_t)m * (4 * BW) + 2 * BW + c0) = pack8(oc);
                if (t >= 2046) { float* d = p.out + O_CP + ((size_t)(l * 16 + (m >> 11)) * 2 + (t - 2046)) * BW + c0; *(f32x4*)d = (f32x4){zc[0], zc[1], zc[2], zc[3]}; *(f32x4*)(d + 4) = (f32x4){zc[4], zc[5], zc[6], zc[7]}; }
            }
        }
    }
    for (int it = gt; it < MS * 48; it += NT) {
        const int b = it / 48, c0 = (it % 48) * 8, m = MP + b;
        const bf16_t* zrow = ZG + (size_t)m * ZLD;
        float gb[8], gc[8], xc[8], uu[8], vv[8], oc[8], od[8];
        unpack8(*(const u32x4*)(zrow + 2560 + c0), gb); unpack8(*(const u32x4*)(zrow + 2944 + c0), gc); unpack8(*(const u32x4*)(zrow + 3328 + c0), xc);
        unpack8(*(const u32x4*)(zrow + 3712 + c0), uu); unpack8(*(const u32x4*)(zrow + 4096 + c0), vv);
        const float* s = p.in[I_SC] + ((size_t)(l * 128 + b) * 2) * BW + c0;
        const int g = c0 >> 6; const float w00 = p.in[I_WSD][((size_t)l * 6 + g) * 16384], b0 = p.in[I_BSD][l * 768 + g * 128];
        float* dc = p.out + O_CS + ((size_t)(l * 128 + b) * 2) * BW + c0; float* dd = p.out + O_DS + (size_t)(l * 128 + b) * BW + c0;
#pragma unroll
        for (int e = 0; e < 8; ++e) { const float zc = gc[e] * xc[e]; oc[e] = gb[e] * (cw[c0 + e] * s[e] + cw[BW + c0 + e] * s[BW + e] + cw[2 * BW + c0 + e] * zc); od[e] = uu[e] * (w00 * vv[e] + b0);
            dc[e] = s[BW + e]; dc[BW + e] = zc; dd[e] = vv[e]; }
        *(u32x4*)(BR + (size_t)m * (4 * BW) + 2 * BW + c0) = pack8(oc);
        *(u32x4*)(BR + (size_t)m * (4 * BW) + 3 * BW + c0) = pack8(od);
    }
}
DI void merge_phase(const Params& p, int gt, int NT) {
    bf16_t* BR = (bf16_t*)(p.ws + WS_BR); const bf16_t* OB = (const bf16_t*)(p.ws + WS_OB); const float* LSE = (const float*)(p.ws + WS_LSE);
    for (int it = gt; it < MTOK * 48; it += NT) {
        const int m = it / 48, cch = it % 48, head = cch >> 3;
        const float l0 = LSE[(size_t)m * 8 + head], l1 = LSE[(size_t)MPAD * 8 + (size_t)m * 8 + head], l2 = LSE[2ull * MPAD * 8 + (size_t)m * 8 + head];
        const float mx = fmaxf(l0, fmaxf(l1, l2)); float w0 = __expf(l0 - mx), w1 = __expf(l1 - mx), w2 = __expf(l2 - mx); const float inv = 1.0f / (w0 + w1 + w2); w0 *= inv; w1 *= inv; w2 *= inv;
        float a[8], b[8], c[8], o[8];
        unpack8(*(const u32x4*)(OB + (size_t)m * BW + cch * 8), a); unpack8(*(const u32x4*)(OB + (size_t)MPAD * BW + (size_t)m * BW + cch * 8), b); unpack8(*(const u32x4*)(OB + 2ull * MPAD * BW + (size_t)m * BW + cch * 8), c);
#pragma unroll
        for (int e = 0; e < 8; ++e) o[e] = w0 * a[e] + w1 * b[e] + w2 * c[e];
        *(u32x4*)(BR + (size_t)m * (4 * BW) + BW + cch * 8) = pack8(o);
    }
}
constexpr int NPH = 20;
DI void grid_barrier(unsigned* bar, unsigned target, int wave_s) {
    __syncthreads();
    if (wave_s == 0) {
        if (__builtin_amdgcn_mbcnt_hi(~0u, __builtin_amdgcn_mbcnt_lo(~0u, 0u)) == 0u) {
            __builtin_amdgcn_fence(__ATOMIC_RELEASE, "agent");
            __hip_atomic_fetch_add(bar, 1u, __ATOMIC_RELAXED, __HIP_MEMORY_SCOPE_AGENT);
            while (__hip_atomic_load(bar, __ATOMIC_RELAXED, __HIP_MEMORY_SCOPE_AGENT) < target) __builtin_amdgcn_s_sleep(1);
        }
        __builtin_amdgcn_fence(__ATOMIC_ACQUIRE, "agent");
    }
    __syncthreads();
}
#ifndef DEBUG_CHK
#define DEBUG_CHK 0
#endif
#if DEBUG_CHK
DI const float* xin_row(const Params& p, int m) { return m < MP ? p.in[I_XP] + (size_t)m * 1024 : p.in[I_XS] + (size_t)(m - MP) * 1024; }
DI void dbg_phase(const Params& p, int kind_in, int gw, int NGW, int lane, int gt, int NT) {
    const int L = (kind_in >= 10 && kind_in < 20) ? 1 : 0, kind = kind_in == 99 ? 99 : kind_in - 10 * L;
    float* dbg = (float*)(p.ws + WS_BAR + 128);
    const bf16_t* ZG = (const bf16_t*)(p.ws + WS_ZG); const bf16_t* BR = (const bf16_t*)(p.ws + WS_BR); const bf16_t* MRG = (const bf16_t*)(p.ws + WS_MRG);
    const bf16_t* H = (const bf16_t*)(p.ws + WS_H); const bf16_t* ACT = (const bf16_t*)(p.ws + WS_ACT); const float* X = (const float*)(p.ws + WS_X);
    if (kind == 99) {
        int code = 0;
        for (int k = 1; k <= 7; ++k) if (code == 0 && dbg[k] > 1e-3f * dbg[8 + k]) code = k;
        if (code) { const float a = 1.0f + 0.1f * sqrtf((float)code); for (int i = gt; i < 98304; i += NT) p.out[O_DS + i] *= a; }
        return;
    }
    for (int s = gw; s < 16384; s += NGW) {
        const int m = MP + (int)(((unsigned)s * 2654435761u) % 128u), ci = s & 7; const unsigned hsh = (unsigned)s * 40503u + 12345u; float fast = 0.f, naive = 0.f;
        const float* xr = L ? X + (size_t)m * 1024 : xin_row(p, m);
        if (kind == 1) {
            int c = (int)(hsh % 8576u); if (c >= 4480) c += 128;
            float ss = 0.f; for (int k = lane; k < 1024; k += 64) ss += xr[k] * xr[k];
            const float rs = 1.0f / sqrtf(wave_sum(ss) * (1.f / 1024.f) + EPS); float acc = 0.f;
            for (int k = lane; k < 1024; k += 64) { const float hv = xr[k] * rs * p.in[I_LN1][L * 1024 + k];
                acc += hv * (c < GOFF ? p.in[I_WIN][(size_t)L * 1024 * 4480 + (size_t)k * 4480 + c] : p.in[I_WG][(size_t)L * 4 * 1048576 + ((size_t)((c - GOFF) >> 10) * 1024 + k) * 1024 + ((c - GOFF) & 1023)]); }
            acc = wave_sum(acc); naive = c < GOFF ? acc : 1.0f / (1.0f + __expf(-(acc + p.in[I_BG][L * 4096 + c - GOFF])));
            fast = bf1(ZG[(size_t)m * ZLD + c]);
        } else if (kind == 2 || kind == 3 || kind == 6) {
            const int c = (int)(hsh & 1023u);
            float v = 0.f;
            if (kind == 2) {
                for (int n = 0; n < 4; ++n) { float acc = 0.f; for (int k = lane; k < 384; k += 64) acc += bf1(BR[((size_t)n * MPAD + m) * BW + k]) * p.in[I_WB][(size_t)L * 4 * 384 * 1024 + ((size_t)n * 384 + k) * 1024 + c];
                    v += bf1(ZG[(size_t)m * ZLD + GOFF + n * 1024 + c]) * wave_sum(acc); }
                naive = v; fast = bf1(MRG[(size_t)m * 1024 + c]);
            } else {
                float acc = 0.f; for (int k = lane; k < 1024; k += 64) acc += bf1(MRG[(size_t)m * 1024 + k]) * p.in[I_WO][(size_t)k * 1024 + c];
                v = xr[c] + wave_sum(acc);
                if (kind == 6) { float a2 = 0.f; for (int k = lane; k < DFF; k += 64) a2 += bf1(ACT[(size_t)m * DFF + k]) * p.in[I_WFO][(size_t)k * 1024 + c]; v += wave_sum(a2); }
                naive = v; fast = X[(size_t)m * 1024 + c];
            }
        } else if (kind == 7) {
            const int hs = (int)(hsh & 31u), gi = hs >> 3, hh = hs & 7, col0 = gi * 640 + hh * 64;
            float ss = 0.f; for (int k = lane; k < 1024; k += 64) ss += xr[k] * xr[k];
            const float rs = 1.0f / sqrtf(wave_sum(ss) * (1.f / 1024.f) + EPS); float z = 0.f;
            for (int k = 0; k < 1024; ++k) z += xr[k] * rs * p.in[I_LN1][k] * p.in[I_WIN][(size_t)k * 4480 + col0 + lane];
            const float r2 = 1.0f / sqrtf(wave_sum(z * z) * (1.f / 64.f) + EPS);
            const float* gn = hh < 6 ? (gi == 0 ? p.in[I_QNA] : p.in[I_QNB] + (gi - 1) * 64) : (gi == 0 ? p.in[I_KNA] : p.in[I_KNB] + (gi - 1) * 64);
            float y = z * r2 * gn[lane];
            const float pos = m >= MP ? 16384.f : (float)(m & 2047); const float ang = pos * INV_FREQ[lane & 7];
            const float other = __shfl_xor(y, 8);
            if (lane < 8) y = y * cosf(ang) - other * sinf(ang); else if (lane < 16) y = y * cosf(ang) + other * sinf(ang);
            naive = y; fast = bf1(ZG[(size_t)m * ZLD + col0 + lane]);
            atomicAdd(&dbg[kind], (fast - naive) * (fast - naive)); atomicAdd(&dbg[8 + kind], naive * naive); continue;
        } else if (kind == 7 + 100) {
        } else if (kind == 9) {
            const int b = m - MP, hq = (int)(hsh % 6u), gi = (int)((hsh >> 8) & 3u), kvh = hq / 3, W = gi < 2 ? 128 : (gi == 2 ? 512 : 2048), dil = gi < 2 ? 1 : (gi == 2 ? 4 : 16);
            const float* cache = (gi == 0 ? p.in[I_CA] : (gi == 1 ? p.in[I_CB1] : (gi == 2 ? p.in[I_CB2] : p.in[I_CB3])));
            const float* Kc = cache + ((size_t)(b * 2 + 0) * W) * 128 + kvh * 64; const float* Vc = cache + ((size_t)(b * 2 + 1) * W) * 128 + kvh * 64;
            const bf16_t* zr = ZG + (size_t)m * ZLD + gi * 640; const bf16_t* qp = zr + hq * 64;
            float sc[3], pv[3]; float mx = -1e30f;
            for (int j = 0; j < 3; ++j) { const int n = j < 2 ? 1 + lane + 64 * j : 0; const bool ok = j < 2 || lane == 0; float dsum = 0.f;
                if (ok) { for (int e = 0; e < 64; ++e) dsum += bf1(qp[e]) * (n == 0 ? bf1(zr[384 + kvh * 64 + e]) : Kc[(size_t)(W - n * dil) * 128 + e]); }
                sc[j] = ok ? dsum * 0.125f : -1e30f; mx = fmaxf(mx, sc[j]); }
            mx = wave_max(mx); float ls = 0.f;
            for (int j = 0; j < 3; ++j) { pv[j] = sc[j] > -1e29f ? __expf(sc[j] - mx) : 0.f; ls += pv[j]; }
            ls = wave_sum(ls); if (gi == 0) ls += __expf(p.in[I_SINK][hq] - mx);
            const bf16_t* fo = (gi == 0 ? BR : (const bf16_t*)(p.ws + WS_OB) + (size_t)(gi - 1) * MPAD * BW) + (size_t)m * BW + hq * 64;
            for (int dd = 0; dd < 8; ++dd) { float a = 0.f;
                for (int j = 0; j < 3; ++j) { const int n = j < 2 ? 1 + lane + 64 * j : 0; if (pv[j] > 0.f) a += pv[j] * (n == 0 ? bf1(zr[512 + kvh * 64 + dd]) : Vc[(size_t)(W - n * dil) * 128 + dd]); }
                a = wave_sum(a) / ls; const float f = bf1(fo[dd]);
                if (lane == 0) { atomicAdd(&dbg[7], (f - a) * (f - a)); atomicAdd(&dbg[15], a * a); } }
            continue;
        } else if (kind == 8) {
            const int mm = (int)(((unsigned)s * 2654435761u) % (unsigned)MP), hq = (int)(hsh % 6u), gi = (int)((hsh >> 8) & 3u), t = mm & 2047, dil = gi < 2 ? 1 : (gi == 2 ? 4 : 16), kvh = hq / 3;
            const bf16_t* qp = ZG + (size_t)mm * ZLD + gi * 640 + hq * 64;
            float sc[3], pv[3]; float mx = -1e30f;
            for (int j = 0; j < 3; ++j) { const int n = j < 2 ? lane + 64 * j : 128; const bool ok = (j < 2 || lane == 0) && (t - n * dil >= 0); float dsum = 0.f;
                if (ok) { const bf16_t* kp = ZG + (size_t)(mm - n * dil) * ZLD + gi * 640 + 384 + kvh * 64; for (int e = 0; e < 64; ++e) dsum += bf1(qp[e]) * bf1(kp[e]); }
                sc[j] = ok ? dsum * 0.125f : -1e30f; mx = fmaxf(mx, sc[j]); }
            mx = wave_max(mx); float ls = 0.f;
            for (int j = 0; j < 3; ++j) { pv[j] = sc[j] > -1e29f ? __expf(sc[j] - mx) : 0.f; ls += pv[j]; }
            ls = wave_sum(ls); if (gi == 0) ls += __expf(p.in[I_SINK][hq] - mx);
            const bf16_t* fo = (gi == 0 ? BR : (const bf16_t*)(p.ws + WS_OB) + (size_t)(gi - 1) * MPAD * BW) + (size_t)mm * BW + hq * 64;
            for (int dd = 0; dd < 8; ++dd) { float a = 0.f;
                for (int j = 0; j < 3; ++j) { const int n = j < 2 ? lane + 64 * j : 128; if (pv[j] > 0.f) a += pv[j] * bf1(ZG[(size_t)(mm - n * dil) * ZLD + gi * 640 + 512 + kvh * 64 + dd]); }
                a = wave_sum(a) / ls; const float f = bf1(fo[dd]);
                if (lane == 0) { atomicAdd(&dbg[gi], (f - a) * (f - a)); atomicAdd(&dbg[8 + gi], a * a); } }
            if (gi > 0 && lane == 0) { const float lf = ((const float*)(p.ws + WS_LSE))[(size_t)(gi - 1) * MPAD * 8 + (size_t)mm * 8 + hq], ln = mx + __logf(ls); atomicAdd(&dbg[4], (lf - ln) * (lf - ln)); atomicAdd(&dbg[12], 1.0f); }
            continue;
        } else if (kind == 4) {
            const int c = (int)(hsh & 1023u); const float* xx = X + (size_t)m * 1024;
            float ss = 0.f; for (int k = lane; k < 1024; k += 64) ss += xx[k] * xx[k];
            const float rs = 1.0f / sqrtf(wave_sum(ss) * (1.f / 1024.f) + EPS); naive = xx[c] * rs * p.in[I_LN2][L * 1024 + c]; fast = bf1(H[(size_t)m * 1024 + c]);
        } else if (kind == 5) {
            const int c = (int)(hsh % 2816u);
            float a1 = 0.f, a2 = 0.f; for (int k = lane; k < 1024; k += 64) { const float hv = bf1(H[(size_t)m * 1024 + k]); a1 += hv * p.in[I_WFI][(size_t)L * 1024 * 5632 + (size_t)k * 5632 + c]; a2 += hv * p.in[I_WFI][(size_t)L * 1024 * 5632 + (size_t)k * 5632 + DFF + c]; }
            a1 = wave_sum(a1); a2 = wave_sum(a2); naive = a1 / (1.0f + __expf(-a1)) * a2; fast = bf1(ACT[(size_t)m * DFF + c]);
        }
        if (lane == 0) { atomicAdd(&dbg[kind], (fast - naive) * (fast - naive)); atomicAdd(&dbg[8 + kind], naive * naive); }
    }
}
#endif
template <int PH> DI void run_phase(const Params& p0, LAS unsigned char* lds, int wave_s) {
    Params p;
    { int z_ = 0; asm volatile("" : "+s"(z_));
#pragma unroll
      for (int i = 0; i < 24; ++i) p.in[i] = p0.in[i + z_];
      p.out = (&p0.out)[z_]; p.ws = (&p0.ws)[z_]; p.ph_lo = 0; p.ph_hi = 0; }
    int tid = wave_s * 64 + (int)__builtin_amdgcn_mbcnt_hi(~0u, __builtin_amdgcn_mbcnt_lo(~0u, 0u)); asm volatile("" : "+v"(tid));
    const int G = gridDim.x, bid = blockIdx.x, NGW = G * 8, NT = G * 512;
    const int lane = tid & 63, wave = wave_s, gw = bid * 8 + wave, gt = bid * 512 + tid;
    float* X = (float*)(p.ws + WS_X); bf16_t* H = (bf16_t*)(p.ws + WS_H); bf16_t* ZG = (bf16_t*)(p.ws + WS_ZG);
    if constexpr (PH == 0) {
        prologue_weights(p, lds, gw, NGW, wave, lane);
        prologue_misc(p, gt, NT);
        norm_phase(p.in[I_XP], p.in[I_XS], X, p.in[I_LN1], H, gw, NGW, lane);
    } else {
        constexpr int l = (PH - 1) / 10, k = (PH - 1) % 10;
        unsigned char* wl = p.ws + WS_W + (size_t)l * WL_B;
        const bf16_t* W1t = (const bf16_t*)wl; const bf16_t* Wbt = (const bf16_t*)(wl + W1_B); const bf16_t* Wot = (const bf16_t*)(wl + W1_B + WB_B);
        const bf16_t* Wft = (const bf16_t*)(wl + W1_B + WB_B + WO_B); const bf16_t* Wdt = (const bf16_t*)(wl + W1_B + WB_B + WO_B + WF_B);
        if constexpr (k == 0) {
            pg8::Gemm g{H, W1t, MPAD, ZLD, 1024}; pg8::StaticOrder S; S.init(MPAD, ZLD, G, bid);
            EpiZG E{ZG, p.in[I_BG] + (size_t)l * 4096, (const float*)(p.ws + WS_ROPE), p.in[I_QNA] + l * 64, p.in[I_KNA] + l * 64, p.in[I_QNB] + l * 192, p.in[I_KNB] + l * 192, p.out, l};
            pg8::gemm_phase<EpiZG, pg8::StaticOrder, PG8_ALIGN, PG8_SP2>(lds, g, S, E, tid);
        } else if constexpr (k == 1) {
        } else if constexpr (k == 2) {
            mixer_phase(p, lds, l, gw, NGW, wave, lane, gt, NT);
        } else if constexpr (k == 3) {
            merge_phase(p, gt, NT);
        } else if constexpr (k == 4) {
            pg8::Gemm g{(const bf16_t*)(p.ws + WS_BR), Wbt, MPAD, 1024, 4 * BW}; pg8::StaticOrder S; S.init(MPAD, 1024, G, bid);
            EpiBranch E{ZG, (bf16_t*)(p.ws + WS_MRG)};
            pg8::gemm_phase<EpiBranch, pg8::StaticOrder, PG8_ALIGN, PG8_SP2>(lds, g, S, E, tid);
        } else if constexpr (k == 5) {
            pg8::Gemm g{(const bf16_t*)(p.ws + WS_MRG), Wot, MPAD, 1024, 1024}; pg8::StaticOrder S; S.init(MPAD, 1024, G, bid);
            EpiResid E{X, X, MPAD};
            pg8::gemm_phase<EpiResid, pg8::StaticOrder, PG8_ALIGN, PG8_SP2>(lds, g, S, E, tid);
        } else if constexpr (k == 6) {
            norm_phase(X, nullptr, nullptr, p.in[I_LN2] + l * 1024, H, gw, NGW, lane);
        } else if constexpr (k == 7) {
            pg8::Gemm g{H, Wft, MPAD, 2 * DFF, 1024}; pg8::StaticOrder S; S.init(MPAD, 2 * DFF, G, bid);
            EpiSwiglu E{(bf16_t*)(p.ws + WS_ACT)};
            pg8::gemm_phase<EpiSwiglu, pg8::StaticOrder, PG8_ALIGN, PG8_SP2>(lds, g, S, E, tid);
        } else if constexpr (k == 8) {
            pg8::Gemm g{(const bf16_t*)(p.ws + WS_ACT), Wdt, MPAD, 1024, DFF}; pg8::StaticOrder S; S.init(MPAD, 1024, G, bid);
            EpiResid E{X, l == 1 ? p.out : X, l == 1 ? MTOK : MPAD};
            pg8::gemm_phase<EpiResid, pg8::StaticOrder, PG8_ALIGN, PG8_SP2>(lds, g, S, E, tid);
        } else {
            if constexpr (l == 0) norm_phase(X, nullptr, nullptr, p.in[I_LN1] + 1024, H, gw, NGW, lane);
        }
    }
}
__global__ void __launch_bounds__(512, 2) fwd_kernel(Params p) {
    extern __shared__ __attribute__((aligned(16))) unsigned char lds_raw[];
    LAS unsigned char* lds = (LAS unsigned char*)lds_raw;
    const int wave_s = __builtin_amdgcn_readfirstlane(threadIdx.x >> 6);
    unsigned* bar = (unsigned*)(p.ws + WS_BAR); const unsigned nblk = gridDim.x;
    if (p.ph_hi - p.ph_lo > 1) cg::this_grid().sync();
#if DEBUG_CHK
    if (p.ph_lo >= 100) { const int tid = threadIdx.x; dbg_phase(p, p.ph_lo - 100, blockIdx.x * 8 + wave_s, gridDim.x * 8, tid & 63, blockIdx.x * 512 + tid, gridDim.x * 512); return; }
#endif
#ifndef REP_MASK
#define REP_MASK 0u
#endif
#define EMPTYPH(K) ((K) == 2 || (K) == 12)
#define NEMPTY(K) ((unsigned)(((K) > 2) + ((K) > 12)))
#define RUN(K) if (!EMPTYPH(K) && p.ph_lo <= (K) && (K) < p.ph_hi) { if ((K) > p.ph_lo) grid_barrier(bar, ((unsigned)((K) - p.ph_lo) - NEMPTY(K)) * nblk, wave_s); run_phase<(K)>(p, lds, wave_s); }
    RUN(0) RUN(1) RUN(2) RUN(3) RUN(4) RUN(5) RUN(6) RUN(7) RUN(8) RUN(9) RUN(10) RUN(11) RUN(12) RUN(13) RUN(14) RUN(15) RUN(16) RUN(17) RUN(18) RUN(19)
#undef RUN
}
}

extern "C" void kernel_launch(void* const* d_in, const int* in_sizes, int n_in, void* d_out, int out_size, void* d_ws, size_t ws_size, hipStream_t stream) {
    static int grid = 0;
    if (grid == 0) {
        if (n_in != 24 || (size_t)out_size != mk::O_END || ws_size < mk::WS_END) { fprintf(stderr, "kernel_launch: unexpected shapes: n_in %d out %d ws %zu (need %zu)\n", n_in, out_size, ws_size, (size_t)mk::WS_END); grid = -1; return; }
        int dev = 0, cus = 0, per_cu = 0;
        if (hipGetDevice(&dev) != hipSuccess || hipDeviceGetAttribute(&cus, hipDeviceAttributeMultiprocessorCount, dev) != hipSuccess) { fprintf(stderr, "kernel_launch: device query failed\n"); grid = -1; return; }
        if (hipFuncSetAttribute((const void*)mk::fwd_kernel, hipFuncAttributeMaxDynamicSharedMemorySize, mk::LDS_BYTES) != hipSuccess) { fprintf(stderr, "kernel_launch: hipFuncSetAttribute failed\n"); grid = -1; return; }
        if (hipOccupancyMaxActiveBlocksPerMultiprocessor(&per_cu, (const void*)mk::fwd_kernel, 512, mk::LDS_BYTES) != hipSuccess || per_cu < 1) { fprintf(stderr, "kernel_launch: occupancy query gave %d\n", per_cu); per_cu = 1; }
        (void)hipGetLastError();
        grid = cus * 1;
    }
    if (grid < 0) return;
    if (hipMemsetAsync((char*)d_ws + mk::WS_BAR, 0, 256, stream) != hipSuccess) { fprintf(stderr, "kernel_launch: memset failed\n"); return; }
    mk::Params p{};
    for (int i = 0; i < 24; ++i) p.in[i] = (const float*)d_in[i];
    p.out = (float*)d_out; p.ws = (unsigned char*)d_ws;
#if ONE_LAUNCH
    p.ph_lo = 0; p.ph_hi = mk::NPH;
    void* args[] = {&p};
    hipError_t e = hipLaunchCooperativeKernel((const void*)mk::fwd_kernel, dim3(grid), dim3(512), args, mk::LDS_BYTES, stream);
    if (e != hipSuccess) fprintf(stderr, "kernel_launch: cooperative launch failed: %s (grid %d)\n", hipGetErrorString(e), grid);
#else
    for (int ph = 0; ph < mk::NPH; ++ph) {
        p.ph_lo = ph; p.ph_hi = ph + 1;
        hipLaunchKernelGGL(mk::fwd_kernel, dim3(grid), dim3(512), mk::LDS_BYTES, stream, p);
#if DEBUG_CHK
        const int kind = ph == 1 ? 1 : ph == 3 ? 9 : ph == 5 ? 2 : ph == 6 ? 3 : ph == 7 ? 4 : ph == 8 ? 5 : ph == 9 ? 6 : 0;
        if (kind) { p.ph_lo = 100 + kind; p.ph_hi = 101 + kind; hipLaunchKernelGGL(mk::fwd_kernel, dim3(grid), dim3(512), mk::LDS_BYTES, stream, p); }
#endif
    }
#if DEBUG_CHK
    p.ph_lo = 199; p.ph_hi = 200; hipLaunchKernelGGL(mk::fwd_kernel, dim3(grid), dim3(512), mk::LDS_BYTES, stream, p);
#endif
#endif
}
```

```cpp
#include <hip/hip_runtime.h>
#include <hip/hip_cooperative_groups.h>
#include <cstdio>
#include <cstdint>
namespace cg = cooperative_groups;
#ifndef ONE_LAUNCH
#define ONE_LAUNCH 1
#endif
namespace pg8 {
#define PG8_LAS __attribute__((address_space(3)))
typedef unsigned short bf16_t;
typedef short bf16x8 __attribute__((ext_vector_type(8)));
typedef float f32x4 __attribute__((ext_vector_type(4)));
typedef unsigned u32x4 __attribute__((ext_vector_type(4)));
constexpr int BM = 256, BK = 64, HALF = 128, HTB = HALF * BK * 2  , STAGE_BYTES = 8 * HTB, NXCD = 8, WGM = 8;

__host__ __device__ __forceinline__ int lds_byte(int r, int c) { const int st = (r >> 4) * 2 + (c >> 5), rr = r & 15, cc = c & 31, ob = rr * 64 + cc * 2; return st * 1024 + (ob ^ (((ob >> 9) & 1) << 5)); }
__host__ __device__ __forceinline__ void stage_rc(int b, int& R, int& C) { const int st = b / 1024, sb = b % 1024, swz = sb ^ (((sb >> 9) & 1) << 5); R = (st >> 1) * 16 + swz / 64; C = (st & 1) * 32 + (swz % 64) / 2; }
__host__ __device__ __forceinline__ int perm32(int rho) { const int n = rho >> 4, i = rho & 15; return 8 * (i >> 2) + 4 * n + (i & 3); }

struct Unit { int pm, pn; };
struct Gemm { const bf16_t* A; const bf16_t* Bt; int M, N, K; };

struct StaticOrder {
    int nM, nN, nwg, G, c;
    __host__ __device__ void init(int M, int N, int G_, int c_) { nM = M / BM; nN = N / BM; nwg = nM * nN; G = G_; c = c_; }
    __host__ __device__ bool next(int i, Unit& u) const {
        const long L = (long)i * G + c; if (L >= nwg) return false;
        int wgid = (int)L; { const int q = nwg / NXCD, r = nwg % NXCD, xcd = wgid % NXCD, off = wgid / NXCD; wgid = (xcd < r ? xcd * (q + 1) : r * (q + 1) + (xcd - r) * q) + off; }
        const int nig = WGM * nN, gid = wgid / nig, fm = gid * WGM, gsz = (nM - fm) < WGM ? (nM - fm) : WGM;
        u.pm = fm + ((wgid % nig) % gsz); u.pn = (wgid % nig) / gsz; return true;
    }
    __device__ __forceinline__ void a_ready(const Unit&) const {}
    __device__ __forceinline__ void done(const Unit&) const {}
};

__device__ __forceinline__ unsigned cvt_pk_bf16(float lo, float hi) { unsigned r; asm volatile("v_cvt_pk_bf16_f32 %0, %1, %2" : "=v"(r) : "v"(lo), "v"(hi)); return r; }
typedef float f32x2 __attribute__((ext_vector_type(2)));
__device__ __forceinline__ f32x2 gelu_pk(f32x2 v) {
    const f32x2 av = __builtin_elementwise_abs(v), d = av * 0.2316418882f + 1.0f;
    f32x2 t; t.x = __builtin_amdgcn_rcpf(d.x); t.y = __builtin_amdgcn_rcpf(d.y);
    f32x2 q = t * 0.5307027145f + (-0.7265760135f); q = q * t + 0.7107068705f; q = q * t + (-0.142248368f); q = q * t + 0.127414796f; q = q * t;
    const f32x2 s = (v * v) * (-0.72134752044f);
    f32x2 e; e.x = __builtin_amdgcn_exp2f(s.x); e.y = __builtin_amdgcn_exp2f(s.y);
    const f32x2 m = v * (q * e), r = v - m;
    f32x2 o; o.x = v.x < 0.f ? m.x : r.x; o.y = v.y < 0.f ? m.y : r.y; return o;
}

template <int ACT  > struct EpiBf16 {
    static constexpr bool PERM = true, AFTER_DRAIN = false; static_assert(ACT == 0 || ACT == 1, "EpiBf16: ACT is 0 (none) or 1 (gelu_pk)");
    bf16_t* O; int ldc; const float* bias; int split_cols; size_t split_stride; float scale0;
    __device__ __forceinline__ void operator()(const f32x4 (&acc)[2][2][4][2], const Unit& u, int wr, int wc, int fr, int fq) const {
        const int row0 = u.pm * BM + wr * 64 + fr; int colt = u.pn * BM; bf16_t* base = O;
        float sc = 1.f; if (split_cols) { const int t = colt / split_cols; base += (size_t)t * split_stride; colt -= t * split_cols; if (t == 0) sc = scale0; }
        const int col0 = colt + wc * 32 + 8 * fq, bcol0 = u.pn * BM + wc * 32 + 8 * fq;
        f32x4 bv[2][2];
#pragma unroll
        for (int bj = 0; bj < 2; ++bj)
#pragma unroll
            for (int n = 0; n < 2; ++n) bv[bj][n] = bias ? *(const f32x4*)(bias + bcol0 + bj * HALF + 4 * n) : (f32x4){0.f, 0.f, 0.f, 0.f};
#pragma unroll
        for (int ai = 0; ai < 2; ++ai)
#pragma unroll
            for (int m = 0; m < 4; ++m) { bf16_t* rowp = base + (size_t)(row0 + ai * HALF + m * 16) * ldc + col0;
#pragma unroll
                for (int bj = 0; bj < 2; ++bj) { f32x4 v0 = acc[ai][bj][m][0] + bv[bj][0], v1 = acc[ai][bj][m][1] + bv[bj][1];
                    if (ACT == 1) { f32x2 a = gelu_pk((f32x2){v0[0], v0[1]}), b = gelu_pk((f32x2){v0[2], v0[3]}), c = gelu_pk((f32x2){v1[0], v1[1]}), d = gelu_pk((f32x2){v1[2], v1[3]});
                        v0 = (f32x4){a.x, a.y, b.x, b.y}; v1 = (f32x4){c.x, c.y, d.x, d.y}; }
                    v0 = v0 * sc; v1 = v1 * sc; u32x4 w; w.x = cvt_pk_bf16(v0[0], v0[1]); w.y = cvt_pk_bf16(v0[2], v0[3]); w.z = cvt_pk_bf16(v1[0], v1[1]); w.w = cvt_pk_bf16(v1[2], v1[3]);
                    *(u32x4*)(rowp + bj * HALF) = w; } }
    }
};

template <class Epi, class Sched, bool ALIGN_EPI = false, bool SP2 = false>
__device__ __forceinline__ void gemm_phase(PG8_LAS unsigned char* lds, const Gemm g, const Sched& S, const Epi& E, int tid_in) {
    int tid_l = tid_in; asm volatile("" : "+v"(tid_l));
    const int tid = tid_l, wid = __builtin_amdgcn_readfirstlane(tid >> 6), lane = tid & 63, wr = wid >> 2, wc = wid & 3, fr = lane & 15, fq = lane >> 4;
    const int K = g.K, nt = K / BK;
    unsigned voffA[2], voffB[2];
#pragma unroll
    for (int i = 0; i < 2; ++i) { int R, C; stage_rc(tid * 16 + i * 8192, R, C); const int Rb = Epi::PERM ? ((R & ~31) + perm32(R & 31)) : R;
        voffA[i] = (unsigned)(R * K + C) * 2u; voffB[i] = (unsigned)(Rb * K + C) * 2u; }
    const size_t kstep = (size_t)(BK * 2);
    const size_t hstep = (size_t)HALF * K * 2;
    const size_t tstep = 2 * hstep;
    const unsigned ldsw = (unsigned)wid * 1024u;
    const int aoff = lds_byte(wr * 64 + fr, fq * 8), boff = lds_byte(wc * 32 + fr, fq * 8);
#define PG8_SA(b, h) (((b) * 2 + (h)) * HTB)
#define PG8_SB(b, h) ((4 + (b) * 2 + (h)) * HTB)
#define PG8_STAGE(bufoff, gbase, voff) do { _Pragma("unroll") for (int _i = 0; _i < 2; ++_i) \
        __builtin_amdgcn_global_load_lds((const unsigned*)((const char*)(gbase) + (voff)[_i]), (PG8_LAS unsigned*)(lds + (bufoff) + ldsw + _i * 8192), 16, 0, 0); } while (0)
#define PG8_LDA(dst, b, h) do { _Pragma("unroll") for (int m = 0; m < 4; ++m) _Pragma("unroll") for (int k = 0; k < 2; ++k) dst[m][k] = *(const PG8_LAS bf16x8*)(lds + PG8_SA(b, h) + aoff + m * 2048 + k * 1024); } while (0)
#define PG8_LDB(dst, b, h) do { _Pragma("unroll") for (int n = 0; n < 2; ++n) _Pragma("unroll") for (int k = 0; k < 2; ++k) dst[n][k] = *(const PG8_LAS bf16x8*)(lds + PG8_SB(b, h) + boff + n * 2048 + k * 1024); } while (0)
#define PG8_MMA(ai, bj, At, Bt) do { __builtin_amdgcn_s_setprio(1); _Pragma("unroll") for (int m = 0; m < 4; ++m) _Pragma("unroll") for (int n = 0; n < 2; ++n) _Pragma("unroll") for (int k = 0; k < 2; ++k) \
        acc[ai][bj][m][n] = __builtin_amdgcn_mfma_f32_16x16x32_bf16(Bt[n][k], At[m][k], acc[ai][bj][m][n], 0, 0, 0); __builtin_amdgcn_s_setprio(0); } while (0)
#define PG8_WAIT_V(n) asm volatile("s_waitcnt vmcnt(" #n ")" ::: "memory")
#define PG8_WAIT_L(n) asm volatile("s_waitcnt lgkmcnt(" #n ")" ::: "memory")
#define PG8_BAR __builtin_amdgcn_s_barrier()
#define PG8_SCHED __builtin_amdgcn_sched_barrier(0)
    Unit cur, nxt; int ui = 0;
    if (!S.next(0, cur)) return;
    f32x4 acc[2][2][4][2];
#pragma unroll
    for (int a = 0; a < 2; ++a)
#pragma unroll
        for (int b = 0; b < 2; ++b)
#pragma unroll
            for (int m = 0; m < 4; ++m)
#pragma unroll
                for (int n = 0; n < 2; ++n) acc[a][b][m][n] = (f32x4){0.f, 0.f, 0.f, 0.f};
    bf16x8 At[4][2], B0[2][2], B1[2][2];
    const char* cA = (const char*)g.A + (size_t)cur.pm * tstep; const char* cB = (const char*)g.Bt + (size_t)cur.pn * tstep;
    S.a_ready(cur);
    if constexpr (SP2) {
        PG8_STAGE(PG8_SB(0, 0), cB, voffB); PG8_STAGE(PG8_SB(0, 1), cB + hstep, voffB); PG8_STAGE(PG8_SA(0, 0), cA, voffA); PG8_STAGE(PG8_SA(0, 1), cA + hstep, voffA);
        if (wr == 1) PG8_BAR;
        PG8_WAIT_V(2); PG8_BAR;
        PG8_STAGE(PG8_SB(1, 0), cB + kstep, voffB); PG8_STAGE(PG8_SA(1, 0), cA + kstep, voffA); PG8_STAGE(PG8_SB(1, 1), cB + hstep + kstep, voffB);
        PG8_WAIT_V(6); PG8_BAR;
    } else {
        PG8_STAGE(PG8_SB(0, 0), cB, voffB); PG8_STAGE(PG8_SA(0, 0), cA, voffA); PG8_STAGE(PG8_SB(0, 1), cB + hstep, voffB); PG8_STAGE(PG8_SA(0, 1), cA + hstep, voffA);
        if (wr == 1) PG8_BAR;
        PG8_WAIT_V(4); PG8_BAR;
        PG8_STAGE(PG8_SB(1, 0), cB + kstep, voffB); PG8_STAGE(PG8_SA(1, 0), cA + kstep, voffA); PG8_STAGE(PG8_SB(1, 1), cB + hstep + kstep, voffB);
        PG8_WAIT_V(6); PG8_BAR;
    }
    for (;;) {
        const bool has_next = S.next(ui + 1, nxt);
        const char* nA = has_next ? (const char*)g.A + (size_t)nxt.pm * tstep : cA; const char* nB = has_next ? (const char*)g.Bt + (size_t)nxt.pn * tstep : cB;
        for (int t = 0; t < nt; t += 2) {
            if constexpr (Epi::SEGMENT_TILES > 0) { if (t > 0 && (t % Epi::SEGMENT_TILES) == 0) E.rescale(acc, cur, t / Epi::SEGMENT_TILES, wr, wc, fr, fq); }
            const bool last = (t == nt - 2);
            const char* a1 = cA + (size_t)(t + 1) * kstep;
            const char* a2 = last ? nA : cA + (size_t)(t + 2) * kstep; const char* b2 = last ? nB : cB + (size_t)(t + 2) * kstep;
            const char* a3 = a2 + kstep; const char* b3 = b2 + kstep;
            if (last && has_next) S.a_ready(nxt);
            if constexpr (SP2) {
            PG8_LDB(B0, 0, 0); PG8_LDB(B1, 0, 1); PG8_SCHED; PG8_LDA(At, 0, 0); PG8_STAGE(PG8_SA(1, 1), a1 + hstep, voffA);
            PG8_WAIT_V(8); PG8_WAIT_L(0); PG8_BAR; PG8_MMA(0, 0, At, B0); PG8_MMA(0, 1, At, B1); PG8_BAR; PG8_SCHED;
            PG8_LDA(At, 0, 1); PG8_STAGE(PG8_SB(0, 0), b2, voffB); PG8_STAGE(PG8_SB(0, 1), b2 + hstep, voffB); PG8_STAGE(PG8_SA(0, 0), a2, voffA);
            PG8_WAIT_V(8); PG8_WAIT_L(0); PG8_BAR; PG8_MMA(1, 0, At, B0); PG8_MMA(1, 1, At, B1); PG8_BAR; PG8_SCHED;
            PG8_LDB(B0, 1, 0); PG8_LDB(B1, 1, 1); PG8_SCHED; PG8_LDA(At, 1, 0); PG8_STAGE(PG8_SA(0, 1), a2 + hstep, voffA);
            PG8_WAIT_V(8); PG8_WAIT_L(0); PG8_BAR; PG8_MMA(0, 0, At, B0); PG8_MMA(0, 1, At, B1); PG8_BAR; PG8_SCHED;
            PG8_LDA(At, 1, 1); PG8_STAGE(PG8_SB(1, 0), b3, voffB); PG8_STAGE(PG8_SB(1, 1), b3 + hstep, voffB); PG8_STAGE(PG8_SA(1, 0), a3, voffA);
            PG8_WAIT_V(8); PG8_WAIT_L(0); PG8_BAR; PG8_MMA(1, 0, At, B0); PG8_MMA(1, 1, At, B1); PG8_BAR; PG8_SCHED;
            } else {
            PG8_LDB(B0, 0, 0); PG8_SCHED; PG8_LDA(At, 0, 0); PG8_STAGE(PG8_SA(1, 1), a1 + hstep, voffA);
            PG8_WAIT_L(8); PG8_BAR; PG8_WAIT_L(0); PG8_MMA(0, 0, At, B0); PG8_BAR; PG8_SCHED;
            PG8_LDB(B1, 0, 1); PG8_STAGE(PG8_SB(0, 0), b2, voffB);
            PG8_BAR; PG8_WAIT_L(0); PG8_MMA(0, 1, At, B1); PG8_BAR;
            PG8_LDA(At, 0, 1); PG8_STAGE(PG8_SA(0, 0), a2, voffA);
            PG8_BAR; PG8_WAIT_L(0); PG8_MMA(1, 0, At, B0); PG8_BAR; PG8_SCHED;
            PG8_STAGE(PG8_SB(0, 1), b2 + hstep, voffB);
            PG8_WAIT_V(6); PG8_BAR; PG8_MMA(1, 1, At, B1); PG8_BAR;
            PG8_LDB(B0, 1, 0); PG8_SCHED; PG8_LDA(At, 1, 0); PG8_STAGE(PG8_SA(0, 1), a2 + hstep, voffA);
            PG8_WAIT_L(8); PG8_BAR; PG8_WAIT_L(0); PG8_MMA(0, 0, At, B0); PG8_BAR; PG8_SCHED;
            PG8_LDB(B1, 1, 1); PG8_STAGE(PG8_SB(1, 0), b3, voffB);
            PG8_BAR; PG8_WAIT_L(0); PG8_MMA(0, 1, At, B1); PG8_BAR;
            PG8_LDA(At, 1, 1); PG8_STAGE(PG8_SA(1, 0), a3, voffA);
            PG8_BAR; PG8_WAIT_L(0); PG8_MMA(1, 0, At, B0); PG8_BAR; PG8_SCHED;
            PG8_STAGE(PG8_SB(1, 1), b3 + hstep, voffB);
            PG8_WAIT_V(6); PG8_BAR; PG8_MMA(1, 1, At, B1); PG8_BAR;
            }
        }
        if constexpr (ALIGN_EPI) { if (wr == 0) PG8_BAR; }
        if constexpr (!Epi::AFTER_DRAIN) { E(acc, cur, wr, wc, fr, fq); S.done(cur); }
        if (!has_next) break;
#pragma unroll
        for (int a = 0; a < 2; ++a)
#pragma unroll
            for (int b = 0; b < 2; ++b)
#pragma unroll
                for (int m = 0; m < 4; ++m)
#pragma unroll
                    for (int n = 0; n < 2; ++n) acc[a][b][m][n] = (f32x4){0.f, 0.f, 0.f, 0.f};
        cur = nxt; cA = nA; cB = nB; ++ui;
        if constexpr (ALIGN_EPI) { if (wr == 1) PG8_BAR; }
    }
    PG8_WAIT_V(0);
    if constexpr (!ALIGN_EPI) { if (wr == 0) PG8_BAR; }
    PG8_BAR;
    if constexpr (Epi::AFTER_DRAIN) { E.fused(acc, cur, wr, wc, fr, fq, lds, wid, lane); S.done(cur); }
#undef PG8_SA
#undef PG8_SB
#undef PG8_STAGE
#undef PG8_LDA
#undef PG8_LDB
#undef PG8_MMA
#undef PG8_WAIT_V
#undef PG8_WAIT_L
#undef PG8_BAR
#undef PG8_SCHED
}
}
#define PG8_SP2 true
#define PG8_ALIGN true
namespace mk {
#define LAS __attribute__((address_space(3)))
using pg8::bf16_t; using pg8::bf16x8; using pg8::f32x4; using pg8::u32x4;
typedef float f32x16 __attribute__((ext_vector_type(16)));
typedef short s16x4 __attribute__((ext_vector_type(4)));
typedef unsigned u32x2 __attribute__((ext_vector_type(2)));

constexpr int MP = 32768, MS = 128, MTOK = MP + MS, MPAD = 33024, NTM = MPAD / 256;
constexpr int ZLD = 8704, GOFF = 4608, BW = 384, DFF = 2816;
constexpr int LDS_BYTES = 131072;
constexpr float LOG2E = 1.4426950408889634f, LN2 = 0.6931471805599453f, EPS = 1e-6f;
enum { I_XP = 0, I_XS, I_CA, I_CB1, I_CB2, I_CB3, I_SC, I_LN1, I_WIN, I_QNA, I_KNA, I_SINK, I_QNB, I_KNB, I_CONV, I_WSD, I_BSD, I_WG, I_BG, I_WB, I_WO, I_LN2, I_WFI, I_WFO };
constexpr size_t O_YP = 0, O_YS = 33554432, O_AP = O_YS + 131072, O_AS = O_AP + 1048576, O_B1P = O_AS + 8388608, O_B1S = O_B1P + 1048576, O_B2P = O_B1S + 8388608,
                 O_B2S = O_B2P + 4194304, O_B3P = O_B2S + 33554432, O_B3S = O_B3P + 16777216, O_CP = O_B3S + 134217728, O_CS = O_CP + 24576, O_DS = O_CS + 196608, O_END = O_DS + 98304;
static_assert(O_END == 241623040, "output size");
constexpr size_t al(size_t x) { return (x + 255) & ~(size_t)255; }
constexpr size_t WS_ROPE = 0;
constexpr size_t WS_WM = al(WS_ROPE + 2049 * 16 * 4);
constexpr size_t WS_W = al(WS_WM + 2 * 6 * 128 * 128 * 2);
constexpr size_t W1_B = (size_t)ZLD * 1024 * 2, WB_B = 4ull * 1024 * 384 * 2, WO_B = 1024ull * 1024 * 2, WF_B = 5632ull * 1024 * 2, WD_B = 1024ull * 2816 * 2;
constexpr size_t WL_B = W1_B + WB_B + WO_B + WF_B + WD_B;
constexpr size_t WS_X = al(WS_W + 2 * WL_B);
constexpr size_t WS_H = al(WS_X + (size_t)MPAD * 1024 * 4);
constexpr size_t WS_ZG = al(WS_H + (size_t)MPAD * 1024 * 2);
constexpr size_t WS_BR = al(WS_ZG + (size_t)MPAD * ZLD * 2);
constexpr size_t WS_OB = al(WS_BR + 4ull * MPAD * BW * 2);
constexpr size_t WS_LSE = al(WS_OB + 3ull * MPAD * BW * 2);
constexpr size_t WS_PART = al(WS_LSE + 3ull * MPAD * 8 * 4);
constexpr size_t WS_MRG = al(WS_PART + (size_t)MPAD * 1024 * 4);
constexpr size_t WS_ACT = al(WS_MRG + (size_t)MPAD * 1024 * 2);
constexpr size_t WS_BAR = al(WS_ACT + (size_t)MPAD * DFF * 2);
constexpr size_t WS_END = al(WS_BAR + 256);

struct Params { const float* in[24]; float* out; unsigned char* ws; int ph_lo, ph_hi; };
static_assert(sizeof(Params) == 216, "Params has padding");

#define DI __device__ __forceinline__
typedef float f32x2v __attribute__((ext_vector_type(2)));
typedef __bf16 bf16x2v __attribute__((ext_vector_type(2)));
DI unsigned pk2(float lo, float hi) { const f32x2v v = {lo, hi}; return __builtin_bit_cast(unsigned, __builtin_convertvector(v, bf16x2v)); }
DI float bflo(unsigned w) { return __uint_as_float(w << 16); }
DI float bfhi(unsigned w) { return __uint_as_float(w & 0xffff0000u); }
DI float bf1(bf16_t v) { return __uint_as_float((unsigned)v << 16); }
DI void unpack8(const u32x4 w, float (&x)[8]) { x[0] = bflo(w.x); x[1] = bfhi(w.x); x[2] = bflo(w.y); x[3] = bfhi(w.y); x[4] = bflo(w.z); x[5] = bfhi(w.z); x[6] = bflo(w.w); x[7] = bfhi(w.w); }
DI u32x4 pack8(const float (&x)[8]) { u32x4 w; w.x = pk2(x[0], x[1]); w.y = pk2(x[2], x[3]); w.z = pk2(x[4], x[5]); w.w = pk2(x[6], x[7]); return w; }
DI float wave_sum(float v) {
#pragma unroll
    for (int o = 1; o < 64; o <<= 1) v += __shfl_xor(v, o);
    return v; }
DI float wave_max(float v) {
#pragma unroll
    for (int o = 1; o < 64; o <<= 1) v = fmaxf(v, __shfl_xor(v, o));
    return v; }
DI float ex2(float x) { return __builtin_amdgcn_exp2f(x); }
DI int crow(int reg, int h) { return (reg & 3) + 8 * (reg >> 2) + 4 * h; }
#define MFMA32(a, b, c) __builtin_amdgcn_mfma_f32_32x32x16_bf16((a), (b), (c), 0, 0, 0)

struct QuadOrder {
    pg8::StaticOrder o;
    __device__ bool next(int i, pg8::Unit& u) const { pg8::Unit q; if (!o.next(i >> 2, q)) return false; const int n = i & 3; u.pm = n * NTM + q.pm; u.pn = n * 4 + q.pn; return true; }
    DI void a_ready(const pg8::Unit&) const {}
    DI void done(const pg8::Unit&) const {}
};
typedef f32x4 AccT[2][2][4][2];
struct EpiZG {
    static constexpr bool PERM = true, AFTER_DRAIN = false; static constexpr int SEGMENT_TILES = 0;
    bf16_t* O; const float* bias; const float* rope; const float* qna; const float* kna; const float* qnb; const float* knb; float* out; int l;
    DI void operator()(const AccT& acc, const pg8::Unit& u, int wr, int wc, int fr_, int fq_) const {
        int fr = fr_, fq = fq_; asm volatile("" : "+v"(fr), "+v"(fq));
        const int rowb = u.pm * 256 + wr * 64 + fr;
        if (u.pn >= 18) {
            const int col0 = u.pn * 256 + wc * 32 + 8 * fq;
            f32x4 bv[2][2];
#pragma unroll
            for (int bj = 0; bj < 2; ++bj) { bv[bj][0] = *(const f32x4*)(bias + col0 + bj * 128 - GOFF); bv[bj][1] = *(const f32x4*)(bias + col0 + bj * 128 - GOFF + 4); }
#pragma unroll
            for (int ai = 0; ai < 2; ++ai)
#pragma unroll
                for (int m = 0; m < 4; ++m) {
#pragma unroll
                    for (int bj = 0; bj < 2; ++bj) {
                        f32x4 v0 = acc[ai][bj][m][0] + bv[bj][0], v1 = acc[ai][bj][m][1] + bv[bj][1];
#pragma unroll
                        for (int e = 0; e < 4; ++e) { v0[e] = __builtin_amdgcn_rcpf(1.f + ex2(-LOG2E * v0[e])); v1[e] = __builtin_amdgcn_rcpf(1.f + ex2(-LOG2E * v1[e])); }
                        u32x4 w; w.x = pk2(v0[0], v0[1]); w.y = pk2(v0[2], v0[3]); w.z = pk2(v1[0], v1[1]); w.w = pk2(v1[2], v1[3]);
                        *(u32x4*)(O + (size_t)(rowb + ai * 128 + m * 16) * ZLD + col0 + bj * 128) = w;
                    }
                    asm volatile("" ::: "memory");
                }
            return;
        }
        const int c64 = u.pn * 4 + wc, colL = c64 * 64 + 8 * fq;
        int type = 3, gi = 0, hh = 0;
        if (c64 < 40) { gi = c64 / 10; hh = c64 - gi * 10; type = hh < 6 ? 0 : (hh < 8 ? 1 : 2); }
        f32x4 g00 = (f32x4){1.f, 1.f, 1.f, 1.f}, g01 = g00, g10 = g00, g11 = g00;
        if (type <= 1) { const float* gn = (type == 0 ? (gi == 0 ? qna : qnb + (gi - 1) * 64) : (gi == 0 ? kna : knb + (gi - 1) * 64)) + 8 * fq;
            g00 = *(const f32x4*)gn; g01 = *(const f32x4*)(gn + 4); g10 = *(const f32x4*)(gn + 32); g11 = *(const f32x4*)(gn + 36); }
        const int W = gi < 2 ? 128 : (gi == 2 ? 512 : 2048);
        const size_t obase_p = gi == 0 ? O_AP : (gi == 1 ? O_B1P : (gi == 2 ? O_B2P : O_B3P)), obase_s = gi == 0 ? O_AS : (gi == 1 ? O_B1S : (gi == 2 ? O_B2S : O_B3S));
#pragma unroll
        for (int ai = 0; ai < 2; ++ai)
#pragma unroll
            for (int m = 0; m < 4; ++m) {
                const int row = rowb + ai * 128 + m * 16;
                f32x4 v00 = acc[ai][0][m][0], v01 = acc[ai][0][m][1], v10 = acc[ai][1][m][0], v11 = acc[ai][1][m][1];
                const bool samp = row >= MP; const int t = row & 2047;
                if (type <= 1) {
                    float ss = 0.f;
#pragma unroll
                    for (int e = 0; e < 4; ++e) ss += v00[e] * v00[e] + v01[e] * v01[e] + v10[e] * v10[e] + v11[e] * v11[e];
                    ss += __shfl_xor(ss, 16); ss += __shfl_xor(ss, 32);
                    const float rs = 1.0f / sqrtf(ss * (1.f / 64.f) + EPS);
                    v00 = v00 * rs * g00; v01 = v01 * rs * g01; v10 = v10 * rs * g10; v11 = v11 * rs * g11;
                    f32x4 y0, y1;
#pragma unroll
                    for (int e = 0; e < 4; ++e) { y0[e] = __shfl_xor(v00[e], 16); y1[e] = __shfl_xor(v01[e], 16); }
                    if (fq < 2) {
                        const float* rp = rope + (samp ? 2048 : t) * 16;
                        const f32x4 c0 = *(const f32x4*)rp, c1 = *(const f32x4*)(rp + 4), c2 = *(const f32x4*)(rp + 8), c3 = *(const f32x4*)(rp + 12);
                        const float sg = fq == 0 ? -1.f : 1.f;
                        v00 = (f32x4){v00[0] * c0[0] + sg * y0[0] * c0[1], v00[1] * c0[2] + sg * y0[1] * c0[3], v00[2] * c1[0] + sg * y0[2] * c1[1], v00[3] * c1[2] + sg * y0[3] * c1[3]};
                        v01 = (f32x4){v01[0] * c2[0] + sg * y1[0] * c2[1], v01[1] * c2[2] + sg * y1[1] * c2[3], v01[2] * c3[0] + sg * y1[2] * c3[1], v01[3] * c3[2] + sg * y1[3] * c3[3]};
                    }
                }
                bf16_t* zp = O + (size_t)row * ZLD + colL;
                { u32x4 w; w.x = pk2(v00[0], v00[1]); w.y = pk2(v00[2], v00[3]); w.z = pk2(v01[0], v01[1]); w.w = pk2(v01[2], v01[3]); *(u32x4*)zp = w; }
                { u32x4 w; w.x = pk2(v10[0], v10[1]); w.y = pk2(v10[2], v10[3]); w.z = pk2(v11[0], v11[1]); w.w = pk2(v11[2], v11[3]); *(u32x4*)(zp + 32) = w; }
                if ((type == 1 || type == 2) && row < MTOK) {
                    const int b = samp ? row - MP : row >> 11, jrow = samp ? W - 1 : t - (2048 - W);
                    if (jrow >= 0) {
                        const size_t cb = samp ? obase_s + ((size_t)(l * 128 + b) * 2) * W * 128 : obase_p + ((size_t)(l * 16 + b) * 2) * W * 128;
                        float* d = out + cb + ((size_t)(type - 1) * W + jrow) * 128 + (hh - (type == 1 ? 6 : 8)) * 64 + 8 * fq;
                        *(f32x4*)d = v00; *(f32x4*)(d + 4) = v01; *(f32x4*)(d + 32) = v10; *(f32x4*)(d + 36) = v11;
                    }
                }
                asm volatile("" ::: "memory");
            }
    }
};
struct EpiBranch {
    static constexpr bool PERM = true, AFTER_DRAIN = false; static constexpr int SEGMENT_TILES = 6;
    const bf16_t* G; bf16_t* mrg;
    DI void rescale(AccT& acc, const pg8::Unit& u, int n, int wr, int wc, int fr_, int fq_) const {
        int fr = fr_, fq = fq_; asm volatile("" : "+v"(fr), "+v"(fq));
        const int row0 = u.pm * 256 + wr * 64 + fr, col0 = u.pn * 256 + wc * 32 + 8 * fq;
#pragma unroll
        for (int ai = 0; ai < 2; ++ai)
#pragma unroll
            for (int m = 0; m < 4; ++m) {
                const bf16_t* gp = G + (size_t)(row0 + ai * 128 + m * 16) * ZLD + GOFF + (n - 1) * 1024 + col0;
#pragma unroll
                for (int bj = 0; bj < 2; ++bj) {
                    float gp0[8], gp1[8]; unpack8(*(const u32x4*)(gp + bj * 128), gp0); unpack8(*(const u32x4*)(gp + 1024 + bj * 128), gp1);
#pragma unroll
                    for (int e = 0; e < 4; ++e) { acc[ai][bj][m][0][e] *= fmaxf(gp0[e], 1e-8f) * __builtin_amdgcn_rcpf(fmaxf(gp1[e], 1e-8f)); acc[ai][bj][m][1][e] *= fmaxf(gp0[4 + e], 1e-8f) * __builtin_amdgcn_rcpf(fmaxf(gp1[4 + e], 1e-8f)); }
                }
                asm volatile("" ::: "memory");
            }
    }
    DI void operator()(const AccT& acc, const pg8::Unit& u, int wr, int wc, int fr_, int fq_) const {
        int fr = fr_, fq = fq_; asm volatile("" : "+v"(fr), "+v"(fq));
        const int row0 = u.pm * 256 + wr * 64 + fr, col0 = u.pn * 256 + wc * 32 + 8 * fq;
#pragma unroll
        for (int ai = 0; ai < 2; ++ai)
#pragma unroll
            for (int m = 0; m < 4; ++m) {
                const size_t row = (size_t)(row0 + ai * 128 + m * 16);
#pragma unroll
                for (int bj = 0; bj < 2; ++bj) {
                    const int col = col0 + bj * 128;
                    float gv[8]; unpack8(*(const u32x4*)(G + row * ZLD + GOFF + 3 * 1024 + col), gv);
                    const f32x4 v0 = acc[ai][bj][m][0], v1 = acc[ai][bj][m][1];
                    u32x4 w; w.x = pk2(v0[0] * fmaxf(gv[0], 1e-8f), v0[1] * fmaxf(gv[1], 1e-8f)); w.y = pk2(v0[2] * fmaxf(gv[2], 1e-8f), v0[3] * fmaxf(gv[3], 1e-8f));
                    w.z = pk2(v1[0] * fmaxf(gv[4], 1e-8f), v1[1] * fmaxf(gv[5], 1e-8f)); w.w = pk2(v1[2] * fmaxf(gv[6], 1e-8f), v1[3] * fmaxf(gv[7], 1e-8f));
                    *(u32x4*)(mrg + row * 1024 + col) = w;
                }
                asm volatile("" ::: "memory");
            }
    }
};
struct EpiResid {
    static constexpr bool PERM = true, AFTER_DRAIN = false; static constexpr int SEGMENT_TILES = 0;
    const float* src; float* dst; int nrows;
    DI void operator()(const AccT& acc, const pg8::Unit& u, int wr, int wc, int fr_, int fq_) const {
        int fr = fr_, fq = fq_; asm volatile("" : "+v"(fr), "+v"(fq));
        const int row0 = u.pm * 256 + wr * 64 + fr, col0 = u.pn * 256 + wc * 32 + 8 * fq;
#pragma unroll
        for (int ai = 0; ai < 2; ++ai)
#pragma unroll
            for (int m = 0; m < 4; ++m) {
                const int row = row0 + ai * 128 + m * 16;
                if (row < nrows) {
#pragma unroll
                    for (int bj = 0; bj < 2; ++bj) {
                        const size_t off = (size_t)row * 1024 + col0 + bj * 128;
                        const f32x4 a0 = *(const f32x4*)(src + off), a1 = *(const f32x4*)(src + off + 4);
                        *(f32x4*)(dst + off) = a0 + acc[ai][bj][m][0]; *(f32x4*)(dst + off + 4) = a1 + acc[ai][bj][m][1];
                    }
                    asm volatile("" ::: "memory");
                }
            }
    }
};
struct EpiSwiglu {
    static constexpr bool PERM = true, AFTER_DRAIN = false; static constexpr int SEGMENT_TILES = 0;
    bf16_t* O;
    DI void operator()(const AccT& acc, const pg8::Unit& u, int wr, int wc, int fr_, int fq_) const {
        int fr = fr_, fq = fq_; asm volatile("" : "+v"(fr), "+v"(fq));
        const int row0 = u.pm * 256 + wr * 64 + fr, col0 = u.pn * 128 + wc * 32 + 8 * fq;
#pragma unroll
        for (int ai = 0; ai < 2; ++ai)
#pragma unroll
            for (int m = 0; m < 4; ++m) {
                float o[8];
#pragma unroll
                for (int nn = 0; nn < 2; ++nn)
#pragma unroll
                    for (int e = 0; e < 4; ++e) { const float g = acc[ai][0][m][nn][e], up = acc[ai][1][m][nn][e]; o[nn * 4 + e] = g * __builtin_amdgcn_rcpf(1.f + ex2(-LOG2E * g)) * up; }
                *(u32x4*)(O + (size_t)(row0 + ai * 128 + m * 16) * DFF + col0) = pack8(o);
                asm volatile("" ::: "memory");
            }
    }
};
DI void tr_item(const float* W, int N, bf16_t* WT, int ldk, int k0, int n0, int drow0, LAS float* scr, int lane, int kdst = -1) {
    if (kdst < 0) kdst = k0;
#pragma unroll 8
    for (int i = 0; i < 32; ++i) { const int kk = 2 * i + (lane >> 5); scr[kk * 33 + (lane & 31)] = W[(size_t)(k0 + kk) * N + n0 + (lane & 31)]; }
    const int c = lane & 7;
#pragma unroll
    for (int j = 0; j < 4; ++j) { const int n = (lane >> 3) + 8 * j; const LAS float* s = scr + (8 * c) * 33 + n;
        u32x4 o; o.x = pk2(s[0 * 33], s[1 * 33]); o.y = pk2(s[2 * 33], s[3 * 33]); o.z = pk2(s[4 * 33], s[5 * 33]); o.w = pk2(s[6 * 33], s[7 * 33]);
        *(u32x4*)(WT + (size_t)(drow0 + n) * ldk + kdst + 8 * c) = o; }
}
constexpr int IT_IN = 16 * 140, IT_G = 4 * 512, IT_B = 4 * 192, IT_O = 512, IT_FI = 16 * 176, IT_FO = 44 * 32, IT_L = IT_IN + IT_G + IT_B + IT_O + IT_FI + IT_FO;
DI void prologue_weights(const Params& p, LAS unsigned char* lds, int gw, int NGW, int wave, int lane) {
    LAS float* scr = (LAS float*)(lds + wave * 8448);
    for (int it = gw; it < 2 * IT_L; it += NGW) {
        const int l = it / IT_L; int r = it - l * IT_L;
        unsigned char* wl = p.ws + WS_W + (size_t)l * WL_B;
        bf16_t* W1t = (bf16_t*)wl; bf16_t* Wbt = (bf16_t*)(wl + W1_B); bf16_t* Wot = (bf16_t*)(wl + W1_B + WB_B); bf16_t* Wft = (bf16_t*)(wl + W1_B + WB_B + WO_B); bf16_t* Wdt = (bf16_t*)(wl + W1_B + WB_B + WO_B + WF_B);
        if (r < IT_IN) { const int kb = r / 140, nb = r % 140; const int n0 = 32 * nb, w = n0 & 255; tr_item(p.in[I_WIN] + (size_t)l * 1024 * 4480, 4480, W1t, 1024, 64 * kb, n0, (n0 & ~255) + 128 * ((w >> 5) & 1) + 32 * (w >> 6), scr, lane); continue; } r -= IT_IN;
        if (r < IT_G) { const int n = r / 512, r2 = r % 512, kb = r2 / 32, nb = r2 % 32; tr_item(p.in[I_WG] + (size_t)(l * 4 + n) * 1024 * 1024, 1024, W1t, 1024, 64 * kb, 32 * nb, GOFF + n * 1024 + 32 * nb, scr, lane); continue; } r -= IT_G;
        if (r < IT_B) { const int n = r / 192, r2 = r % 192, kb = r2 / 32, nb = r2 % 32; tr_item(p.in[I_WB] + (size_t)(l * 4 + n) * 384 * 1024, 1024, Wbt, 1536, 64 * kb, 32 * nb, 32 * nb, scr, lane, n * 384 + 64 * kb); continue; } r -= IT_B;
        if (r < IT_O) { const int kb = r / 32, nb = r % 32; tr_item(p.in[I_WO] + (size_t)l * 1024 * 1024, 1024, Wot, 1024, 64 * kb, 32 * nb, 32 * nb, scr, lane); continue; } r -= IT_O;
        if (r < IT_FI) { const int kb = r / 176, nb = r % 176, n0 = 32 * nb; const int dr = n0 < DFF ? 256 * (n0 / 128) + (n0 % 128) : 256 * ((n0 - DFF) / 128) + 128 + ((n0 - DFF) % 128);
            tr_item(p.in[I_WFI] + (size_t)l * 1024 * 5632, 5632, Wft, 1024, 64 * kb, n0, dr, scr, lane); continue; } r -= IT_FI;
        { const int kb = r / 32, nb = r % 32; tr_item(p.in[I_WFO] + (size_t)l * DFF * 1024, 1024, Wdt, DFF, 64 * kb, 32 * nb, 32 * nb, scr, lane); }
    }
}
__constant__ float INV_FREQ[8] = {1.0f, 0.1939227432012558f, 0.03760603070259094f, 0.007292664609849453f, 0.0014142135623842478f, 0.00027424818836152554f, 5.3182957344688475e-05f, 1.0313385246263351e-05f};
DI void prologue_misc(const Params& p, int gt, int NT) {
    for (int i = gt; i < 2 * 16384; i += NT) { const int l = i >> 14, j = i & 16383, rr = j >> 7, prow = 4352 + (rr < 64 ? 64 + rr : 128 + rr); *(u32x4*)(p.ws + WS_W + (size_t)l * WL_B + (size_t)prow * 2048 + (size_t)(j & 127) * 16) = (u32x4){0u, 0u, 0u, 0u}; }
    bf16_t* Wm = (bf16_t*)(p.ws + WS_WM);
    for (int i = gt; i < 2 * 6 * 128 * 64; i += NT) { const int e = 2 * i, jj = e & 127, ii = (e >> 7) & 127; const float a = p.in[I_WSD][e], b = p.in[I_WSD][e + 1];
        *(unsigned*)(Wm + e) = pk2(jj <= ii ? a : 0.f, jj + 1 <= ii ? b : 0.f); }
    float* rope = (float*)(p.ws + WS_ROPE);
    for (int i = gt; i < 2049 * 8; i += NT) { const int pos = (i >> 3) == 2048 ? 16384 : (i >> 3); double rev = (double)pos * (double)INV_FREQ[i & 7] * 0.15915494309189535; rev -= rint(rev);
        const float rf = (float)rev; rope[2 * i] = __builtin_amdgcn_cosf(rf); rope[2 * i + 1] = __builtin_amdgcn_sinf(rf); }
}
DI void norm_phase(const float* xp, const float* xs, float* xcopy, const float* gain, bf16_t* H, int gw, int NGW, int lane) {
    f32x4 gv[4];
#pragma unroll
    for (int j = 0; j < 4; ++j) gv[j] = ((const f32x4*)gain)[lane + 64 * j];
    f32x4 nx[4];
    auto rowptr = [&](int m) -> const float* { return (xs && m >= MP) ? xs + (size_t)(m - MP) * 1024 : xp + (size_t)m * 1024; };
    if (gw < MTOK) {
#pragma unroll
        for (int j = 0; j < 4; ++j) nx[j] = ((const f32x4*)rowptr(gw))[lane + 64 * j];
    }
    for (int m = gw; m < MPAD; m += NGW) {
        u32x2* ho = (u32x2*)(H + (size_t)m * 1024) + lane;
        if (m >= MTOK) {
#pragma unroll
            for (int j = 0; j < 4; ++j) { ho[64 * j] = (u32x2){0u, 0u}; if (xcopy) ((f32x4*)(xcopy + (size_t)m * 1024))[lane + 64 * j] = (f32x4){0.f, 0.f, 0.f, 0.f}; }
            continue;
        }
        f32x4 v[4]; float ss = 0.f;
#pragma unroll
        for (int j = 0; j < 4; ++j) { v[j] = nx[j]; ss += (v[j].x * v[j].x + v[j].y * v[j].y) + (v[j].z * v[j].z + v[j].w * v[j].w); }
        if (m + NGW < MTOK) {
#pragma unroll
            for (int j = 0; j < 4; ++j) nx[j] = ((const f32x4*)rowptr(m + NGW))[lane + 64 * j];
        }
        const float rs = 1.0f / sqrtf(wave_sum(ss) * (1.f / 1024.f) + EPS);
#pragma unroll
        for (int j = 0; j < 4; ++j) { const f32x4 g = gv[j];
            ho[64 * j] = (u32x2){pk2(v[j].x * rs * g.x, v[j].y * rs * g.y), pk2(v[j].z * rs * g.z, v[j].w * rs * g.w)};
            if (xcopy) ((f32x4*)(xcopy + (size_t)m * 1024))[lane + 64 * j] = v[j]; }
    }
}
DI void qk_phase(const Params& p, int l, int gw, int NGW, int lane) {
    bf16_t* ZG = (bf16_t*)(p.ws + WS_ZG); const float* rope = (const float*)(p.ws + WS_ROPE);
    const int sub = lane & 7, hh = lane >> 3;
    float gnv[4][8];
#pragma unroll
    for (int gi = 0; gi < 4; ++gi) {
        const float* gn = hh < 6 ? (gi == 0 ? p.in[I_QNA] + l * 64 : p.in[I_QNB] + (l * 3 + gi - 1) * 64) : (gi == 0 ? p.in[I_KNA] + l * 64 : p.in[I_KNB] + (l * 3 + gi - 1) * 64);
        const f32x4 g0 = *(const f32x4*)(gn + sub * 8), g1 = *(const f32x4*)(gn + sub * 8 + 4);
#pragma unroll
        for (int e = 0; e < 4; ++e) { gnv[gi][e] = g0[e]; gnv[gi][4 + e] = g1[e]; }
    }
    u32x4 nxt[4];
    if (gw < MTOK) {
#pragma unroll
        for (int gi = 0; gi < 4; ++gi) nxt[gi] = *(const u32x4*)(ZG + (size_t)gw * ZLD + gi * 640 + lane * 8);
    }
    for (int m = gw; m < MTOK; m += NGW) {
        const bool samp = m >= MP; const int b = samp ? m - MP : m >> 11, t = samp ? 0 : (m & 2047);
        const float* rp = rope + (samp ? 2048 : t) * 16;
        bf16_t* zrow = ZG + (size_t)m * ZLD;
        u32x4 cur[4];
#pragma unroll
        for (int gi = 0; gi < 4; ++gi) cur[gi] = nxt[gi];
        if (m + NGW < MTOK) {
#pragma unroll
            for (int gi = 0; gi < 4; ++gi) nxt[gi] = *(const u32x4*)(ZG + (size_t)(m + NGW) * ZLD + gi * 640 + lane * 8);
        }
        f32x4 rc0, rc1, rc2, rc3;
        if (sub < 2) { rc0 = *(const f32x4*)rp; rc1 = *(const f32x4*)(rp + 4); rc2 = *(const f32x4*)(rp + 8); rc3 = *(const f32x4*)(rp + 12); }
#pragma unroll
        for (int gi = 0; gi < 4; ++gi) {
            const int W = gi == 0 ? 128 : (gi == 1 ? 128 : (gi == 2 ? 512 : 2048));
            const size_t obase_p = gi == 0 ? O_AP : (gi == 1 ? O_B1P : (gi == 2 ? O_B2P : O_B3P)), obase_s = gi == 0 ? O_AS : (gi == 1 ? O_B1S : (gi == 2 ? O_B2S : O_B3S));
            float x[8]; unpack8(cur[gi], x);
            float ss = 0.f;
#pragma unroll
            for (int e = 0; e < 8; ++e) ss += x[e] * x[e];
            ss += __shfl_xor(ss, 1); ss += __shfl_xor(ss, 2); ss += __shfl_xor(ss, 4);
            const float rs = 1.0f / sqrtf(ss * (1.f / 64.f) + EPS);
#pragma unroll
            for (int e = 0; e < 8; ++e) x[e] = x[e] * rs * gnv[gi][e];
            float y[8];
#pragma unroll
            for (int e = 0; e < 8; ++e) y[e] = __shfl_xor(x[e], 1);
            if (sub < 2) {
                const float cs[16] = {rc0[0], rc0[1], rc0[2], rc0[3], rc1[0], rc1[1], rc1[2], rc1[3], rc2[0], rc2[1], rc2[2], rc2[3], rc3[0], rc3[1], rc3[2], rc3[3]};
#pragma unroll
                for (int e = 0; e < 8; ++e) { const float c = cs[2 * e], s = cs[2 * e + 1]; x[e] = sub == 0 ? x[e] * c - y[e] * s : x[e] * c + y[e] * s; }
            }
            *(u32x4*)(zrow + gi * 640 + lane * 8) = pack8(x);
            const int jrow = samp ? W - 1 : t - (2048 - W);
            const size_t cb = samp ? obase_s + ((size_t)(l * 128 + b) * 2) * W * 128 : obase_p + ((size_t)(l * 16 + b) * 2) * W * 128;
            if (jrow >= 0) {
                if (hh >= 6) { float* d = p.out + cb + (size_t)jrow * 128 + (hh - 6) * 64 + sub * 8; *(f32x4*)d = (f32x4){x[0], x[1], x[2], x[3]}; *(f32x4*)(d + 4) = (f32x4){x[4], x[5], x[6], x[7]}; }
                if (lane < 16) { float v[8]; unpack8(*(const u32x4*)(zrow + gi * 640 + 512 + lane * 8), v);
                    float* d = p.out + cb + (size_t)(W + jrow) * 128 + lane * 8; *(f32x4*)d = (f32x4){v[0], v[1], v[2], v[3]}; *(f32x4*)(d + 4) = (f32x4){v[4], v[5], v[6], v[7]}; }
            }
        }
        if (lane < 48 && (samp || t >= 2046)) {
            float gc[8], xc[8]; unpack8(*(const u32x4*)(zrow + 2944 + lane * 8), gc); unpack8(*(const u32x4*)(zrow + 3328 + lane * 8), xc);
            f32x4 z0 = (f32x4){gc[0] * xc[0], gc[1] * xc[1], gc[2] * xc[2], gc[3] * xc[3]}, z1 = (f32x4){gc[4] * xc[4], gc[5] * xc[5], gc[6] * xc[6], gc[7] * xc[7]};
            if (samp) {
                float* d = p.out + O_CS + ((size_t)(l * 128 + b) * 2) * BW + lane * 8; const float* s1 = p.in[I_SC] + ((size_t)(l * 128 + b) * 2 + 1) * BW + lane * 8;
                *(f32x4*)d = *(const f32x4*)s1; *(f32x4*)(d + 4) = *(const f32x4*)(s1 + 4); *(f32x4*)(d + BW) = z0; *(f32x4*)(d + BW + 4) = z1;
                float vd[8]; unpack8(*(const u32x4*)(zrow + 4096 + lane * 8), vd); float* dd = p.out + O_DS + (size_t)(l * 128 + b) * BW + lane * 8;
                *(f32x4*)dd = (f32x4){vd[0], vd[1], vd[2], vd[3]}; *(f32x4*)(dd + 4) = (f32x4){vd[4], vd[5], vd[6], vd[7]};
            } else { float* d = p.out + O_CP + ((size_t)(l * 16 + b) * 2 + (t - 2046)) * BW + lane * 8; *(f32x4*)d = z0; *(f32x4*)(d + 4) = z1; }
        }
    }
}
DI bf16x8 vt_frag(LAS unsigned char* img, int rowbase0, int tstep, int cc, int lane) {
    const int q = (lane & 15) >> 2, p4 = lane & 3, blk = (lane >> 4) & 1;
    const int colb = (32 * cc + 16 * blk + 4 * p4) * 2;
    const s16x4 lo = __builtin_amdgcn_ds_read_tr16_b64_v4i16((LAS s16x4*)(img + (rowbase0 + q) * 144 + colb));
    const s16x4 hi = __builtin_amdgcn_ds_read_tr16_b64_v4i16((LAS s16x4*)(img + (rowbase0 + tstep + q) * 144 + colb));
    return __builtin_shufflevector(lo, hi, 0, 1, 2, 3, 4, 5, 6, 7);
}
DI void attn_unit(LAS unsigned char* qimg, LAS unsigned char* img, const bf16_t* ZG, int tok0, int dil, int qb, int gi, int kvh, bf16_t* Obuf, int ostr, float* lse_out, const float* sink, int lane) {
    const int r = lane & 31, h = lane >> 5;
    const int colq = gi * 640 + kvh * 192, colk = gi * 640 + 384 + kvh * 64, colv = gi * 640 + 512 + kvh * 64;
    const int tq = tok0 + dil * (32 * qb + r);
    const bf16_t* qrow = ZG + (size_t)tq * ZLD + colq + 32 * h;
    {
        bf16x8 qv[12];
#pragma unroll
        for (int i = 0; i < 12; ++i) qv[i] = *(const bf16x8*)(qrow + (i >> 2) * 64 + 8 * (i & 3));
#pragma unroll
        for (int i = 0; i < 12; ++i) *(LAS bf16x8*)(qimg + i * 1024 + lane * 16) = qv[i];
    }
    f32x16 o[3][2]; float mrun[3], lrun[3];
#pragma unroll
    for (int g = 0; g < 3; ++g) { mrun[g] = -1e30f; lrun[g] = 0.f;
#pragma unroll
        for (int i = 0; i < 16; ++i) { o[g][0][i] = 0.f; o[g][1][i] = 0.f; } }
    const float SC = 0.125f * LOG2E;
    const int c0 = qb >= 4 ? 0 : 4 - qb;
    bf16x8 kf[4], vv[4];
    { const bf16_t* krow = ZG + (size_t)(tok0 + dil * (32 * (qb - 4 + c0) + r)) * ZLD + 32 * h;
#pragma unroll
      for (int ks = 0; ks < 4; ++ks) { kf[ks] = *(const bf16x8*)(krow + colk + 8 * ks); vv[ks] = *(const bf16x8*)(krow + colv + 8 * ks); } }
    for (int c = c0; c < 5; ++c) {
#pragma unroll
        for (int ks = 0; ks < 4; ++ks) *(LAS bf16x8*)(img + r * 144 + 64 * h + 16 * ks) = vv[ks];
        bf16x8 kc[4];
#pragma unroll
        for (int ks = 0; ks < 4; ++ks) kc[ks] = kf[ks];
        if (c < 4) {
            const bf16_t* krow = ZG + (size_t)(tok0 + dil * (32 * (qb - 3 + c) + r)) * ZLD + 32 * h;
#pragma unroll
            for (int ks = 0; ks < 4; ++ks) { kf[ks] = *(const bf16x8*)(krow + colk + 8 * ks); vv[ks] = *(const bf16x8*)(krow + colv + 8 * ks); }
        }
        bf16x8 vf[2][2];
#pragma unroll
        for (int s = 0; s < 2; ++s)
#pragma unroll
            for (int cc = 0; cc < 2; ++cc) vf[s][cc] = vt_frag(img, 16 * s + 4 * h, 8, cc, lane);
#pragma unroll
        for (int g = 0; g < 3; ++g) {
            f32x16 s;
#pragma unroll
            for (int i = 0; i < 16; ++i) s[i] = 0.f;
#pragma unroll
            for (int ks = 0; ks < 4; ++ks) s = MFMA32(kc[ks], *(const LAS bf16x8*)(qimg + (g * 4 + ks) * 1024 + lane * 16), s);
            float t[16]; float mx = -1e30f;
#pragma unroll
            for (int i = 0; i < 16; ++i) { const int cr = crow(i, h); const bool valid = c == 0 ? (cr >= r) : (c == 4 ? (cr <= r) : true); t[i] = valid ? s[i] * SC : -1e30f; mx = fmaxf(mx, t[i]); }
            mx = fmaxf(mx, __shfl_xor(mx, 32));
            const float mnew = fmaxf(mrun[g], mx), alpha = ex2(mrun[g] - mnew);
            float rsum = 0.f;
#pragma unroll
            for (int i = 0; i < 16; ++i) { t[i] = ex2(t[i] - mnew); rsum += t[i]; }
            rsum += __shfl_xor(rsum, 32);
            lrun[g] = lrun[g] * alpha + rsum; mrun[g] = mnew;
#pragma unroll
            for (int i = 0; i < 16; ++i) { o[g][0][i] *= alpha; o[g][1][i] *= alpha; }
#pragma unroll
            for (int s2 = 0; s2 < 2; ++s2) {
                u32x4 pw; pw.x = pk2(t[8 * s2], t[8 * s2 + 1]); pw.y = pk2(t[8 * s2 + 2], t[8 * s2 + 3]); pw.z = pk2(t[8 * s2 + 4], t[8 * s2 + 5]); pw.w = pk2(t[8 * s2 + 6], t[8 * s2 + 7]);
                const bf16x8 pf = __builtin_bit_cast(bf16x8, pw);
                o[g][0] = MFMA32(vf[s2][0], pf, o[g][0]); o[g][1] = MFMA32(vf[s2][1], pf, o[g][1]);
            }
        }
    }
#pragma unroll
    for (int g = 0; g < 3; ++g) {
        const int head = kvh * 3 + g; float lsum = lrun[g];
        if (sink) lsum += ex2(sink[head] * LOG2E - mrun[g]);
        const float inv = 1.0f / lsum;
        bf16_t* orow = Obuf + (size_t)tq * ostr + head * 64 + 4 * h;
#pragma unroll
        for (int cc = 0; cc < 2; ++cc)
#pragma unroll
            for (int q4 = 0; q4 < 4; ++q4) *(u32x2*)(orow + 32 * cc + 8 * q4) = (u32x2){pk2(o[g][cc][4 * q4] * inv, o[g][cc][4 * q4 + 1] * inv), pk2(o[g][cc][4 * q4 + 2] * inv, o[g][cc][4 * q4 + 3] * inv)};
        if (lse_out && h == 0) lse_out[(size_t)tq * 8 + head] = (mrun[g] + __builtin_amdgcn_logf(lsum)) * LN2;
    }
}
DI void sattn_unit(const bf16_t* ZG, const float* cache, int W, int dil, int b, int gi, int hq, bf16_t* Obuf, int ostr, float* lse_out, const float* sink, int lane) {
    const int m = MP + b, kvh = hq / 3; const bf16_t* zrow = ZG + (size_t)m * ZLD + gi * 640;
    const bf16_t* qp = zrow + hq * 64;
    const float* Kc = cache + ((size_t)(b * 2 + 0) * W) * 128 + kvh * 64;
    const float* Vc = cache + ((size_t)(b * 2 + 1) * W) * 128 + kvh * 64;
    const float* k0 = Kc + (size_t)(W - (1 + lane) * dil) * 128; const float* k1 = Kc + (size_t)(W - (65 + lane) * dil) * 128;
    float s0 = 0.f, s1 = 0.f, s2 = 0.f;
#pragma unroll 2
    for (int d8 = 0; d8 < 8; ++d8) {
        float q[8], kn[8]; unpack8(*(const u32x4*)(qp + 8 * d8), q); unpack8(*(const u32x4*)(zrow + 384 + kvh * 64 + 8 * d8), kn);
        const f32x4 a0 = *(const f32x4*)(k0 + 8 * d8), a1 = *(const f32x4*)(k0 + 8 * d8 + 4), b0 = *(const f32x4*)(k1 + 8 * d8), b1 = *(const f32x4*)(k1 + 8 * d8 + 4);
#pragma unroll
        for (int e = 0; e < 4; ++e) { s0 += q[e] * a0[e] + q[4 + e] * a1[e]; s1 += q[e] * b0[e] + q[4 + e] * b1[e]; s2 += q[e] * kn[e] + q[4 + e] * kn[4 + e]; }
    }
    s0 *= 0.125f; s1 *= 0.125f; s2 *= 0.125f;
    const float mx = fmaxf(wave_max(fmaxf(s0, s1)), s2);
    const float p0 = __expf(s0 - mx), p1 = __expf(s1 - mx), p2 = __expf(s2 - mx);
    float lsum = wave_sum(p0 + p1) + p2;
    if (sink) lsum += __expf(sink[hq] - mx);
    float acc = p2 * bf1(zrow[512 + kvh * 64 + lane]);
    for (int n0 = 1; n0 <= 64; n0 += 8) {
        float va[8], vb[8];
#pragma unroll
        for (int j = 0; j < 8; ++j) { va[j] = Vc[(size_t)(W - (n0 + j) * dil) * 128 + lane]; vb[j] = Vc[(size_t)(W - (n0 + j + 64) * dil) * 128 + lane]; }
#pragma unroll
        for (int j = 0; j < 8; ++j) acc += __shfl(p0, n0 + j - 1) * va[j] + __shfl(p1, n0 + j - 1) * vb[j];
    }
    Obuf[(size_t)m * ostr + hq * 64 + lane] = (bf16_t)(pk2(acc / lsum, 0.f) & 0xffffu);
    if (lse_out && lane == 0) lse_out[(size_t)m * 8 + hq] = mx + __logf(lsum);
}
DI void sg_unit(LAS unsigned char* img, const bf16_t* ZG, const bf16_t* Wm, const float* bs, int T0, int g, int ib, bf16_t* Od, int ostr, int lane) {
    const int r = lane & 31, h = lane >> 5;
    f32x16 acc[2];
#pragma unroll
    for (int i = 0; i < 16; ++i) { acc[0][i] = 0.f; acc[1][i] = 0.f; }
    const bf16_t* wrow = Wm + ((size_t)g * 128 + 32 * ib + r) * 128 + 8 * h;
    for (int jc = 0; jc <= ib; ++jc) {
        const bf16_t* vrow = ZG + (size_t)(T0 + 32 * jc + r) * ZLD + 4096 + g * 64 + 32 * h;
#pragma unroll
        for (int ks = 0; ks < 4; ++ks) { const bf16x8 vv = *(const bf16x8*)(vrow + 8 * ks); *(LAS bf16x8*)(img + r * 144 + 64 * h + 16 * ks) = vv; }
#pragma unroll
        for (int s = 0; s < 2; ++s) {
            const bf16x8 wf = *(const bf16x8*)(wrow + 32 * jc + 16 * s);
            acc[0] = MFMA32(vt_frag(img, 16 * s + 8 * h, 4, 0, lane), wf, acc[0]);
            acc[1] = MFMA32(vt_frag(img, 16 * s + 8 * h, 4, 1, lane), wf, acc[1]);
        }
    }
    const int tok = T0 + 32 * ib + r; const float bias = bs[g * 128 + 32 * ib + r];
    const bf16_t* urow = ZG + (size_t)tok * ZLD + 3712 + g * 64 + 4 * h; bf16_t* orow = Od + (size_t)tok * ostr + g * 64 + 4 * h;
#pragma unroll
    for (int cc = 0; cc < 2; ++cc)
#pragma unroll
        for (int q4 = 0; q4 < 4; ++q4) { const u32x2 uw = *(const u32x2*)(urow + 32 * cc + 8 * q4);
            *(u32x2*)(orow + 32 * cc + 8 * q4) = (u32x2){pk2(bflo(uw.x) * (acc[cc][4 * q4] + bias), bfhi(uw.x) * (acc[cc][4 * q4 + 1] + bias)), pk2(bflo(uw.y) * (acc[cc][4 * q4 + 2] + bias), bfhi(uw.y) * (acc[cc][4 * q4 + 3] + bias))}; }
}

#ifndef NAIVE_ATTN
#define NAIVE_ATTN 0
#endif
#ifndef NAIVE_SG
#define NAIVE_SG 0
#endif
DI void naive_attn_phase(const Params& p, int l, int gt, int NT) {
    const bf16_t* ZG = (const bf16_t*)(p.ws + WS_ZG); bf16_t* BR = (bf16_t*)(p.ws + WS_BR); bf16_t* OB = (bf16_t*)(p.ws + WS_OB); float* LSE = (float*)(p.ws + WS_LSE);
    const int sub = gt & 3;
    for (int it = gt >> 2; it < MP * 24; it += NT >> 2) {
        const int m = it / 24, rem = it % 24, hq = rem % 6, gi = rem / 6, t = m & 2047, dil = gi < 2 ? 1 : (gi == 2 ? 4 : 16), kvh = hq / 3;
        float q[16], acc[16];
        { float a[8], b[8]; const bf16_t* qp = ZG + (size_t)m * ZLD + gi * 640 + hq * 64 + sub * 16; unpack8(*(const u32x4*)qp, a); unpack8(*(const u32x4*)(qp + 8), b);
#pragma unroll
          for (int e = 0; e < 8; ++e) { q[e] = a[e]; q[8 + e] = b[e]; acc[e] = 0.f; acc[8 + e] = 0.f; } }
        float mx = -1e30f, ls = 0.f;
        for (int n = 0; n <= 128; ++n) {
            if (t - n * dil < 0) break;
            const bf16_t* kp = ZG + (size_t)(m - n * dil) * ZLD + gi * 640 + 384 + kvh * 64 + sub * 16;
            float a[8], b[8]; unpack8(*(const u32x4*)kp, a); unpack8(*(const u32x4*)(kp + 8), b);
            float d = 0.f;
#pragma unroll
            for (int e = 0; e < 8; ++e) d += q[e] * a[e] + q[8 + e] * b[e];
            d += __shfl_xor(d, 1); d += __shfl_xor(d, 2); d *= 0.125f;
            const float mn = fmaxf(mx, d), al = __expf(mx - mn), pe = __expf(d - mn);
            unpack8(*(const u32x4*)(kp + 128), a); unpack8(*(const u32x4*)(kp + 136), b);
#pragma unroll
            for (int e = 0; e < 8; ++e) { acc[e] = acc[e] * al + pe * a[e]; acc[8 + e] = acc[8 + e] * al + pe * b[e]; }
            ls = ls * al + pe; mx = mn;
        }
        if (gi == 0) ls += __expf(p.in[I_SINK][l * 6 + hq] - mx);
        const float inv = 1.0f / ls; float o[8], o2[8];
#pragma unroll
        for (int e = 0; e < 8; ++e) { o[e] = acc[e] * inv; o2[e] = acc[8 + e] * inv; }
        bf16_t* op = (gi == 0 ? BR : OB + (size_t)(gi - 1) * MPAD * BW) + (size_t)m * BW + hq * 64 + sub * 16;
        *(u32x4*)op = pack8(o); *(u32x4*)(op + 8) = pack8(o2);
        if (gi > 0 && sub == 0) LSE[(size_t)(gi - 1) * MPAD * 8 + (size_t)m * 8 + hq] = mx + __logf(ls);
    }
}
DI void naive_sg_phase(const Params& p, int l, int gt, int NT) {
    const bf16_t* ZG = (const bf16_t*)(p.ws + WS_ZG); bf16_t* BR = (bf16_t*)(p.ws + WS_BR);
    for (int it = gt; it < MP * 48; it += NT) {
        const int m = it / 48, c0 = (it % 48) * 8, g = c0 >> 6, i = m & 127, T0 = m - i;
        float sv[8];
#pragma unroll
        for (int e = 0; e < 8; ++e) sv[e] = 0.f;
        const float* wr = p.in[I_WSD] + ((size_t)(l * 6 + g) * 128 + i) * 128;
        for (int j = 0; j <= i; ++j) { float v[8]; unpack8(*(const u32x4*)(ZG + (size_t)(T0 + j) * ZLD + 4096 + c0), v); const float w = wr[j];
#pragma unroll
            for (int e = 0; e < 8; ++e) sv[e] += w * v[e]; }
        float u[8], o[8]; unpack8(*(const u32x4*)(ZG + (size_t)m * ZLD + 3712 + c0), u); const float bias = p.in[I_BSD][l * 768 + g * 128 + i];
#pragma unroll
        for (int e = 0; e < 8; ++e) o[e] = u[e] * (sv[e] + bias);
        *(u32x4*)(BR + 3ull * MPAD * BW + (size_t)m * BW + c0) = pack8(o);
    }
}
constexpr int CP_A = 256 * 32 * 127, CP_B2 = 256 * 32 * 511, CP_B3 = 256 * 32 * 2047, CP_T0 = CP_A, CP_T1 = 2 * CP_A, CP_T2 = CP_T1 + CP_B2, CP_T3 = CP_T2 + CP_B3, CP_NCH = CP_T3 / 64;
static_assert(CP_T3 % 64 == 0, "copy chunks");
DI void cp_decode(const Params& p, int l, int i, const float*& src, float*& dst) {
    if (i < CP_T0) { const int seg = i / (32 * 127), off = i % (32 * 127); const size_t base = ((size_t)l * 256 + seg) * 128 * 128; src = p.in[I_CA] + base + 128 + (size_t)off * 4; dst = p.out + O_AS + base + (size_t)off * 4; }
    else if (i < CP_T1) { i -= CP_T0; const int seg = i / (32 * 127), off = i % (32 * 127); const size_t base = ((size_t)l * 256 + seg) * 128 * 128; src = p.in[I_CB1] + base + 128 + (size_t)off * 4; dst = p.out + O_B1S + base + (size_t)off * 4; }
    else if (i < CP_T2) { i -= CP_T1; const int seg = i / (32 * 511), off = i % (32 * 511); const size_t base = ((size_t)l * 256 + seg) * 512 * 128; src = p.in[I_CB2] + base + 128 + (size_t)off * 4; dst = p.out + O_B2S + base + (size_t)off * 4; }
    else { i -= CP_T2; const int seg = i / (32 * 2047), off = i % (32 * 2047); const size_t base = ((size_t)l * 256 + seg) * 2048 * 128; src = p.in[I_CB3] + base + 128 + (size_t)off * 4; dst = p.out + O_B3S + base + (size_t)off * 4; }
}
constexpr int CP_NSL = 4;
DI void copy_slice(const Params& p, int l, int s, int gw, int NGW, int lane) {
    for (int c0 = s * NGW + gw; c0 < CP_NCH; c0 += 8 * CP_NSL * NGW) {
        f32x4 v[8]; float* dst[8]; bool ok[8];
#pragma unroll
        for (int q = 0; q < 8; ++q) { const int cid = c0 + q * CP_NSL * NGW; ok[q] = cid < CP_NCH; dst[q] = nullptr; v[q] = (f32x4){0.f, 0.f, 0.f, 0.f};
            if (ok[q]) { const float* src; cp_decode(p, l, cid * 64 + lane, src, dst[q]); v[q] = __builtin_nontemporal_load((const f32x4*)src); } }
#pragma unroll
        for (int q = 0; q < 8; ++q) if (ok[q]) __builtin_nontemporal_store(v[q], (f32x4*)dst[q]);
    }
}
DI void tail_copy(const Params& p, int l, int blk_lo, int blk_hi, int nwg, int wave) {
    int lane = (int)__builtin_amdgcn_mbcnt_hi(~0u, __builtin_amdgcn_mbcnt_lo(~0u, 0u)); asm volatile("" : "+v"(lane));
    int G = gridDim.x, bid = blockIdx.x; asm volatile("" : "+s"(G), "+s"(bid));
    const int r0 = nwg % G; if (r0 == 0 || bid < r0) return;
    const int ne = G - r0, e = bid - r0, nb = blk_hi - blk_lo;
    const int lo = blk_lo + (int)((long long)nb * e / ne), hi = blk_lo + (int)((long long)nb * (e + 1) / ne);
    for (int blk = lo + wave; blk < hi; blk += 8) {
        f32x4 v[16]; float* dst[16];
#pragma unroll
        for (int q = 0; q < 16; ++q) { const float* src; cp_decode(p, l, (blk * 16 + q) * 64 + lane, src, dst[q]); v[q] = __builtin_nontemporal_load((const f32x4*)src); }
#pragma unroll
        for (int q = 0; q < 16; ++q) __builtin_nontemporal_store(v[q], (f32x4*)dst[q]);
    }
}
constexpr int CP_NB = CP_NCH / 16, CPQ0 = 0, CPQ1 = 3149, CPQ2 = 7874, CPQ3 = 11023, CPQ4 = 14060, CPQ5 = CP_NB;
static_assert(CP_NCH % 16 == 0 && CP_NB == 22496, "copy blocks");
DI void mixer_phase(const Params& p, LAS unsigned char* lds, int l, int gw, int NGW, int wave, int lane, int gt, int NT) {
    const bf16_t* ZG = (const bf16_t*)(p.ws + WS_ZG);
    bf16_t* BR = (bf16_t*)(p.ws + WS_BR); bf16_t* OB = (bf16_t*)(p.ws + WS_OB); float* LSE = (float*)(p.ws + WS_LSE);
    LAS unsigned char* qimg = lds + wave * 16896; LAS unsigned char* img = qimg + 12288;
    constexpr int NCMP = 7;
    { const int bid_ = gw >> 3, G_ = NGW >> 3;
      if (wave >= NCMP) return;
      gw = bid_ * NCMP + wave; NGW = G_ * NCMP; gt = bid_ * (NCMP * 64) + wave * 64 + lane; NT = G_ * (NCMP * 64); }
#ifndef MIX_REP
#define MIX_REP 0
#endif
    for (int rep_ = 0; rep_ < ((MIX_REP & 1) ? 2 : 1); ++rep_)
    for (int u = gw; u < 8192; u += NGW) {
        const int gi = u >> 11, rem = u & 2047; const int ld = gi < 2 ? 0 : (gi == 2 ? 2 : 4), dil = 1 << ld, lnqb = 6 - ld;
        const int qb = rem & ((1 << lnqb) - 1), rem2 = rem >> lnqb, res = rem2 & (dil - 1), rem3 = rem2 >> ld, kvh = rem3 & 1, b = rem3 >> 1;
        attn_unit(qimg, img, ZG, b * 2048 + res, dil, qb, gi, kvh, gi == 0 ? BR : OB + (size_t)(gi - 1) * MPAD * BW, gi == 0 ? 4 * BW : BW, gi == 0 ? nullptr : LSE + (size_t)(gi - 1) * MPAD * 8, gi == 0 ? p.in[I_SINK] + l * 6 : nullptr, lane);
    }
    const bf16_t* Wm = (const bf16_t*)(p.ws + WS_WM) + (size_t)l * 6 * 128 * 128;
#if 0
#else
    for (int rep_ = 0; rep_ < ((MIX_REP & 2) ? 2 : 1); ++rep_)
    for (int u = gw; u < 6144; u += NGW) { const int ib = u & 3, g = (u >> 2) % 6, ch = u / 24; sg_unit(img, ZG, Wm, p.in[I_BSD] + l * 768, ch * 128, g, ib, BR + 3 * BW, 4 * BW, lane); }
#endif
    for (int rep_ = 0; rep_ < ((MIX_REP & 4) ? 2 : 1); ++rep_)
    for (int u = gw; u < 3072; u += NGW) {
        const int hq = u % 6, gi = (u / 6) & 3, b = u / 24; const int W = gi < 2 ? 128 : (gi == 2 ? 512 : 2048), dil = gi < 2 ? 1 : (gi == 2 ? 4 : 16);
        const float* cache = (gi == 0 ? p.in[I_CA] : (gi == 1 ? p.in[I_CB1] : (gi == 2 ? p.in[I_CB2] : p.in[I_CB3]))) + (size_t)l * 256 * W * 128;
        sattn_unit(ZG, cache, W, dil, b, gi, hq, gi == 0 ? BR : OB + (size_t)(gi - 1) * MPAD * BW, gi == 0 ? 4 * BW : BW, gi == 0 ? nullptr : LSE + (size_t)(gi - 1) * MPAD * 8, gi == 0 ? p.in[I_SINK] + l * 6 : nullptr, lane);
    }
    const float* cw = p.in[I_CONV] + l * 3 * BW;
    for (int it = gt; it < (MP / 16) * 48; it += NT) {
        const int run = it / 48, c0 = (it % 48) * 8, m0 = run * 16, t0 = m0 & 2047;
        float w0[8], w1[8], w2[8], z1[8], z2[8];
#pragma unroll
        for (int e = 0; e < 8; ++e) { w0[e] = cw[c0 + e]; w1[e] = cw[BW + c0 + e]; w2[e] = cw[2 * BW + c0 + e]; z1[e] = 0.f; z2[e] = 0.f; }
        if (t0 >= 2) { float a[8], bb[8]; const bf16_t* zr = ZG + (size_t)(m0 - 1) * ZLD;
            unpack8(*(const u32x4*)(zr + 2944 + c0), a); unpack8(*(const u32x4*)(zr + 3328 + c0), bb);
#pragma unroll
            for (int e = 0; e < 8; ++e) z1[e] = a[e] * bb[e];
            unpack8(*(const u32x4*)(zr - ZLD + 2944 + c0), a); unpack8(*(const u32x4*)(zr - ZLD + 3328 + c0), bb);
#pragma unroll
            for (int e = 0; e < 8; ++e) z2[e] = a[e] * bb[e]; }
        for (int b4 = 0; b4 < 4; ++b4) {
            u32x4 rb[4], rc[4], rx[4];
#pragma unroll
            for (int j = 0; j < 4; ++j) { const bf16_t* zr = ZG + (size_t)(m0 + 4 * b4 + j) * ZLD; rb[j] = *(const u32x4*)(zr + 2560 + c0); rc[j] = *(const u32x4*)(zr + 2944 + c0); rx[j] = *(const u32x4*)(zr + 3328 + c0); }
#pragma unroll
            for (int j = 0; j < 4; ++j) {
                const int m = m0 + 4 * b4 + j, t = t0 + 4 * b4 + j;
                float gb[8], gc[8], xc[8], zc[8], oc[8]; unpack8(rb[j], gb); unpack8(rc[j], gc); unpack8(rx[j], xc);
#pragma unroll
                for (int e = 0; e < 8; ++e) { zc[e] = gc[e] * xc[e]; oc[e] = gb[e] * (w0[e] * z2[e] + w1[e] * z1[e] + w2[e] * zc[e]); z2[e] = z1[e]; z1[e] = zc[e]; }
                *(u32x4*)(BR + (size_t)m * (4 * BW) + 2 * BW + c0) = pack8(oc);
                if (t >= 2046) { float* d = p.out + O_CP + ((size_t)(l * 16 + (m >> 11)) * 2 + (t - 2046)) * BW + c0; *(f32x4*)d = (f32x4){zc[0], zc[1], zc[2], zc[3]}; *(f32x4*)(d + 4) = (f32x4){zc[4], zc[5], zc[6], zc[7]}; }
            }
        }
    }
    for (int it = gt; it < MS * 48; it += NT) {
        const int b = it / 48, c0 = (it % 48) * 8, m = MP + b;
        const bf16_t* zrow = ZG + (size_t)m * ZLD;
        float gb[8], gc[8], xc[8], uu[8], vv[8], oc[8], od[8];
        unpack8(*(const u32x4*)(zrow + 2560 + c0), gb); unpack8(*(const u32x4*)(zrow + 2944 + c0), gc); unpack8(*(const u32x4*)(zrow + 3328 + c0), xc);
        unpack8(*(const u32x4*)(zrow + 3712 + c0), uu); unpack8(*(const u32x4*)(zrow + 4096 + c0), vv);
        const float* s = p.in[I_SC] + ((size_t)(l * 128 + b) * 2) * BW + c0;
        const int g = c0 >> 6; const float w00 = p.in[I_WSD][((size_t)l * 6 + g) * 16384], b0 = p.in[I_BSD][l * 768 + g * 128];
        float* dc = p.out + O_CS + ((size_t)(l * 128 + b) * 2) * BW + c0; float* dd = p.out + O_DS + (size_t)(l * 128 + b) * BW + c0;
#pragma unroll
        for (int e = 0; e < 8; ++e) { const float zc = gc[e] * xc[e]; oc[e] = gb[e] * (cw[c0 + e] * s[e] + cw[BW + c0 + e] * s[BW + e] + cw[2 * BW + c0 + e] * zc); od[e] = uu[e] * (w00 * vv[e] + b0);
            dc[e] = s[BW + e]; dc[BW + e] = zc; dd[e] = vv[e]; }
        *(u32x4*)(BR + (size_t)m * (4 * BW) + 2 * BW + c0) = pack8(oc);
        *(u32x4*)(BR + (size_t)m * (4 * BW) + 3 * BW + c0) = pack8(od);
    }
}
DI void merge_phase(const Params& p, int gt, int NT) {
    bf16_t* BR = (bf16_t*)(p.ws + WS_BR); const bf16_t* OB = (const bf16_t*)(p.ws + WS_OB); const float* LSE = (const float*)(p.ws + WS_LSE);
    for (int it = gt; it < MTOK * 48; it += NT) {
        const int m = it / 48, cch = it % 48, head = cch >> 3;
        const float l0 = LSE[(size_t)m * 8 + head], l1 = LSE[(size_t)MPAD * 8 + (size_t)m * 8 + head], l2 = LSE[2ull * MPAD * 8 + (size_t)m * 8 + head];
        const float mx = fmaxf(l0, fmaxf(l1, l2)); float w0 = __expf(l0 - mx), w1 = __expf(l1 - mx), w2 = __expf(l2 - mx); const float inv = 1.0f / (w0 + w1 + w2); w0 *= inv; w1 *= inv; w2 *= inv;
        float a[8], b[8], c[8], o[8];
        unpack8(*(const u32x4*)(OB + (size_t)m * BW + cch * 8), a); unpack8(*(const u32x4*)(OB + (size_t)MPAD * BW + (size_t)m * BW + cch * 8), b); unpack8(*(const u32x4*)(OB + 2ull * MPAD * BW + (size_t)m * BW + cch * 8), c);
#pragma unroll
        for (int e = 0; e < 8; ++e) o[e] = w0 * a[e] + w1 * b[e] + w2 * c[e];
        *(u32x4*)(BR + (size_t)m * (4 * BW) + BW + cch * 8) = pack8(o);
    }
}
constexpr int NPH = 20;
DI void grid_barrier(unsigned* bar, unsigned target, int wave_s) {
    __syncthreads();
    if (wave_s == 0) {
        if (__builtin_amdgcn_mbcnt_hi(~0u, __builtin_amdgcn_mbcnt_lo(~0u, 0u)) == 0u) {
            __builtin_amdgcn_fence(__ATOMIC_RELEASE, "agent");
            __hip_atomic_fetch_add(bar, 1u, __ATOMIC_RELAXED, __HIP_MEMORY_SCOPE_AGENT);
            while (__hip_atomic_load(bar, __ATOMIC_RELAXED, __HIP_MEMORY_SCOPE_AGENT) < target) __builtin_amdgcn_s_sleep(1);
        }
        __builtin_amdgcn_fence(__ATOMIC_ACQUIRE, "agent");
    }
    __syncthreads();
}
#ifndef DEBUG_CHK
#define DEBUG_CHK 0
#endif
#if DEBUG_CHK
DI const float* xin_row(const Params& p, int m) { return m < MP ? p.in[I_XP] + (size_t)m * 1024 : p.in[I_XS] + (size_t)(m - MP) * 1024; }
DI void dbg_phase(const Params& p, int kind_in, int gw, int NGW, int lane, int gt, int NT) {
    const int L = (kind_in >= 10 && kind_in < 20) ? 1 : 0, kind = kind_in == 99 ? 99 : kind_in - 10 * L;
    float* dbg = (float*)(p.ws + WS_BAR + 128);
    const bf16_t* ZG = (const bf16_t*)(p.ws + WS_ZG); const bf16_t* BR = (const bf16_t*)(p.ws + WS_BR); const bf16_t* MRG = (const bf16_t*)(p.ws + WS_MRG);
    const bf16_t* H = (const bf16_t*)(p.ws + WS_H); const bf16_t* ACT = (const bf16_t*)(p.ws + WS_ACT); const float* X = (const float*)(p.ws + WS_X);
    if (kind == 99) {
        int code = 0;
        for (int k = 1; k <= 7; ++k) if (code == 0 && dbg[k] > 1e-3f * dbg[8 + k]) code = k;
        if (code) { const float a = 1.0f + 0.1f * sqrtf((float)code); for (int i = gt; i < 98304; i += NT) p.out[O_DS + i] *= a; }
        return;
    }
    for (int s = gw; s < 16384; s += NGW) {
        const int m = MP + (int)(((unsigned)s * 2654435761u) % 128u), ci = s & 7; const unsigned hsh = (unsigned)s * 40503u + 12345u; float fast = 0.f, naive = 0.f;
        const float* xr = L ? X + (size_t)m * 1024 : xin_row(p, m);
        if (kind == 1) {
            int c = (int)(hsh % 8576u); if (c >= 4480) c += 128;
            float ss = 0.f; for (int k = lane; k < 1024; k += 64) ss += xr[k] * xr[k];
            const float rs = 1.0f / sqrtf(wave_sum(ss) * (1.f / 1024.f) + EPS); float acc = 0.f;
            for (int k = lane; k < 1024; k += 64) { const float hv = xr[k] * rs * p.in[I_LN1][L * 1024 + k];
                acc += hv * (c < GOFF ? p.in[I_WIN][(size_t)L * 1024 * 4480 + (size_t)k * 4480 + c] : p.in[I_WG][(size_t)L * 4 * 1048576 + ((size_t)((c - GOFF) >> 10) * 1024 + k) * 1024 + ((c - GOFF) & 1023)]); }
            acc = wave_sum(acc); naive = c < GOFF ? acc : 1.0f / (1.0f + __expf(-(acc + p.in[I_BG][L * 4096 + c - GOFF])));
            fast = bf1(ZG[(size_t)m * ZLD + c]);
        } else if (kind == 2 || kind == 3 || kind == 6) {
            const int c = (int)(hsh & 1023u);
            float v = 0.f;
            if (kind == 2) {
                for (int n = 0; n < 4; ++n) { float acc = 0.f; for (int k = lane; k < 384; k += 64) acc += bf1(BR[((size_t)n * MPAD + m) * BW + k]) * p.in[I_WB][(size_t)L * 4 * 384 * 1024 + ((size_t)n * 384 + k) * 1024 + c];
                    v += bf1(ZG[(size_t)m * ZLD + GOFF + n * 1024 + c]) * wave_sum(acc); }
                naive = v; fast = bf1(MRG[(size_t)m * 1024 + c]);
            } else {
                float acc = 0.f; for (int k = lane; k < 1024; k += 64) acc += bf1(MRG[(size_t)m * 1024 + k]) * p.in[I_WO][(size_t)k * 1024 + c];
                v = xr[c] + wave_sum(acc);
                if (kind == 6) { float a2 = 0.f; for (int k = lane; k < DFF; k += 64) a2 += bf1(ACT[(size_t)m * DFF + k]) * p.in[I_WFO][(size_t)k * 1024 + c]; v += wave_sum(a2); }
                naive = v; fast = X[(size_t)m * 1024 + c];
            }
        } else if (kind == 7) {
            const int hs = (int)(hsh & 31u), gi = hs >> 3, hh = hs & 7, col0 = gi * 640 + hh * 64;
            float ss = 0.f; for (int k = lane; k < 1024; k += 64) ss += xr[k] * xr[k];
            const float rs = 1.0f / sqrtf(wave_sum(ss) * (1.f / 1024.f) + EPS); float z = 0.f;
            for (int k = 0; k < 1024; ++k) z += xr[k] * rs * p.in[I_LN1][k] * p.in[I_WIN][(size_t)k * 4480 + col0 + lane];
            const float r2 = 1.0f / sqrtf(wave_sum(z * z) * (1.f / 64.f) + EPS);
            const float* gn = hh < 6 ? (gi == 0 ? p.in[I_QNA] : p.in[I_QNB] + (gi - 1) * 64) : (gi == 0 ? p.in[I_KNA] : p.in[I_KNB] + (gi - 1) * 64);
            float y = z * r2 * gn[lane];
            const float pos = m >= MP ? 16384.f : (float)(m & 2047); const float ang = pos * INV_FREQ[lane & 7];
            const float other = __shfl_xor(y, 8);
            if (lane < 8) y = y * cosf(ang) - other * sinf(ang); else if (lane < 16) y = y * cosf(ang) + other * sinf(ang);
            naive = y; fast = bf1(ZG[(size_t)m * ZLD + col0 + lane]);
            atomicAdd(&dbg[kind], (fast - naive) * (fast - naive)); atomicAdd(&dbg[8 + kind], naive * naive); continue;
        } else if (kind == 7 + 100) {
        } else if (kind == 9) {
            const int b = m - MP, hq = (int)(hsh % 6u), gi = (int)((hsh >> 8) & 3u), kvh = hq / 3, W = gi < 2 ? 128 : (gi == 2 ? 512 : 2048), dil = gi < 2 ? 1 : (gi == 2 ? 4 : 16);
            const float* cache = (gi == 0 ? p.in[I_CA] : (gi == 1 ? p.in[I_CB1] : (gi == 2 ? p.in[I_CB2] : p.in[I_CB3])));
            const float* Kc = cache + ((size_t)(b * 2 + 0) * W) * 128 + kvh * 64; const float* Vc = cache + ((size_t)(b * 2 + 1) * W) * 128 + kvh * 64;
            const bf16_t* zr = ZG + (size_t)m * ZLD + gi * 640; const bf16_t* qp = zr + hq * 64;
            float sc[3], pv[3]; float mx = -1e30f;
            for (int j = 0; j < 3; ++j) { const int n = j < 2 ? 1 + lane + 64 * j : 0; const bool ok = j < 2 || lane == 0; float dsum = 0.f;
                if (ok) { for (int e = 0; e < 64; ++e) dsum += bf1(qp[e]) * (n == 0 ? bf1(zr[384 + kvh * 64 + e]) : Kc[(size_t)(W - n * dil) * 128 + e]); }
                sc[j] = ok ? dsum * 0.125f : -1e30f; mx = fmaxf(mx, sc[j]); }
            mx = wave_max(mx); float ls = 0.f;
            for (int j = 0; j < 3; ++j) { pv[j] = sc[j] > -1e29f ? __expf(sc[j] - mx) : 0.f; ls += pv[j]; }
            ls = wave_sum(ls); if (gi == 0) ls += __expf(p.in[I_SINK][hq] - mx);
            const bf16_t* fo = (gi == 0 ? BR : (const bf16_t*)(p.ws + WS_OB) + (size_t)(gi - 1) * MPAD * BW) + (size_t)m * BW + hq * 64;
            for (int dd = 0; dd < 8; ++dd) { float a = 0.f;
                for (int j = 0; j < 3; ++j) { const int n = j < 2 ? 1 + lane + 64 * j : 0; if (pv[j] > 0.f) a += pv[j] * (n == 0 ? bf1(zr[512 + kvh * 64 + dd]) : Vc[(size_t)(W - n * dil) * 128 + dd]); }
                a = wave_sum(a) / ls; const float f = bf1(fo[dd]);
                if (lane == 0) { atomicAdd(&dbg[7], (f - a) * (f - a)); atomicAdd(&dbg[15], a * a); } }
            continue;
        } else if (kind == 8) {
            const int mm = (int)(((unsigned)s * 2654435761u) % (unsigned)MP), hq = (int)(hsh % 6u), gi = (int)((hsh >> 8) & 3u), t = mm & 2047, dil = gi < 2 ? 1 : (gi == 2 ? 4 : 16), kvh = hq / 3;
            const bf16_t* qp = ZG + (size_t)mm * ZLD + gi * 640 + hq * 64;
            float sc[3], pv[3]; float mx = -1e30f;
            for (int j = 0; j < 3; ++j) { const int n = j < 2 ? lane + 64 * j : 128; const bool ok = (j < 2 || lane == 0) && (t - n * dil >= 0); float dsum = 0.f;
                if (ok) { const bf16_t* kp = ZG + (size_t)(mm - n * dil) * ZLD + gi * 640 + 384 + kvh * 64; for (int e = 0; e < 64; ++e) dsum += bf1(qp[e]) * bf1(kp[e]); }
                sc[j] = ok ? dsum * 0.125f : -1e30f; mx = fmaxf(mx, sc[j]); }
            mx = wave_max(mx); float ls = 0.f;
            for (int j = 0; j < 3; ++j) { pv[j] = sc[j] > -1e29f ? __expf(sc[j] - mx) : 0.f; ls += pv[j]; }
            ls = wave_sum(ls); if (gi == 0) ls += __expf(p.in[I_SINK][hq] - mx);
            const bf16_t* fo = (gi == 0 ? BR : (const bf16_t*)(p.ws + WS_OB) + (size_t)(gi - 1) * MPAD * BW) + (size_t)mm * BW + hq * 64;
            for (int dd = 0; dd < 8; ++dd) { float a = 0.f;
                for (int j = 0; j < 3; ++j) { const int n = j < 2 ? lane + 64 * j : 128; if (pv[j] > 0.f) a += pv[j] * bf1(ZG[(size_t)(mm - n * dil) * ZLD + gi * 640 + 512 + kvh * 64 + dd]); }
                a = wave_sum(a) / ls; const float f = bf1(fo[dd]);
                if (lane == 0) { atomicAdd(&dbg[gi], (f - a) * (f - a)); atomicAdd(&dbg[8 + gi], a * a); } }
            if (gi > 0 && lane == 0) { const float lf = ((const float*)(p.ws + WS_LSE))[(size_t)(gi - 1) * MPAD * 8 + (size_t)mm * 8 + hq], ln = mx + __logf(ls); atomicAdd(&dbg[4], (lf - ln) * (lf - ln)); atomicAdd(&dbg[12], 1.0f); }
            continue;
        } else if (kind == 4) {
            const int c = (int)(hsh & 1023u); const float* xx = X + (size_t)m * 1024;
            float ss = 0.f; for (int k = lane; k < 1024; k += 64) ss += xx[k] * xx[k];
            const float rs = 1.0f / sqrtf(wave_sum(ss) * (1.f / 1024.f) + EPS); naive = xx[c] * rs * p.in[I_LN2][L * 1024 + c]; fast = bf1(H[(size_t)m * 1024 + c]);
        } else if (kind == 5) {
            const int c = (int)(hsh % 2816u);
            float a1 = 0.f, a2 = 0.f; for (int k = lane; k < 1024; k += 64) { const float hv = bf1(H[(size_t)m * 1024 + k]); a1 += hv * p.in[I_WFI][(size_t)L * 1024 * 5632 + (size_t)k * 5632 + c]; a2 += hv * p.in[I_WFI][(size_t)L * 1024 * 5632 + (size_t)k * 5632 + DFF + c]; }
            a1 = wave_sum(a1); a2 = wave_sum(a2); naive = a1 / (1.0f + __expf(-a1)) * a2; fast = bf1(ACT[(size_t)m * DFF + c]);
        }
        if (lane == 0) { atomicAdd(&dbg[kind], (fast - naive) * (fast - naive)); atomicAdd(&dbg[8 + kind], naive * naive); }
    }
}
#endif
template <int PH> DI void run_phase(const Params& p0, LAS unsigned char* lds, int wave_s) {
    Params p;
    { int z_ = 0; asm volatile("" : "+s"(z_));
#pragma unroll
      for (int i = 0; i < 24; ++i) p.in[i] = p0.in[i + z_];
      p.out = (&p0.out)[z_]; p.ws = (&p0.ws)[z_]; p.ph_lo = 0; p.ph_hi = 0; }
    int tid = wave_s * 64 + (int)__builtin_amdgcn_mbcnt_hi(~0u, __builtin_amdgcn_mbcnt_lo(~0u, 0u)); asm volatile("" : "+v"(tid));
    const int G = gridDim.x, bid = blockIdx.x, NGW = G * 8, NT = G * 512;
    const int lane = tid & 63, wave = wave_s, gw = bid * 8 + wave, gt = bid * 512 + tid;
    float* X = (float*)(p.ws + WS_X); bf16_t* H = (bf16_t*)(p.ws + WS_H); bf16_t* ZG = (bf16_t*)(p.ws + WS_ZG);
    if constexpr (PH == 0) {
        prologue_weights(p, lds, gw, NGW, wave, lane);
        prologue_misc(p, gt, NT);
        norm_phase(p.in[I_XP], p.in[I_XS], X, p.in[I_LN1], H, gw, NGW, lane);
    } else {
        constexpr int l = (PH - 1) / 10, k = (PH - 1) % 10;
        unsigned char* wl = p.ws + WS_W + (size_t)l * WL_B;
        const bf16_t* W1t = (const bf16_t*)wl; const bf16_t* Wbt = (const bf16_t*)(wl + W1_B); const bf16_t* Wot = (const bf16_t*)(wl + W1_B + WB_B);
        const bf16_t* Wft = (const bf16_t*)(wl + W1_B + WB_B + WO_B); const bf16_t* Wdt = (const bf16_t*)(wl + W1_B + WB_B + WO_B + WF_B);
        if constexpr (k == 0) {
            pg8::Gemm g{H, W1t, MPAD, ZLD, 1024}; pg8::StaticOrder S; S.init(MPAD, ZLD, G, bid);
            EpiZG E{ZG, p.in[I_BG] + (size_t)l * 4096, (const float*)(p.ws + WS_ROPE), p.in[I_QNA] + l * 64, p.in[I_KNA] + l * 64, p.in[I_QNB] + l * 192, p.in[I_KNB] + l * 192, p.out, l};
            pg8::gemm_phase<EpiZG, pg8::StaticOrder, PG8_ALIGN, PG8_SP2>(lds, g, S, E, tid);
            tail_copy(p, l, CPQ0, CPQ1, NTM * 34, wave_s);
        } else if constexpr (k == 1) {
        } else if constexpr (k == 2) {
            mixer_phase(p, lds, l, gw, NGW, wave, lane, gt, NT);
        } else if constexpr (k == 3) {
            merge_phase(p, gt, NT);
        } else if constexpr (k == 4) {
            pg8::Gemm g{(const bf16_t*)(p.ws + WS_BR), Wbt, MPAD, 1024, 4 * BW}; pg8::StaticOrder S; S.init(MPAD, 1024, G, bid);
            EpiBranch E{ZG, (bf16_t*)(p.ws + WS_MRG)};
            pg8::gemm_phase<EpiBranch, pg8::StaticOrder, PG8_ALIGN, PG8_SP2>(lds, g, S, E, tid);
            tail_copy(p, l, CPQ1, CPQ2, NTM * 4, wave_s);
        } else if constexpr (k == 5) {
            pg8::Gemm g{(const bf16_t*)(p.ws + WS_MRG), Wot, MPAD, 1024, 1024}; pg8::StaticOrder S; S.init(MPAD, 1024, G, bid);
            EpiResid E{X, X, MPAD};
            pg8::gemm_phase<EpiResid, pg8::StaticOrder, PG8_ALIGN, PG8_SP2>(lds, g, S, E, tid);
            tail_copy(p, l, CPQ2, CPQ3, NTM * 4, wave_s);
        } else if constexpr (k == 6) {
            norm_phase(X, nullptr, nullptr, p.in[I_LN2] + l * 1024, H, gw, NGW, lane);
        } else if constexpr (k == 7) {
            pg8::Gemm g{H, Wft, MPAD, 2 * DFF, 1024}; pg8::StaticOrder S; S.init(MPAD, 2 * DFF, G, bid);
            EpiSwiglu E{(bf16_t*)(p.ws + WS_ACT)};
            pg8::gemm_phase<EpiSwiglu, pg8::StaticOrder, PG8_ALIGN, PG8_SP2>(lds, g, S, E, tid);
            tail_copy(p, l, CPQ3, CPQ4, NTM * 22, wave_s);
        } else if constexpr (k == 8) {
            pg8::Gemm g{(const bf16_t*)(p.ws + WS_ACT), Wdt, MPAD, 1024, DFF}; pg8::StaticOrder S; S.init(MPAD, 1024, G, bid);
            EpiResid E{X, l == 1 ? p.out : X, l == 1 ? MTOK : MPAD};
            pg8::gemm_phase<EpiResid, pg8::StaticOrder, PG8_ALIGN, PG8_SP2>(lds, g, S, E, tid);
            tail_copy(p, l, CPQ4, CPQ5, NTM * 4, wave_s);
        } else {
            if constexpr (l == 0) norm_phase(X, nullptr, nullptr, p.in[I_LN1] + 1024, H, gw, NGW, lane);
        }
    }
}
__global__ void __launch_bounds__(512, 2) fwd_kernel(Params p) {
    extern __shared__ __attribute__((aligned(16))) unsigned char lds_raw[];
    LAS unsigned char* lds = (LAS unsigned char*)lds_raw;
    const int wave_s = __builtin_amdgcn_readfirstlane(threadIdx.x >> 6);
    unsigned* bar = (unsigned*)(p.ws + WS_BAR); const unsigned nblk = gridDim.x;
    if (p.ph_hi - p.ph_lo > 1) cg::this_grid().sync();
#if DEBUG_CHK
    if (p.ph_lo >= 100) { const int tid = threadIdx.x; dbg_phase(p, p.ph_lo - 100, blockIdx.x * 8 + wave_s, gridDim.x * 8, tid & 63, blockIdx.x * 512 + tid, gridDim.x * 512); return; }
#endif
#ifndef REP_MASK
#define REP_MASK 0u
#endif
#define EMPTYPH(K) ((K) == 2 || (K) == 12)
#define NEMPTY(K) ((unsigned)(((K) > 2) + ((K) > 12)))
#define RUN(K) if (!EMPTYPH(K) && p.ph_lo <= (K) && (K) < p.ph_hi) { if ((K) > p.ph_lo) grid_barrier(bar, ((unsigned)((K) - p.ph_lo) - NEMPTY(K)) * nblk, wave_s); run_phase<(K)>(p, lds, wave_s); }
    RUN(0) RUN(1) RUN(2) RUN(3) RUN(4) RUN(5) RUN(6) RUN(7) RUN(8) RUN(9) RUN(10) RUN(11) RUN(12) RUN(13) RUN(14) RUN(15) RUN(16) RUN(17) RUN(18) RUN(19)
#undef RUN
}
}

extern "C" void kernel_launch(void* const* d_in, const int* in_sizes, int n_in, void* d_out, int out_size, void* d_ws, size_t ws_size, hipStream_t stream) {
    static int grid = 0;
    if (grid == 0) {
        if (n_in != 24 || (size_t)out_size != mk::O_END || ws_size < mk::WS_END) { fprintf(stderr, "kernel_launch: unexpected shapes: n_in %d out %d ws %zu (need %zu)\n", n_in, out_size, ws_size, (size_t)mk::WS_END); grid = -1; return; }
        int dev = 0, cus = 0, per_cu = 0;
        if (hipGetDevice(&dev) != hipSuccess || hipDeviceGetAttribute(&cus, hipDeviceAttributeMultiprocessorCount, dev) != hipSuccess) { fprintf(stderr, "kernel_launch: device query failed\n"); grid = -1; return; }
        if (hipFuncSetAttribute((const void*)mk::fwd_kernel, hipFuncAttributeMaxDynamicSharedMemorySize, mk::LDS_BYTES) != hipSuccess) { fprintf(stderr, "kernel_launch: hipFuncSetAttribute failed\n"); grid = -1; return; }
        if (hipOccupancyMaxActiveBlocksPerMultiprocessor(&per_cu, (const void*)mk::fwd_kernel, 512, mk::LDS_BYTES) != hipSuccess || per_cu < 1) { fprintf(stderr, "kernel_launch: occupancy query gave %d\n", per_cu); per_cu = 1; }
        (void)hipGetLastError();
        grid = cus * 1;
    }
    if (grid < 0) return;
    if (hipMemsetAsync((char*)d_ws + mk::WS_BAR, 0, 256, stream) != hipSuccess) { fprintf(stderr, "kernel_launch: memset failed\n"); return; }
    mk::Params p{};
    for (int i = 0; i < 24; ++i) p.in[i] = (const float*)d_in[i];
    p.out = (float*)d_out; p.ws = (unsigned char*)d_ws;
#if ONE_LAUNCH
    p.ph_lo = 0; p.ph_hi = mk::NPH;
    void* args[] = {&p};
    hipError_t e = hipLaunchCooperativeKernel((const void*)mk::fwd_kernel, dim3(grid), dim3(512), args, mk::LDS_BYTES, stream);
    if (e != hipSuccess) fprintf(stderr, "kernel_launch: cooperative launch failed: %s (grid %d)\n", hipGetErrorString(e), grid);
#else
    for (int ph = 0; ph < mk::NPH; ++ph) {
        p.ph_lo = ph; p.ph_hi = ph + 1;
        hipLaunchKernelGGL(mk::fwd_kernel, dim3(grid), dim3(512), mk::LDS_BYTES, stream, p);
#if DEBUG_CHK
        const int kind = ph == 1 ? 1 : ph == 3 ? 9 : ph == 5 ? 2 : ph == 6 ? 3 : ph == 7 ? 4 : ph == 8 ? 5 : ph == 9 ? 6 : 0;
        if (kind) { p.ph_lo = 100 + kind; p.ph_hi = 101 + kind; hipLaunchKernelGGL(mk::fwd_kernel, dim3(grid), dim3(512), mk::LDS_BYTES, stream, p); }
#endif
    }
#if DEBUG_CHK
    p.ph_lo = 199; p.ph_hi = 200; hipLaunchKernelGGL(mk::fwd_kernel, dim3(grid), dim3(512), mk::LDS_BYTES, stream, p);
#endif
#endif
}
```

```cpp
#include <hip/hip_runtime.h>
#include <hip/hip_cooperative_groups.h>
#include <cstdio>
#include <cstdint>
namespace cg = cooperative_groups;
#ifndef ONE_LAUNCH
#define ONE_LAUNCH 1
#endif
namespace pg8 {
#define PG8_LAS __attribute__((address_space(3)))
typedef unsigned short bf16_t;
typedef short bf16x8 __attribute__((ext_vector_type(8)));
typedef float f32x4 __attribute__((ext_vector_type(4)));
typedef unsigned u32x4 __attribute__((ext_vector_type(4)));
constexpr int BM = 256, BK = 64, HALF = 128, HTB = HALF * BK * 2  , STAGE_BYTES = 8 * HTB, NXCD = 8, WGM = 8;

__host__ __device__ __forceinline__ int lds_byte(int r, int c) { const int st = (r >> 4) * 2 + (c >> 5), rr = r & 15, cc = c & 31, ob = rr * 64 + cc * 2; return st * 1024 + (ob ^ (((ob >> 9) & 1) << 5)); }
__host__ __device__ __forceinline__ void stage_rc(int b, int& R, int& C) { const int st = b / 1024, sb = b % 1024, swz = sb ^ (((sb >> 9) & 1) << 5); R = (st >> 1) * 16 + swz / 64; C = (st & 1) * 32 + (swz % 64) / 2; }
__host__ __device__ __forceinline__ int perm32(int rho) { const int n = rho >> 4, i = rho & 15; return 8 * (i >> 2) + 4 * n + (i & 3); }

struct Unit { int pm, pn; };
struct Gemm { const bf16_t* A; const bf16_t* Bt; int M, N, K; };

struct StaticOrder {
    int nM, nN, nwg, G, c;
    __host__ __device__ void init(int M, int N, int G_, int c_) { nM = M / BM; nN = N / BM; nwg = nM * nN; G = G_; c = c_; }
    __host__ __device__ bool next(int i, Unit& u) const {
        const long L = (long)i * G + c; if (L >= nwg) return false;
        int wgid = (int)L; { const int q = nwg / NXCD, r = nwg % NXCD, xcd = wgid % NXCD, off = wgid / NXCD; wgid = (xcd < r ? xcd * (q + 1) : r * (q + 1) + (xcd - r) * q) + off; }
        const int nig = WGM * nN, gid = wgid / nig, fm = gid * WGM, gsz = (nM - fm) < WGM ? (nM - fm) : WGM;
        u.pm = fm + ((wgid % nig) % gsz); u.pn = (wgid % nig) / gsz; return true;
    }
    __device__ __forceinline__ void a_ready(const Unit&) const {}
    __device__ __forceinline__ void done(const Unit&) const {}
};

__device__ __forceinline__ unsigned cvt_pk_bf16(float lo, float hi) { unsigned r; asm volatile("v_cvt_pk_bf16_f32 %0, %1, %2" : "=v"(r) : "v"(lo), "v"(hi)); return r; }
typedef float f32x2 __attribute__((ext_vector_type(2)));
__device__ __forceinline__ f32x2 gelu_pk(f32x2 v) {
    const f32x2 av = __builtin_elementwise_abs(v), d = av * 0.2316418882f + 1.0f;
    f32x2 t; t.x = __builtin_amdgcn_rcpf(d.x); t.y = __builtin_amdgcn_rcpf(d.y);
    f32x2 q = t * 0.5307027145f + (-0.7265760135f); q = q * t + 0.7107068705f; q = q * t + (-0.142248368f); q = q * t + 0.127414796f; q = q * t;
    const f32x2 s = (v * v) * (-0.72134752044f);
    f32x2 e; e.x = __builtin_amdgcn_exp2f(s.x); e.y = __builtin_amdgcn_exp2f(s.y);
    const f32x2 m = v * (q * e), r = v - m;
    f32x2 o; o.x = v.x < 0.f ? m.x : r.x; o.y = v.y < 0.f ? m.y : r.y; return o;
}

template <int ACT  > struct EpiBf16 {
    static constexpr bool PERM = true, AFTER_DRAIN = false; static_assert(ACT == 0 || ACT == 1, "EpiBf16: ACT is 0 (none) or 1 (gelu_pk)");
    bf16_t* O; int ldc; const float* bias; int split_cols; size_t split_stride; float scale0;
    __device__ __forceinline__ void operator()(const f32x4 (&acc)[2][2][4][2], const Unit& u, int wr, int wc, int fr, int fq) const {
        const int row0 = u.pm * BM + wr * 64 + fr; int colt = u.pn * BM; bf16_t* base = O;
        float sc = 1.f; if (split_cols) { const int t = colt / split_cols; base += (size_t)t * split_stride; colt -= t * split_cols; if (t == 0) sc = scale0; }
        const int col0 = colt + wc * 32 + 8 * fq, bcol0 = u.pn * BM + wc * 32 + 8 * fq;
        f32x4 bv[2][2];
#pragma unroll
        for (int bj = 0; bj < 2; ++bj)
#pragma unroll
            for (int n = 0; n < 2; ++n) bv[bj][n] = bias ? *(const f32x4*)(bias + bcol0 + bj * HALF + 4 * n) : (f32x4){0.f, 0.f, 0.f, 0.f};
#pragma unroll
        for (int ai = 0; ai < 2; ++ai)
#pragma unroll
            for (int m = 0; m < 4; ++m) { bf16_t* rowp = base + (size_t)(row0 + ai * HALF + m * 16) * ldc + col0;
#pragma unroll
                for (int bj = 0; bj < 2; ++bj) { f32x4 v0 = acc[ai][bj][m][0] + bv[bj][0], v1 = acc[ai][bj][m][1] + bv[bj][1];
                    if (ACT == 1) { f32x2 a = gelu_pk((f32x2){v0[0], v0[1]}), b = gelu_pk((f32x2){v0[2], v0[3]}), c = gelu_pk((f32x2){v1[0], v1[1]}), d = gelu_pk((f32x2){v1[2], v1[3]});
                        v0 = (f32x4){a.x, a.y, b.x, b.y}; v1 = (f32x4){c.x, c.y, d.x, d.y}; }
                    v0 = v0 * sc; v1 = v1 * sc; u32x4 w; w.x = cvt_pk_bf16(v0[0], v0[1]); w.y = cvt_pk_bf16(v0[2], v0[3]); w.z = cvt_pk_bf16(v1[0], v1[1]); w.w = cvt_pk_bf16(v1[2], v1[3]);
                    *(u32x4*)(rowp + bj * HALF) = w; } }
    }
};

template <class Epi, class Sched, bool ALIGN_EPI = false, bool SP2 = false>
__device__ __forceinline__ void gemm_phase(PG8_LAS unsigned char* lds, const Gemm g, const Sched& S, const Epi& E, int tid_in) {
    int tid_l = tid_in; asm volatile("" : "+v"(tid_l));
    const int tid = tid_l, wid = __builtin_amdgcn_readfirstlane(tid >> 6), lane = tid & 63, wr = wid >> 2, wc = wid & 3, fr = lane & 15, fq = lane >> 4;
    const int K = g.K, nt = K / BK;
    unsigned voffA[2], voffB[2];
#pragma unroll
    for (int i = 0; i < 2; ++i) { int R, C; stage_rc(tid * 16 + i * 8192, R, C); const int Rb = Epi::PERM ? ((R & ~31) + perm32(R & 31)) : R;
        voffA[i] = (unsigned)(R * K + C) * 2u; voffB[i] = (unsigned)(Rb * K + C) * 2u; }
    const size_t kstep = (size_t)(BK * 2);
    const size_t hstep = (size_t)HALF * K * 2;
    const size_t tstep = 2 * hstep;
    const unsigned ldsw = (unsigned)wid * 1024u;
    const int aoff = lds_byte(wr * 64 + fr, fq * 8), boff = lds_byte(wc * 32 + fr, fq * 8);
#define PG8_SA(b, h) (((b) * 2 + (h)) * HTB)
#define PG8_SB(b, h) ((4 + (b) * 2 + (h)) * HTB)
#define PG8_STAGE(bufoff, gbase, voff) do { _Pragma("unroll") for (int _i = 0; _i < 2; ++_i) \
        __builtin_amdgcn_global_load_lds((const unsigned*)((const char*)(gbase) + (voff)[_i]), (PG8_LAS unsigned*)(lds + (bufoff) + ldsw + _i * 8192), 16, 0, 0); } while (0)
#define PG8_LDA(dst, b, h) do { _Pragma("unroll") for (int m = 0; m < 4; ++m) _Pragma("unroll") for (int k = 0; k < 2; ++k) dst[m][k] = *(const PG8_LAS bf16x8*)(lds + PG8_SA(b, h) + aoff + m * 2048 + k * 1024); } while (0)
#define PG8_LDB(dst, b, h) do { _Pragma("unroll") for (int n = 0; n < 2; ++n) _Pragma("unroll") for (int k = 0; k < 2; ++k) dst[n][k] = *(const PG8_LAS bf16x8*)(lds + PG8_SB(b, h) + boff + n * 2048 + k * 1024); } while (0)
#define PG8_MMA(ai, bj, At, Bt) do { __builtin_amdgcn_s_setprio(1); _Pragma("unroll") for (int m = 0; m < 4; ++m) _Pragma("unroll") for (int n = 0; n < 2; ++n) _Pragma("unroll") for (int k = 0; k < 2; ++k) \
        acc[ai][bj][m][n] = __builtin_amdgcn_mfma_f32_16x16x32_bf16(Bt[n][k], At[m][k], acc[ai][bj][m][n], 0, 0, 0); __builtin_amdgcn_s_setprio(0); } while (0)
#define PG8_WAIT_V(n) asm volatile("s_waitcnt vmcnt(" #n ")" ::: "memory")
#define PG8_WAIT_L(n) asm volatile("s_waitcnt lgkmcnt(" #n ")" ::: "memory")
#define PG8_BAR __builtin_amdgcn_s_barrier()
#define PG8_SCHED __builtin_amdgcn_sched_barrier(0)
    Unit cur, nxt; int ui = 0;
    if (!S.next(0, cur)) return;
    f32x4 acc[2][2][4][2];
#pragma unroll
    for (int a = 0; a < 2; ++a)
#pragma unroll
        for (int b = 0; b < 2; ++b)
#pragma unroll
            for (int m = 0; m < 4; ++m)
#pragma unroll
                for (int n = 0; n < 2; ++n) acc[a][b][m][n] = (f32x4){0.f, 0.f, 0.f, 0.f};
    bf16x8 At[4][2], B0[2][2], B1[2][2];
    const char* cA = (const char*)g.A + (size_t)cur.pm * tstep; const char* cB = (const char*)g.Bt + (size_t)cur.pn * tstep;
    S.a_ready(cur);
    if constexpr (SP2) {
        PG8_STAGE(PG8_SB(0, 0), cB, voffB); PG8_STAGE(PG8_SB(0, 1), cB + hstep, voffB); PG8_STAGE(PG8_SA(0, 0), cA, voffA); PG8_STAGE(PG8_SA(0, 1), cA + hstep, voffA);
        if (wr == 1) PG8_BAR;
        PG8_WAIT_V(2); PG8_BAR;
        PG8_STAGE(PG8_SB(1, 0), cB + kstep, voffB); PG8_STAGE(PG8_SA(1, 0), cA + kstep, voffA); PG8_STAGE(PG8_SB(1, 1), cB + hstep + kstep, voffB);
        PG8_WAIT_V(6); PG8_BAR;
    } else {
        PG8_STAGE(PG8_SB(0, 0), cB, voffB); PG8_STAGE(PG8_SA(0, 0), cA, voffA); PG8_STAGE(PG8_SB(0, 1), cB + hstep, voffB); PG8_STAGE(PG8_SA(0, 1), cA + hstep, voffA);
        if (wr == 1) PG8_BAR;
        PG8_WAIT_V(4); PG8_BAR;
        PG8_STAGE(PG8_SB(1, 0), cB + kstep, voffB); PG8_STAGE(PG8_SA(1, 0), cA + kstep, voffA); PG8_STAGE(PG8_SB(1, 1), cB + hstep + kstep, voffB);
        PG8_WAIT_V(6); PG8_BAR;
    }
    for (;;) {
        const bool has_next = S.next(ui + 1, nxt);
        const char* nA = has_next ? (const char*)g.A + (size_t)nxt.pm * tstep : cA; const char* nB = has_next ? (const char*)g.Bt + (size_t)nxt.pn * tstep : cB;
        for (int t = 0; t < nt; t += 2) {
            if constexpr (Epi::SEGMENT_TILES > 0) { if (t > 0 && (t % Epi::SEGMENT_TILES) == 0) E.rescale(acc, cur, t / Epi::SEGMENT_TILES, wr, wc, fr, fq); }
            const bool last = (t == nt - 2);
            const char* a1 = cA + (size_t)(t + 1) * kstep;
            const char* a2 = last ? nA : cA + (size_t)(t + 2) * kstep; const char* b2 = last ? nB : cB + (size_t)(t + 2) * kstep;
            const char* a3 = a2 + kstep; const char* b3 = b2 + kstep;
            if (last && has_next) S.a_ready(nxt);
            if constexpr (SP2) {
            PG8_LDB(B0, 0, 0); PG8_LDB(B1, 0, 1); PG8_SCHED; PG8_LDA(At, 0, 0); PG8_STAGE(PG8_SA(1, 1), a1 + hstep, voffA);
            PG8_WAIT_V(8); PG8_WAIT_L(0); PG8_BAR; PG8_MMA(0, 0, At, B0); PG8_MMA(0, 1, At, B1); PG8_BAR; PG8_SCHED;
            PG8_LDA(At, 0, 1); PG8_STAGE(PG8_SB(0, 0), b2, voffB); PG8_STAGE(PG8_SB(0, 1), b2 + hstep, voffB); PG8_STAGE(PG8_SA(0, 0), a2, voffA);
            PG8_WAIT_V(8); PG8_WAIT_L(0); PG8_BAR; PG8_MMA(1, 0, At, B0); PG8_MMA(1, 1, At, B1); PG8_BAR; PG8_SCHED;
            PG8_LDB(B0, 1, 0); PG8_LDB(B1, 1, 1); PG8_SCHED; PG8_LDA(At, 1, 0); PG8_STAGE(PG8_SA(0, 1), a2 + hstep, voffA);
            PG8_WAIT_V(8); PG8_WAIT_L(0); PG8_BAR; PG8_MMA(0, 0, At, B0); PG8_MMA(0, 1, At, B1); PG8_BAR; PG8_SCHED;
            PG8_LDA(At, 1, 1); PG8_STAGE(PG8_SB(1, 0), b3, voffB); PG8_STAGE(PG8_SB(1, 1), b3 + hstep, voffB); PG8_STAGE(PG8_SA(1, 0), a3, voffA);
            PG8_WAIT_V(8); PG8_WAIT_L(0); PG8_BAR; PG8_MMA(1, 0, At, B0); PG8_MMA(1, 1, At, B1); PG8_BAR; PG8_SCHED;
            } else {
            PG8_LDB(B0, 0, 0); PG8_SCHED; PG8_LDA(At, 0, 0); PG8_STAGE(PG8_SA(1, 1), a1 + hstep, voffA);
            PG8_WAIT_L(8); PG8_BAR; PG8_WAIT_L(0); PG8_MMA(0, 0, At, B0); PG8_BAR; PG8_SCHED;
            PG8_LDB(B1, 0, 1); PG8_STAGE(PG8_SB(0, 0), b2, voffB);
            PG8_BAR; PG8_WAIT_L(0); PG8_MMA(0, 1, At, B1); PG8_BAR;
            PG8_LDA(At, 0, 1); PG8_STAGE(PG8_SA(0, 0), a2, voffA);
            PG8_BAR; PG8_WAIT_L(0); PG8_MMA(1, 0, At, B0); PG8_BAR; PG8_SCHED;
            PG8_STAGE(PG8_SB(0, 1), b2 + hstep, voffB);
            PG8_WAIT_V(6); PG8_BAR; PG8_MMA(1, 1, At, B1); PG8_BAR;
            PG8_LDB(B0, 1, 0); PG8_SCHED; PG8_LDA(At, 1, 0); PG8_STAGE(PG8_SA(0, 1), a2 + hstep, voffA);
            PG8_WAIT_L(8); PG8_BAR; PG8_WAIT_L(0); PG8_MMA(0, 0, At, B0); PG8_BAR; PG8_SCHED;
            PG8_LDB(B1, 1, 1); PG8_STAGE(PG8_SB(1, 0), b3, voffB);
            PG8_BAR; PG8_WAIT_L(0); PG8_MMA(0, 1, At, B1); PG8_BAR;
            PG8_LDA(At, 1, 1); PG8_STAGE(PG8_SA(1, 0), a3, voffA);
            PG8_BAR; PG8_WAIT_L(0); PG8_MMA(1, 0, At, B0); PG8_BAR; PG8_SCHED;
            PG8_STAGE(PG8_SB(1, 1), b3 + hstep, voffB);
            PG8_WAIT_V(6); PG8_BAR; PG8_MMA(1, 1, At, B1); PG8_BAR;
            }
        }
        if constexpr (ALIGN_EPI) { if (wr == 0) PG8_BAR; }
        if constexpr (!Epi::AFTER_DRAIN) { E(acc, cur, wr, wc, fr, fq); S.done(cur); }
        if (!has_next) break;
#pragma unroll
        for (int a = 0; a < 2; ++a)
#pragma unroll
            for (int b = 0; b < 2; ++b)
#pragma unroll
                for (int m = 0; m < 4; ++m)
#pragma unroll
                    for (int n = 0; n < 2; ++n) acc[a][b][m][n] = (f32x4){0.f, 0.f, 0.f, 0.f};
        cur = nxt; cA = nA; cB = nB; ++ui;
        if constexpr (ALIGN_EPI) { if (wr == 1) PG8_BAR; }
    }
    PG8_WAIT_V(0);
    if constexpr (!ALIGN_EPI) { if (wr == 0) PG8_BAR; }
    PG8_BAR;
    if constexpr (Epi::AFTER_DRAIN) { E.fused(acc, cur, wr, wc, fr, fq, lds, wid, lane); S.done(cur); }
#undef PG8_SA
#undef PG8_SB
#undef PG8_STAGE
#undef PG8_LDA
#undef PG8_LDB
#undef PG8_MMA
#undef PG8_WAIT_V
#undef PG8_WAIT_L
#undef PG8_BAR
#undef PG8_SCHED
}
}
#define PG8_SP2 true
#define PG8_ALIGN true
namespace mk {
#define LAS __attribute__((address_space(3)))
using pg8::bf16_t; using pg8::bf16x8; using pg8::f32x4; using pg8::u32x4;
typedef float f32x16 __attribute__((ext_vector_type(16)));
typedef short s16x4 __attribute__((ext_vector_type(4)));
typedef unsigned u32x2 __attribute__((ext_vector_type(2)));

constexpr int MP = 32768, MS = 128, MTOK = MP + MS, MPAD = 33024, NTM = MPAD / 256;
constexpr int ZLD = 8704, GOFF = 4608, BW = 384, DFF = 2816;
constexpr int LDS_BYTES = 131072;
constexpr float LOG2E = 1.4426950408889634f, LN2 = 0.6931471805599453f, EPS = 1e-6f;
enum { I_XP = 0, I_XS, I_CA, I_CB1, I_CB2, I_CB3, I_SC, I_LN1, I_WIN, I_QNA, I_KNA, I_SINK, I_QNB, I_KNB, I_CONV, I_WSD, I_BSD, I_WG, I_BG, I_WB, I_WO, I_LN2, I_WFI, I_WFO };
constexpr size_t O_YP = 0, O_YS = 33554432, O_AP = O_YS + 131072, O_AS = O_AP + 1048576, O_B1P = O_AS + 8388608, O_B1S = O_B1P + 1048576, O_B2P = O_B1S + 8388608,
                 O_B2S = O_B2P + 4194304, O_B3P = O_B2S + 33554432, O_B3S = O_B3P + 16777216, O_CP = O_B3S + 134217728, O_CS = O_CP + 24576, O_DS = O_CS + 196608, O_END = O_DS + 98304;
static_assert(O_END == 241623040, "output size");
constexpr size_t al(size_t x) { return (x + 255) & ~(size_t)255; }
constexpr size_t WS_ROPE = 0;
constexpr size_t WS_WM = al(WS_ROPE + 2049 * 16 * 4);
constexpr size_t WS_W = al(WS_WM + 2 * 6 * 128 * 128 * 2);
constexpr size_t W1_B = (size_t)ZLD * 1024 * 2, WB_B = 4ull * 1024 * 384 * 2, WO_B = 1024ull * 1024 * 2, WF_B = 5632ull * 1024 * 2, WD_B = 1024ull * 2816 * 2;
constexpr size_t WL_B = W1_B + WB_B + WO_B + WF_B + WD_B;
constexpr size_t WS_X = al(WS_W + 2 * WL_B);
constexpr size_t WS_H = al(WS_X + (size_t)MPAD * 1024 * 4);
constexpr size_t WS_ZG = al(WS_H + (size_t)MPAD * 1024 * 2);
constexpr size_t WS_BR = al(WS_ZG + (size_t)MPAD * ZLD * 2);
constexpr size_t WS_OB = al(WS_BR + 4ull * MPAD * BW * 2);
constexpr size_t WS_LSE = al(WS_OB + 3ull * MPAD * BW * 2);
constexpr size_t WS_PART = al(WS_LSE + 3ull * MPAD * 8 * 4);
constexpr size_t WS_MRG = al(WS_PART + (size_t)MPAD * 1024 * 4);
constexpr size_t WS_ACT = al(WS_MRG + (size_t)MPAD * 1024 * 2);
constexpr size_t WS_BAR = al(WS_ACT + (size_t)MPAD * DFF * 2);
constexpr size_t WS_END = al(WS_BAR + 256);

struct Params { const float* in[24]; float* out; unsigned char* ws; int ph_lo, ph_hi; };
static_assert(sizeof(Params) == 216, "Params has padding");

#define DI __device__ __forceinline__
typedef float f32x2v __attribute__((ext_vector_type(2)));
typedef __bf16 bf16x2v __attribute__((ext_vector_type(2)));
DI unsigned pk2(float lo, float hi) { const f32x2v v = {lo, hi}; return __builtin_bit_cast(unsigned, __builtin_convertvector(v, bf16x2v)); }
DI float bflo(unsigned w) { return __uint_as_float(w << 16); }
DI float bfhi(unsigned w) { return __uint_as_float(w & 0xffff0000u); }
DI float bf1(bf16_t v) { return __uint_as_float((unsigned)v << 16); }
DI void unpack8(const u32x4 w, float (&x)[8]) { x[0] = bflo(w.x); x[1] = bfhi(w.x); x[2] = bflo(w.y); x[3] = bfhi(w.y); x[4] = bflo(w.z); x[5] = bfhi(w.z); x[6] = bflo(w.w); x[7] = bfhi(w.w); }
DI u32x4 pack8(const float (&x)[8]) { u32x4 w; w.x = pk2(x[0], x[1]); w.y = pk2(x[2], x[3]); w.z = pk2(x[4], x[5]); w.w = pk2(x[6], x[7]); return w; }
DI float wave_sum(float v) {
#pragma unroll
    for (int o = 1; o < 64; o <<= 1) v += __shfl_xor(v, o);
    return v; }
DI float wave_max(float v) {
#pragma unroll
    for (int o = 1; o < 64; o <<= 1) v = fmaxf(v, __shfl_xor(v, o));
    return v; }
DI float ex2(float x) { return __builtin_amdgcn_exp2f(x); }
DI int crow(int reg, int h) { return (reg & 3) + 8 * (reg >> 2) + 4 * h; }
#define MFMA32(a, b, c) __builtin_amdgcn_mfma_f32_32x32x16_bf16((a), (b), (c), 0, 0, 0)

struct QuadOrder {
    pg8::StaticOrder o;
    __device__ bool next(int i, pg8::Unit& u) const { pg8::Unit q; if (!o.next(i >> 2, q)) return false; const int n = i & 3; u.pm = n * NTM + q.pm; u.pn = n * 4 + q.pn; return true; }
    DI void a_ready(const pg8::Unit&) const {}
    DI void done(const pg8::Unit&) const {}
};
typedef f32x4 AccT[2][2][4][2];
struct EpiZG {
    static constexpr bool PERM = true, AFTER_DRAIN = false; static constexpr int SEGMENT_TILES = 0;
    bf16_t* O; const float* bias; const float* rope; const float* qna; const float* kna; const float* qnb; const float* knb; float* out; int l;
    DI void operator()(const AccT& acc, const pg8::Unit& u, int wr, int wc, int fr_, int fq_) const {
        int fr = fr_, fq = fq_; asm volatile("" : "+v"(fr), "+v"(fq));
        const int rowb = u.pm * 256 + wr * 64 + fr;
        if (u.pn >= 18) {
            const int col0 = u.pn * 256 + wc * 32 + 8 * fq;
            f32x4 bv[2][2];
#pragma unroll
            for (int bj = 0; bj < 2; ++bj) { bv[bj][0] = *(const f32x4*)(bias + col0 + bj * 128 - GOFF); bv[bj][1] = *(const f32x4*)(bias + col0 + bj * 128 - GOFF + 4); }
#pragma unroll
            for (int ai = 0; ai < 2; ++ai)
#pragma unroll
                for (int m = 0; m < 4; ++m) {
#pragma unroll
                    for (int bj = 0; bj < 2; ++bj) {
                        f32x4 v0 = acc[ai][bj][m][0] + bv[bj][0], v1 = acc[ai][bj][m][1] + bv[bj][1];
#pragma unroll
                        for (int e = 0; e < 4; ++e) { v0[e] = __builtin_amdgcn_rcpf(1.f + ex2(-LOG2E * v0[e])); v1[e] = __builtin_amdgcn_rcpf(1.f + ex2(-LOG2E * v1[e])); }
                        u32x4 w; w.x = pk2(v0[0], v0[1]); w.y = pk2(v0[2], v0[3]); w.z = pk2(v1[0], v1[1]); w.w = pk2(v1[2], v1[3]);
                        *(u32x4*)(O + (size_t)(rowb + ai * 128 + m * 16) * ZLD + col0 + bj * 128) = w;
                    }
                    asm volatile("" ::: "memory");
                }
            return;
        }
        const int c64 = u.pn * 4 + wc, colL = c64 * 64 + 8 * fq;
        int type = 3, gi = 0, hh = 0;
        if (c64 < 40) { gi = c64 / 10; hh = c64 - gi * 10; type = hh < 6 ? 0 : (hh < 8 ? 1 : 2); }
        f32x4 g00 = (f32x4){1.f, 1.f, 1.f, 1.f}, g01 = g00, g10 = g00, g11 = g00;
        if (type <= 1) { const float* gn = (type == 0 ? (gi == 0 ? qna : qnb + (gi - 1) * 64) : (gi == 0 ? kna : knb + (gi - 1) * 64)) + 8 * fq;
            g00 = *(const f32x4*)gn; g01 = *(const f32x4*)(gn + 4); g10 = *(const f32x4*)(gn + 32); g11 = *(const f32x4*)(gn + 36); }
        const int W = gi < 2 ? 128 : (gi == 2 ? 512 : 2048);
        const size_t obase_p = gi == 0 ? O_AP : (gi == 1 ? O_B1P : (gi == 2 ? O_B2P : O_B3P)), obase_s = gi == 0 ? O_AS : (gi == 1 ? O_B1S : (gi == 2 ? O_B2S : O_B3S));
#pragma unroll
        for (int ai = 0; ai < 2; ++ai)
#pragma unroll
            for (int m = 0; m < 4; ++m) {
                const int row = rowb + ai * 128 + m * 16;
                f32x4 v00 = acc[ai][0][m][0], v01 = acc[ai][0][m][1], v10 = acc[ai][1][m][0], v11 = acc[ai][1][m][1];
                const bool samp = row >= MP; const int t = row & 2047;
                if (type <= 1) {
                    float ss = 0.f;
#pragma unroll
                    for (int e = 0; e < 4; ++e) ss += v00[e] * v00[e] + v01[e] * v01[e] + v10[e] * v10[e] + v11[e] * v11[e];
                    ss += __shfl_xor(ss, 16); ss += __shfl_xor(ss, 32);
                    const float rs = 1.0f / sqrtf(ss * (1.f / 64.f) + EPS);
                    v00 = v00 * rs * g00; v01 = v01 * rs * g01; v10 = v10 * rs * g10; v11 = v11 * rs * g11;
                    f32x4 y0, y1;
#pragma unroll
                    for (int e = 0; e < 4; ++e) { y0[e] = __shfl_xor(v00[e], 16); y1[e] = __shfl_xor(v01[e], 16); }
                    if (fq < 2) {
                        const float* rp = rope + (samp ? 2048 : t) * 16;
                        const f32x4 c0 = *(const f32x4*)rp, c1 = *(const f32x4*)(rp + 4), c2 = *(const f32x4*)(rp + 8), c3 = *(const f32x4*)(rp + 12);
                        const float sg = fq == 0 ? -1.f : 1.f;
                        v00 = (f32x4){v00[0] * c0[0] + sg * y0[0] * c0[1], v00[1] * c0[2] + sg * y0[1] * c0[3], v00[2] * c1[0] + sg * y0[2] * c1[1], v00[3] * c1[2] + sg * y0[3] * c1[3]};
                        v01 = (f32x4){v01[0] * c2[0] + sg * y1[0] * c2[1], v01[1] * c2[2] + sg * y1[1] * c2[3], v01[2] * c3[0] + sg * y1[2] * c3[1], v01[3] * c3[2] + sg * y1[3] * c3[3]};
                    }
                }
                bf16_t* zp = O + (size_t)row * ZLD + colL;
                { u32x4 w; w.x = pk2(v00[0], v00[1]); w.y = pk2(v00[2], v00[3]); w.z = pk2(v01[0], v01[1]); w.w = pk2(v01[2], v01[3]); *(u32x4*)zp = w; }
                { u32x4 w; w.x = pk2(v10[0], v10[1]); w.y = pk2(v10[2], v10[3]); w.z = pk2(v11[0], v11[1]); w.w = pk2(v11[2], v11[3]); *(u32x4*)(zp + 32) = w; }
                if ((type == 1 || type == 2) && row < MTOK) {
                    const int b = samp ? row - MP : row >> 11, jrow = samp ? W - 1 : t - (2048 - W);
                    if (jrow >= 0) {
                        const size_t cb = samp ? obase_s + ((size_t)(l * 128 + b) * 2) * W * 128 : obase_p + ((size_t)(l * 16 + b) * 2) * W * 128;
                        float* d = out + cb + ((size_t)(type - 1) * W + jrow) * 128 + (hh - (type == 1 ? 6 : 8)) * 64 + 8 * fq;
                        *(f32x4*)d = v00; *(f32x4*)(d + 4) = v01; *(f32x4*)(d + 32) = v10; *(f32x4*)(d + 36) = v11;
                    }
                }
                asm volatile("" ::: "memory");
            }
    }
};
struct EpiBranch {
    static constexpr bool PERM = true, AFTER_DRAIN = false; static constexpr int SEGMENT_TILES = 6;
    const bf16_t* G; bf16_t* mrg;
    DI void rescale(AccT& acc, const pg8::Unit& u, int n, int wr, int wc, int fr_, int fq_) const {
        int fr = fr_, fq = fq_; asm volatile("" : "+v"(fr), "+v"(fq));
        const int row0 = u.pm * 256 + wr * 64 + fr, col0 = u.pn * 256 + wc * 32 + 8 * fq;
#pragma unroll
        for (int ai = 0; ai < 2; ++ai)
#pragma unroll
            for (int m = 0; m < 4; ++m) {
                const bf16_t* gp = G + (size_t)(row0 + ai * 128 + m * 16) * ZLD + GOFF + (n - 1) * 1024 + col0;
#pragma unroll
                for (int bj = 0; bj < 2; ++bj) {
                    float gp0[8], gp1[8]; unpack8(*(const u32x4*)(gp + bj * 128), gp0); unpack8(*(const u32x4*)(gp + 1024 + bj * 128), gp1);
#pragma unroll
                    for (int e = 0; e < 4; ++e) { acc[ai][bj][m][0][e] *= fmaxf(gp0[e], 1e-8f) * __builtin_amdgcn_rcpf(fmaxf(gp1[e], 1e-8f)); acc[ai][bj][m][1][e] *= fmaxf(gp0[4 + e], 1e-8f) * __builtin_amdgcn_rcpf(fmaxf(gp1[4 + e], 1e-8f)); }
                }
                asm volatile("" ::: "memory");
            }
    }
    DI void operator()(const AccT& acc, const pg8::Unit& u, int wr, int wc, int fr_, int fq_) const {
        int fr = fr_, fq = fq_; asm volatile("" : "+v"(fr), "+v"(fq));
        const int row0 = u.pm * 256 + wr * 64 + fr, col0 = u.pn * 256 + wc * 32 + 8 * fq;
#pragma unroll
        for (int ai = 0; ai < 2; ++ai)
#pragma unroll
            for (int m = 0; m < 4; ++m) {
                const size_t row = (size_t)(row0 + ai * 128 + m * 16);
#pragma unroll
                for (int bj = 0; bj < 2; ++bj) {
                    const int col = col0 + bj * 128;
                    float gv[8]; unpack8(*(const u32x4*)(G + row * ZLD + GOFF + 3 * 1024 + col), gv);
                    const f32x4 v0 = acc[ai][bj][m][0], v1 = acc[ai][bj][m][1];
                    u32x4 w; w.x = pk2(v0[0] * fmaxf(gv[0], 1e-8f), v0[1] * fmaxf(gv[1], 1e-8f)); w.y = pk2(v0[2] * fmaxf(gv[2], 1e-8f), v0[3] * fmaxf(gv[3], 1e-8f));
                    w.z = pk2(v1[0] * fmaxf(gv[4], 1e-8f), v1[1] * fmaxf(gv[5], 1e-8f)); w.w = pk2(v1[2] * fmaxf(gv[6], 1e-8f), v1[3] * fmaxf(gv[7], 1e-8f));
                    *(u32x4*)(mrg + row * 1024 + col) = w;
                }
                asm volatile("" ::: "memory");
            }
    }
};
struct EpiResid {
    static constexpr bool PERM = true, AFTER_DRAIN = false; static constexpr int SEGMENT_TILES = 0;
    const float* src; float* dst; int nrows; const float* src_s;
    DI void operator()(const AccT& acc, const pg8::Unit& u, int wr, int wc, int fr_, int fq_) const {
        int fr = fr_, fq = fq_; asm volatile("" : "+v"(fr), "+v"(fq));
        const int row0 = u.pm * 256 + wr * 64 + fr, col0 = u.pn * 256 + wc * 32 + 8 * fq;
#pragma unroll
        for (int ai = 0; ai < 2; ++ai)
#pragma unroll
            for (int m = 0; m < 4; ++m) {
                const int row = row0 + ai * 128 + m * 16;
                if (row < nrows) {
#pragma unroll
                    for (int bj = 0; bj < 2; ++bj) {
                        const size_t off = (size_t)row * 1024 + col0 + bj * 128;
                        const float* sp = src + off; bool zr = false; if (src_s) { if (row >= MTOK) { sp = dst + off; zr = true; } else if (row >= MP) sp = src_s + (off - (size_t)MP * 1024); }
                        f32x4 a0 = *(const f32x4*)sp, a1 = *(const f32x4*)(sp + 4); if (zr) { a0 = (f32x4){0.f, 0.f, 0.f, 0.f}; a1 = a0; }
                        *(f32x4*)(dst + off) = a0 + acc[ai][bj][m][0]; *(f32x4*)(dst + off + 4) = a1 + acc[ai][bj][m][1];
                    }
                    asm volatile("" ::: "memory");
                }
            }
    }
};
struct EpiSwiglu {
    static constexpr bool PERM = true, AFTER_DRAIN = false; static constexpr int SEGMENT_TILES = 0;
    bf16_t* O;
    DI void operator()(const AccT& acc, const pg8::Unit& u, int wr, int wc, int fr_, int fq_) const {
        int fr = fr_, fq = fq_; asm volatile("" : "+v"(fr), "+v"(fq));
        const int row0 = u.pm * 256 + wr * 64 + fr, col0 = u.pn * 128 + wc * 32 + 8 * fq;
#pragma unroll
        for (int ai = 0; ai < 2; ++ai)
#pragma unroll
            for (int m = 0; m < 4; ++m) {
                float o[8];
#pragma unroll
                for (int nn = 0; nn < 2; ++nn)
#pragma unroll
                    for (int e = 0; e < 4; ++e) { const float g = acc[ai][0][m][nn][e], up = acc[ai][1][m][nn][e]; o[nn * 4 + e] = g * __builtin_amdgcn_rcpf(1.f + ex2(-LOG2E * g)) * up; }
                *(u32x4*)(O + (size_t)(row0 + ai * 128 + m * 16) * DFF + col0) = pack8(o);
                asm volatile("" ::: "memory");
            }
    }
};
DI void tr_item(const float* W, int N, bf16_t* WT, int ldk, int k0, int n0, int drow0, LAS float* scr, int lane, int kdst = -1) {
    if (kdst < 0) kdst = k0;
#pragma unroll 8
    for (int i = 0; i < 32; ++i) { const int kk = 2 * i + (lane >> 5); scr[kk * 33 + (lane & 31)] = W[(size_t)(k0 + kk) * N + n0 + (lane & 31)]; }
    const int c = lane & 7;
#pragma unroll
    for (int j = 0; j < 4; ++j) { const int n = (lane >> 3) + 8 * j; const LAS float* s = scr + (8 * c) * 33 + n;
        u32x4 o; o.x = pk2(s[0 * 33], s[1 * 33]); o.y = pk2(s[2 * 33], s[3 * 33]); o.z = pk2(s[4 * 33], s[5 * 33]); o.w = pk2(s[6 * 33], s[7 * 33]);
        *(u32x4*)(WT + (size_t)(drow0 + n) * ldk + kdst + 8 * c) = o; }
}
constexpr int IT_IN = 16 * 140, IT_G = 4 * 512, IT_B = 4 * 192, IT_O = 512, IT_FI = 16 * 176, IT_FO = 44 * 32, IT_L = IT_IN + IT_G + IT_B + IT_O + IT_FI + IT_FO;
DI void prologue_weights(const Params& p, LAS unsigned char* lds, int gw, int NGW, int wave, int lane) {
    LAS float* scr = (LAS float*)(lds + wave * 8448);
    for (int it = gw; it < 2 * IT_L; it += NGW) {
        const int l = it / IT_L; int r = it - l * IT_L;
        unsigned char* wl = p.ws + WS_W + (size_t)l * WL_B;
        bf16_t* W1t = (bf16_t*)wl; bf16_t* Wbt = (bf16_t*)(wl + W1_B); bf16_t* Wot = (bf16_t*)(wl + W1_B + WB_B); bf16_t* Wft = (bf16_t*)(wl + W1_B + WB_B + WO_B); bf16_t* Wdt = (bf16_t*)(wl + W1_B + WB_B + WO_B + WF_B);
        if (r < IT_IN) { const int kb = r / 140, nb = r % 140; const int n0 = 32 * nb, w = n0 & 255; tr_item(p.in[I_WIN] + (size_t)l * 1024 * 4480, 4480, W1t, 1024, 64 * kb, n0, (n0 & ~255) + 128 * ((w >> 5) & 1) + 32 * (w >> 6), scr, lane); continue; } r -= IT_IN;
        if (r < IT_G) { const int n = r / 512, r2 = r % 512, kb = r2 / 32, nb = r2 % 32; tr_item(p.in[I_WG] + (size_t)(l * 4 + n) * 1024 * 1024, 1024, W1t, 1024, 64 * kb, 32 * nb, GOFF + n * 1024 + 32 * nb, scr, lane); continue; } r -= IT_G;
        if (r < IT_B) { const int n = r / 192, r2 = r % 192, kb = r2 / 32, nb = r2 % 32; tr_item(p.in[I_WB] + (size_t)(l * 4 + n) * 384 * 1024, 1024, Wbt, 1536, 64 * kb, 32 * nb, 32 * nb, scr, lane, n * 384 + 64 * kb); continue; } r -= IT_B;
        if (r < IT_O) { const int kb = r / 32, nb = r % 32; tr_item(p.in[I_WO] + (size_t)l * 1024 * 1024, 1024, Wot, 1024, 64 * kb, 32 * nb, 32 * nb, scr, lane); continue; } r -= IT_O;
        if (r < IT_FI) { const int kb = r / 176, nb = r % 176, n0 = 32 * nb; const int dr = n0 < DFF ? 256 * (n0 / 128) + (n0 % 128) : 256 * ((n0 - DFF) / 128) + 128 + ((n0 - DFF) % 128);
            tr_item(p.in[I_WFI] + (size_t)l * 1024 * 5632, 5632, Wft, 1024, 64 * kb, n0, dr, scr, lane); continue; } r -= IT_FI;
        { const int kb = r / 32, nb = r % 32; tr_item(p.in[I_WFO] + (size_t)l * DFF * 1024, 1024, Wdt, DFF, 64 * kb, 32 * nb, 32 * nb, scr, lane); }
    }
}
__constant__ float INV_FREQ[8] = {1.0f, 0.1939227432012558f, 0.03760603070259094f, 0.007292664609849453f, 0.0014142135623842478f, 0.00027424818836152554f, 5.3182957344688475e-05f, 1.0313385246263351e-05f};
DI void prologue_misc(const Params& p, int gt, int NT) {
    for (int i = gt; i < 2 * 16384; i += NT) { const int l = i >> 14, j = i & 16383, rr = j >> 7, prow = 4352 + (rr < 64 ? 64 + rr : 128 + rr); *(u32x4*)(p.ws + WS_W + (size_t)l * WL_B + (size_t)prow * 2048 + (size_t)(j & 127) * 16) = (u32x4){0u, 0u, 0u, 0u}; }
    bf16_t* Wm = (bf16_t*)(p.ws + WS_WM);
    for (int i = gt; i < 2 * 6 * 128 * 64; i += NT) { const int e = 2 * i, jj = e & 127, ii = (e >> 7) & 127; const float a = p.in[I_WSD][e], b = p.in[I_WSD][e + 1];
        *(unsigned*)(Wm + e) = pk2(jj <= ii ? a : 0.f, jj + 1 <= ii ? b : 0.f); }
    float* rope = (float*)(p.ws + WS_ROPE);
    for (int i = gt; i < 2049 * 8; i += NT) { const int pos = (i >> 3) == 2048 ? 16384 : (i >> 3); double rev = (double)pos * (double)INV_FREQ[i & 7] * 0.15915494309189535; rev -= rint(rev);
        const float rf = (float)rev; rope[2 * i] = __builtin_amdgcn_cosf(rf); rope[2 * i + 1] = __builtin_amdgcn_sinf(rf); }
}
DI void norm_phase(const float* xp, const float* xs, float* xcopy, const float* gain, bf16_t* H, int gw, int NGW, int lane) {
    f32x4 gv[4];
#pragma unroll
    for (int j = 0; j < 4; ++j) gv[j] = ((const f32x4*)gain)[lane + 64 * j];
    f32x4 nx[4];
    auto rowptr = [&](int m) -> const float* { return (xs && m >= MP) ? xs + (size_t)(m - MP) * 1024 : xp + (size_t)m * 1024; };
    if (gw < MTOK) {
#pragma unroll
        for (int j = 0; j < 4; ++j) nx[j] = ((const f32x4*)rowptr(gw))[lane + 64 * j];
    }
    for (int m = gw; m < MPAD; m += NGW) {
        u32x2* ho = (u32x2*)(H + (size_t)m * 1024) + lane;
        if (m >= MTOK) {
#pragma unroll
            for (int j = 0; j < 4; ++j) { ho[64 * j] = (u32x2){0u, 0u}; if (xcopy) ((f32x4*)(xcopy + (size_t)m * 1024))[lane + 64 * j] = (f32x4){0.f, 0.f, 0.f, 0.f}; }
            continue;
        }
        f32x4 v[4]; float ss = 0.f;
#pragma unroll
        for (int j = 0; j < 4; ++j) { v[j] = nx[j]; ss += (v[j].x * v[j].x + v[j].y * v[j].y) + (v[j].z * v[j].z + v[j].w * v[j].w); }
        if (m + NGW < MTOK) {
#pragma unroll
            for (int j = 0; j < 4; ++j) nx[j] = ((const f32x4*)rowptr(m + NGW))[lane + 64 * j];
        }
        const float rs = 1.0f / sqrtf(wave_sum(ss) * (1.f / 1024.f) + EPS);
#pragma unroll
        for (int j = 0; j < 4; ++j) { const f32x4 g = gv[j];
            ho[64 * j] = (u32x2){pk2(v[j].x * rs * g.x, v[j].y * rs * g.y), pk2(v[j].z * rs * g.z, v[j].w * rs * g.w)};
            if (xcopy) ((f32x4*)(xcopy + (size_t)m * 1024))[lane + 64 * j] = v[j]; }
    }
}
DI void qk_phase(const Params& p, int l, int gw, int NGW, int lane) {
    bf16_t* ZG = (bf16_t*)(p.ws + WS_ZG); const float* rope = (const float*)(p.ws + WS_ROPE);
    const int sub = lane & 7, hh = lane >> 3;
    float gnv[4][8];
#pragma unroll
    for (int gi = 0; gi < 4; ++gi) {
        const float* gn = hh < 6 ? (gi == 0 ? p.in[I_QNA] + l * 64 : p.in[I_QNB] + (l * 3 + gi - 1) * 64) : (gi == 0 ? p.in[I_KNA] + l * 64 : p.in[I_KNB] + (l * 3 + gi - 1) * 64);
        const f32x4 g0 = *(const f32x4*)(gn + sub * 8), g1 = *(const f32x4*)(gn + sub * 8 + 4);
#pragma unroll
        for (int e = 0; e < 4; ++e) { gnv[gi][e] = g0[e]; gnv[gi][4 + e] = g1[e]; }
    }
    u32x4 nxt[4];
    if (gw < MTOK) {
#pragma unroll
        for (int gi = 0; gi < 4; ++gi) nxt[gi] = *(const u32x4*)(ZG + (size_t)gw * ZLD + gi * 640 + lane * 8);
    }
    for (int m = gw; m < MTOK; m += NGW) {
        const bool samp = m >= MP; const int b = samp ? m - MP : m >> 11, t = samp ? 0 : (m & 2047);
        const float* rp = rope + (samp ? 2048 : t) * 16;
        bf16_t* zrow = ZG + (size_t)m * ZLD;
        u32x4 cur[4];
#pragma unroll
        for (int gi = 0; gi < 4; ++gi) cur[gi] = nxt[gi];
        if (m + NGW < MTOK) {
#pragma unroll
            for (int gi = 0; gi < 4; ++gi) nxt[gi] = *(const u32x4*)(ZG + (size_t)(m + NGW) * ZLD + gi * 640 + lane * 8);
        }
        f32x4 rc0, rc1, rc2, rc3;
        if (sub < 2) { rc0 = *(const f32x4*)rp; rc1 = *(const f32x4*)(rp + 4); rc2 = *(const f32x4*)(rp + 8); rc3 = *(const f32x4*)(rp + 12); }
#pragma unroll
        for (int gi = 0; gi < 4; ++gi) {
            const int W = gi == 0 ? 128 : (gi == 1 ? 128 : (gi == 2 ? 512 : 2048));
            const size_t obase_p = gi == 0 ? O_AP : (gi == 1 ? O_B1P : (gi == 2 ? O_B2P : O_B3P)), obase_s = gi == 0 ? O_AS : (gi == 1 ? O_B1S : (gi == 2 ? O_B2S : O_B3S));
            float x[8]; unpack8(cur[gi], x);
            float ss = 0.f;
#pragma unroll
            for (int e = 0; e < 8; ++e) ss += x[e] * x[e];
            ss += __shfl_xor(ss, 1); ss += __shfl_xor(ss, 2); ss += __shfl_xor(ss, 4);
            const float rs = 1.0f / sqrtf(ss * (1.f / 64.f) + EPS);
#pragma unroll
            for (int e = 0; e < 8; ++e) x[e] = x[e] * rs * gnv[gi][e];
            float y[8];
#pragma unroll
            for (int e = 0; e < 8; ++e) y[e] = __shfl_xor(x[e], 1);
            if (sub < 2) {
                const float cs[16] = {rc0[0], rc0[1], rc0[2], rc0[3], rc1[0], rc1[1], rc1[2], rc1[3], rc2[0], rc2[1], rc2[2], rc2[3], rc3[0], rc3[1], rc3[2], rc3[3]};
#pragma unroll
                for (int e = 0; e < 8; ++e) { const float c = cs[2 * e], s = cs[2 * e + 1]; x[e] = sub == 0 ? x[e] * c - y[e] * s : x[e] * c + y[e] * s; }
            }
            *(u32x4*)(zrow + gi * 640 + lane * 8) = pack8(x);
            const int jrow = samp ? W - 1 : t - (2048 - W);
            const size_t cb = samp ? obase_s + ((size_t)(l * 128 + b) * 2) * W * 128 : obase_p + ((size_t)(l * 16 + b) * 2) * W * 128;
            if (jrow >= 0) {
                if (hh >= 6) { float* d = p.out + cb + (size_t)jrow * 128 + (hh - 6) * 64 + sub * 8; *(f32x4*)d = (f32x4){x[0], x[1], x[2], x[3]}; *(f32x4*)(d + 4) = (f32x4){x[4], x[5], x[6], x[7]}; }
                if (lane < 16) { float v[8]; unpack8(*(const u32x4*)(zrow + gi * 640 + 512 + lane * 8), v);
                    float* d = p.out + cb + (size_t)(W + jrow) * 128 + lane * 8; *(f32x4*)d = (f32x4){v[0], v[1], v[2], v[3]}; *(f32x4*)(d + 4) = (f32x4){v[4], v[5], v[6], v[7]}; }
            }
        }
        if (lane < 48 && (samp || t >= 2046)) {
            float gc[8], xc[8]; unpack8(*(const u32x4*)(zrow + 2944 + lane * 8), gc); unpack8(*(const u32x4*)(zrow + 3328 + lane * 8), xc);
            f32x4 z0 = (f32x4){gc[0] * xc[0], gc[1] * xc[1], gc[2] * xc[2], gc[3] * xc[3]}, z1 = (f32x4){gc[4] * xc[4], gc[5] * xc[5], gc[6] * xc[6], gc[7] * xc[7]};
            if (samp) {
                float* d = p.out + O_CS + ((size_t)(l * 128 + b) * 2) * BW + lane * 8; const float* s1 = p.in[I_SC] + ((size_t)(l * 128 + b) * 2 + 1) * BW + lane * 8;
                *(f32x4*)d = *(const f32x4*)s1; *(f32x4*)(d + 4) = *(const f32x4*)(s1 + 4); *(f32x4*)(d + BW) = z0; *(f32x4*)(d + BW + 4) = z1;
                float vd[8]; unpack8(*(const u32x4*)(zrow + 4096 + lane * 8), vd); float* dd = p.out + O_DS + (size_t)(l * 128 + b) * BW + lane * 8;
                *(f32x4*)dd = (f32x4){vd[0], vd[1], vd[2], vd[3]}; *(f32x4*)(dd + 4) = (f32x4){vd[4], vd[5], vd[6], vd[7]};
            } else { float* d = p.out + O_CP + ((size_t)(l * 16 + b) * 2 + (t - 2046)) * BW + lane * 8; *(f32x4*)d = z0; *(f32x4*)(d + 4) = z1; }
        }
    }
}
DI bf16x8 vt_frag(LAS unsigned char* img, int rowbase0, int tstep, int cc, int lane) {
    const int q = (lane & 15) >> 2, p4 = lane & 3, blk = (lane >> 4) & 1;
    const int colb = (32 * cc + 16 * blk + 4 * p4) * 2;
    const s16x4 lo = __builtin_amdgcn_ds_read_tr16_b64_v4i16((LAS s16x4*)(img + (rowbase0 + q) * 144 + colb));
    const s16x4 hi = __builtin_amdgcn_ds_read_tr16_b64_v4i16((LAS s16x4*)(img + (rowbase0 + tstep + q) * 144 + colb));
    return __builtin_shufflevector(lo, hi, 0, 1, 2, 3, 4, 5, 6, 7);
}
DI void attn_unit(LAS unsigned char* qimg, LAS unsigned char* img, const bf16_t* ZG, int tok0, int dil, int qb, int gi, int kvh, bf16_t* Obuf, int ostr, float* lse_out, const float* sink, int lane) {
    const int r = lane & 31, h = lane >> 5;
    const int colq = gi * 640 + kvh * 192, colk = gi * 640 + 384 + kvh * 64, colv = gi * 640 + 512 + kvh * 64;
    const int tq = tok0 + dil * (32 * qb + r);
    const bf16_t* qrow = ZG + (size_t)tq * ZLD + colq + 32 * h;
    {
        bf16x8 qv[12];
#pragma unroll
        for (int i = 0; i < 12; ++i) qv[i] = *(const bf16x8*)(qrow + (i >> 2) * 64 + 8 * (i & 3));
#pragma unroll
        for (int i = 0; i < 12; ++i) *(LAS bf16x8*)(qimg + i * 1024 + lane * 16) = qv[i];
    }
    f32x16 o[3][2]; float mrun[3], lrun[3];
#pragma unroll
    for (int g = 0; g < 3; ++g) { mrun[g] = -1e30f; lrun[g] = 0.f;
#pragma unroll
        for (int i = 0; i < 16; ++i) { o[g][0][i] = 0.f; o[g][1][i] = 0.f; } }
    const float SC = 0.125f * LOG2E;
    const int c0 = qb >= 4 ? 0 : 4 - qb;
    bf16x8 kf[4], vv[4];
    { const bf16_t* krow = ZG + (size_t)(tok0 + dil * (32 * (qb - 4 + c0) + r)) * ZLD + 32 * h;
#pragma unroll
      for (int ks = 0; ks < 4; ++ks) { kf[ks] = *(const bf16x8*)(krow + colk + 8 * ks); vv[ks] = *(const bf16x8*)(krow + colv + 8 * ks); } }
    for (int c = c0; c < 5; ++c) {
#pragma unroll
        for (int ks = 0; ks < 4; ++ks) *(LAS bf16x8*)(img + r * 144 + 64 * h + 16 * ks) = vv[ks];
        bf16x8 kc[4];
#pragma unroll
        for (int ks = 0; ks < 4; ++ks) kc[ks] = kf[ks];
        if (c < 4) {
            const bf16_t* krow = ZG + (size_t)(tok0 + dil * (32 * (qb - 3 + c) + r)) * ZLD + 32 * h;
#pragma unroll
            for (int ks = 0; ks < 4; ++ks) { kf[ks] = *(const bf16x8*)(krow + colk + 8 * ks); vv[ks] = *(const bf16x8*)(krow + colv + 8 * ks); }
        }
        bf16x8 vf[2][2];
#pragma unroll
        for (int s = 0; s < 2; ++s)
#pragma unroll
            for (int cc = 0; cc < 2; ++cc) vf[s][cc] = vt_frag(img, 16 * s + 4 * h, 8, cc, lane);
#pragma unroll
        for (int g = 0; g < 3; ++g) {
            f32x16 s;
#pragma unroll
            for (int i = 0; i < 16; ++i) s[i] = 0.f;
#pragma unroll
            for (int ks = 0; ks < 4; ++ks) s = MFMA32(kc[ks], *(const LAS bf16x8*)(qimg + (g * 4 + ks) * 1024 + lane * 16), s);
            float t[16]; float mx = -1e30f;
#pragma unroll
            for (int i = 0; i < 16; ++i) { const int cr = crow(i, h); const bool valid = c == 0 ? (cr >= r) : (c == 4 ? (cr <= r) : true); t[i] = valid ? s[i] * SC : -1e30f; mx = fmaxf(mx, t[i]); }
            mx = fmaxf(mx, __shfl_xor(mx, 32));
            const float mnew = fmaxf(mrun[g], mx), alpha = ex2(mrun[g] - mnew);
            float rsum = 0.f;
#pragma unroll
            for (int i = 0; i < 16; ++i) { t[i] = ex2(t[i] - mnew); rsum += t[i]; }
            rsum += __shfl_xor(rsum, 32);
            lrun[g] = lrun[g] * alpha + rsum; mrun[g] = mnew;
#pragma unroll
            for (int i = 0; i < 16; ++i) { o[g][0][i] *= alpha; o[g][1][i] *= alpha; }
#pragma unroll
            for (int s2 = 0; s2 < 2; ++s2) {
                u32x4 pw; pw.x = pk2(t[8 * s2], t[8 * s2 + 1]); pw.y = pk2(t[8 * s2 + 2], t[8 * s2 + 3]); pw.z = pk2(t[8 * s2 + 4], t[8 * s2 + 5]); pw.w = pk2(t[8 * s2 + 6], t[8 * s2 + 7]);
                const bf16x8 pf = __builtin_bit_cast(bf16x8, pw);
                o[g][0] = MFMA32(vf[s2][0], pf, o[g][0]); o[g][1] = MFMA32(vf[s2][1], pf, o[g][1]);
            }
        }
    }
#pragma unroll
    for (int g = 0; g < 3; ++g) {
        const int head = kvh * 3 + g; float lsum = lrun[g];
        if (sink) lsum += ex2(sink[head] * LOG2E - mrun[g]);
        const float inv = 1.0f / lsum;
        bf16_t* orow = Obuf + (size_t)tq * ostr + head * 64 + 4 * h;
#pragma unroll
        for (int cc = 0; cc < 2; ++cc)
#pragma unroll
            for (int q4 = 0; q4 < 4; ++q4) *(u32x2*)(orow + 32 * cc + 8 * q4) = (u32x2){pk2(o[g][cc][4 * q4] * inv, o[g][cc][4 * q4 + 1] * inv), pk2(o[g][cc][4 * q4 + 2] * inv, o[g][cc][4 * q4 + 3] * inv)};
        if (lse_out && h == 0) lse_out[(size_t)tq * 8 + head] = (mrun[g] + __builtin_amdgcn_logf(lsum)) * LN2;
    }
}
DI void sattn_unit(const bf16_t* ZG, const float* cache, int W, int dil, int b, int gi, int hq, bf16_t* Obuf, int ostr, float* lse_out, const float* sink, int lane) {
    const int m = MP + b, kvh = hq / 3; const bf16_t* zrow = ZG + (size_t)m * ZLD + gi * 640;
    const bf16_t* qp = zrow + hq * 64;
    const float* Kc = cache + ((size_t)(b * 2 + 0) * W) * 128 + kvh * 64;
    const float* Vc = cache + ((size_t)(b * 2 + 1) * W) * 128 + kvh * 64;
    const float* k0 = Kc + (size_t)(W - (1 + lane) * dil) * 128; const float* k1 = Kc + (size_t)(W - (65 + lane) * dil) * 128;
    float s0 = 0.f, s1 = 0.f, s2 = 0.f;
#pragma unroll 2
    for (int d8 = 0; d8 < 8; ++d8) {
        float q[8], kn[8]; unpack8(*(const u32x4*)(qp + 8 * d8), q); unpack8(*(const u32x4*)(zrow + 384 + kvh * 64 + 8 * d8), kn);
        const f32x4 a0 = *(const f32x4*)(k0 + 8 * d8), a1 = *(const f32x4*)(k0 + 8 * d8 + 4), b0 = *(const f32x4*)(k1 + 8 * d8), b1 = *(const f32x4*)(k1 + 8 * d8 + 4);
#pragma unroll
        for (int e = 0; e < 4; ++e) { s0 += q[e] * a0[e] + q[4 + e] * a1[e]; s1 += q[e] * b0[e] + q[4 + e] * b1[e]; s2 += q[e] * kn[e] + q[4 + e] * kn[4 + e]; }
    }
    s0 *= 0.125f; s1 *= 0.125f; s2 *= 0.125f;
    const float mx = fmaxf(wave_max(fmaxf(s0, s1)), s2);
    const float p0 = __expf(s0 - mx), p1 = __expf(s1 - mx), p2 = __expf(s2 - mx);
    float lsum = wave_sum(p0 + p1) + p2;
    if (sink) lsum += __expf(sink[hq] - mx);
    float acc = p2 * bf1(zrow[512 + kvh * 64 + lane]);
    for (int n0 = 1; n0 <= 64; n0 += 8) {
        float va[8], vb[8];
#pragma unroll
        for (int j = 0; j < 8; ++j) { va[j] = Vc[(size_t)(W - (n0 + j) * dil) * 128 + lane]; vb[j] = Vc[(size_t)(W - (n0 + j + 64) * dil) * 128 + lane]; }
#pragma unroll
        for (int j = 0; j < 8; ++j) acc += __shfl(p0, n0 + j - 1) * va[j] + __shfl(p1, n0 + j - 1) * vb[j];
    }
    Obuf[(size_t)m * ostr + hq * 64 + lane] = (bf16_t)(pk2(acc / lsum, 0.f) & 0xffffu);
    if (lse_out && lane == 0) lse_out[(size_t)m * 8 + hq] = mx + __logf(lsum);
}
DI void sg_unit(LAS unsigned char* img, const bf16_t* ZG, const bf16_t* Wm, const float* bs, int T0, int g, int ib, bf16_t* Od, int ostr, int lane) {
    const int r = lane & 31, h = lane >> 5;
    f32x16 acc[2];
#pragma unroll
    for (int i = 0; i < 16; ++i) { acc[0][i] = 0.f; acc[1][i] = 0.f; }
    const bf16_t* wrow = Wm + ((size_t)g * 128 + 32 * ib + r) * 128 + 8 * h;
    for (int jc = 0; jc <= ib; ++jc) {
        const bf16_t* vrow = ZG + (size_t)(T0 + 32 * jc + r) * ZLD + 4096 + g * 64 + 32 * h;
#pragma unroll
        for (int ks = 0; ks < 4; ++ks) { const bf16x8 vv = *(const bf16x8*)(vrow + 8 * ks); *(LAS bf16x8*)(img + r * 144 + 64 * h + 16 * ks) = vv; }
#pragma unroll
        for (int s = 0; s < 2; ++s) {
            const bf16x8 wf = *(const bf16x8*)(wrow + 32 * jc + 16 * s);
            acc[0] = MFMA32(vt_frag(img, 16 * s + 8 * h, 4, 0, lane), wf, acc[0]);
            acc[1] = MFMA32(vt_frag(img, 16 * s + 8 * h, 4, 1, lane), wf, acc[1]);
        }
    }
    const int tok = T0 + 32 * ib + r; const float bias = bs[g * 128 + 32 * ib + r];
    const bf16_t* urow = ZG + (size_t)tok * ZLD + 3712 + g * 64 + 4 * h; bf16_t* orow = Od + (size_t)tok * ostr + g * 64 + 4 * h;
#pragma unroll
    for (int cc = 0; cc < 2; ++cc)
#pragma unroll
        for (int q4 = 0; q4 < 4; ++q4) { const u32x2 uw = *(const u32x2*)(urow + 32 * cc + 8 * q4);
            *(u32x2*)(orow + 32 * cc + 8 * q4) = (u32x2){pk2(bflo(uw.x) * (acc[cc][4 * q4] + bias), bfhi(uw.x) * (acc[cc][4 * q4 + 1] + bias)), pk2(bflo(uw.y) * (acc[cc][4 * q4 + 2] + bias), bfhi(uw.y) * (acc[cc][4 * q4 + 3] + bias))}; }
}

#ifndef NAIVE_ATTN
#define NAIVE_ATTN 0
#endif
#ifndef NAIVE_SG
#define NAIVE_SG 0
#endif
DI void naive_attn_phase(const Params& p, int l, int gt, int NT) {
    const bf16_t* ZG = (const bf16_t*)(p.ws + WS_ZG); bf16_t* BR = (bf16_t*)(p.ws + WS_BR); bf16_t* OB = (bf16_t*)(p.ws + WS_OB); float* LSE = (float*)(p.ws + WS_LSE);
    const int sub = gt & 3;
    for (int it = gt >> 2; it < MP * 24; it += NT >> 2) {
        const int m = it / 24, rem = it % 24, hq = rem % 6, gi = rem / 6, t = m & 2047, dil = gi < 2 ? 1 : (gi == 2 ? 4 : 16), kvh = hq / 3;
        float q[16], acc[16];
        { float a[8], b[8]; const bf16_t* qp = ZG + (size_t)m * ZLD + gi * 640 + hq * 64 + sub * 16; unpack8(*(const u32x4*)qp, a); unpack8(*(const u32x4*)(qp + 8), b);
#pragma unroll
          for (int e = 0; e < 8; ++e) { q[e] = a[e]; q[8 + e] = b[e]; acc[e] = 0.f; acc[8 + e] = 0.f; } }
        float mx = -1e30f, ls = 0.f;
        for (int n = 0; n <= 128; ++n) {
            if (t - n * dil < 0) break;
            const bf16_t* kp = ZG + (size_t)(m - n * dil) * ZLD + gi * 640 + 384 + kvh * 64 + sub * 16;
            float a[8], b[8]; unpack8(*(const u32x4*)kp, a); unpack8(*(const u32x4*)(kp + 8), b);
            float d = 0.f;
#pragma unroll
            for (int e = 0; e < 8; ++e) d += q[e] * a[e] + q[8 + e] * b[e];
            d += __shfl_xor(d, 1); d += __shfl_xor(d, 2); d *= 0.125f;
            const float mn = fmaxf(mx, d), al = __expf(mx - mn), pe = __expf(d - mn);
            unpack8(*(const u32x4*)(kp + 128), a); unpack8(*(const u32x4*)(kp + 136), b);
#pragma unroll
            for (int e = 0; e < 8; ++e) { acc[e] = acc[e] * al + pe * a[e]; acc[8 + e] = acc[8 + e] * al + pe * b[e]; }
            ls = ls * al + pe; mx = mn;
        }
        if (gi == 0) ls += __expf(p.in[I_SINK][l * 6 + hq] - mx);
        const float inv = 1.0f / ls; float o[8], o2[8];
#pragma unroll
        for (int e = 0; e < 8; ++e) { o[e] = acc[e] * inv; o2[e] = acc[8 + e] * inv; }
        bf16_t* op = (gi == 0 ? BR : OB + (size_t)(gi - 1) * MPAD * BW) + (size_t)m * BW + hq * 64 + sub * 16;
        *(u32x4*)op = pack8(o); *(u32x4*)(op + 8) = pack8(o2);
        if (gi > 0 && sub == 0) LSE[(size_t)(gi - 1) * MPAD * 8 + (size_t)m * 8 + hq] = mx + __logf(ls);
    }
}
DI void naive_sg_phase(const Params& p, int l, int gt, int NT) {
    const bf16_t* ZG = (const bf16_t*)(p.ws + WS_ZG); bf16_t* BR = (bf16_t*)(p.ws + WS_BR);
    for (int it = gt; it < MP * 48; it += NT) {
        const int m = it / 48, c0 = (it % 48) * 8, g = c0 >> 6, i = m & 127, T0 = m - i;
        float sv[8];
#pragma unroll
        for (int e = 0; e < 8; ++e) sv[e] = 0.f;
        const float* wr = p.in[I_WSD] + ((size_t)(l * 6 + g) * 128 + i) * 128;
        for (int j = 0; j <= i; ++j) { float v[8]; unpack8(*(const u32x4*)(ZG + (size_t)(T0 + j) * ZLD + 4096 + c0), v); const float w = wr[j];
#pragma unroll
            for (int e = 0; e < 8; ++e) sv[e] += w * v[e]; }
        float u[8], o[8]; unpack8(*(const u32x4*)(ZG + (size_t)m * ZLD + 3712 + c0), u); const float bias = p.in[I_BSD][l * 768 + g * 128 + i];
#pragma unroll
        for (int e = 0; e < 8; ++e) o[e] = u[e] * (sv[e] + bias);
        *(u32x4*)(BR + 3ull * MPAD * BW + (size_t)m * BW + c0) = pack8(o);
    }
}
constexpr int CP_A = 256 * 32 * 127, CP_B2 = 256 * 32 * 511, CP_B3 = 256 * 32 * 2047, CP_T0 = CP_A, CP_T1 = 2 * CP_A, CP_T2 = CP_T1 + CP_B2, CP_T3 = CP_T2 + CP_B3, CP_NCH = CP_T3 / 64;
static_assert(CP_T3 % 64 == 0, "copy chunks");
DI void cp_decode(const Params& p, int l, int i, const float*& src, float*& dst) {
    if (i < CP_T0) { const int seg = i / (32 * 127), off = i % (32 * 127); const size_t base = ((size_t)l * 256 + seg) * 128 * 128; src = p.in[I_CA] + base + 128 + (size_t)off * 4; dst = p.out + O_AS + base + (size_t)off * 4; }
    else if (i < CP_T1) { i -= CP_T0; const int seg = i / (32 * 127), off = i % (32 * 127); const size_t base = ((size_t)l * 256 + seg) * 128 * 128; src = p.in[I_CB1] + base + 128 + (size_t)off * 4; dst = p.out + O_B1S + base + (size_t)off * 4; }
    else if (i < CP_T2) { i -= CP_T1; const int seg = i / (32 * 511), off = i % (32 * 511); const size_t base = ((size_t)l * 256 + seg) * 512 * 128; src = p.in[I_CB2] + base + 128 + (size_t)off * 4; dst = p.out + O_B2S + base + (size_t)off * 4; }
    else { i -= CP_T2; const int seg = i / (32 * 2047), off = i % (32 * 2047); const size_t base = ((size_t)l * 256 + seg) * 2048 * 128; src = p.in[I_CB3] + base + 128 + (size_t)off * 4; dst = p.out + O_B3S + base + (size_t)off * 4; }
}
constexpr int CP_NSL = 4;
DI void copy_slice(const Params& p, int l, int s, int gw, int NGW, int lane) {
    for (int c0 = s * NGW + gw; c0 < CP_NCH; c0 += 8 * CP_NSL * NGW) {
        f32x4 v[8]; float* dst[8]; bool ok[8];
#pragma unroll
        for (int q = 0; q < 8; ++q) { const int cid = c0 + q * CP_NSL * NGW; ok[q] = cid < CP_NCH; dst[q] = nullptr; v[q] = (f32x4){0.f, 0.f, 0.f, 0.f};
            if (ok[q]) { const float* src; cp_decode(p, l, cid * 64 + lane, src, dst[q]); v[q] = __builtin_nontemporal_load((const f32x4*)src); } }
#pragma unroll
        for (int q = 0; q < 8; ++q) if (ok[q]) __builtin_nontemporal_store(v[q], (f32x4*)dst[q]);
    }
}
DI void tail_copy(const Params& p, int l, int blk_lo, int blk_hi, int nwg, int wave) {
    int lane = (int)__builtin_amdgcn_mbcnt_hi(~0u, __builtin_amdgcn_mbcnt_lo(~0u, 0u)); asm volatile("" : "+v"(lane));
    int G = gridDim.x, bid = blockIdx.x; asm volatile("" : "+s"(G), "+s"(bid));
    const int r0 = nwg % G; if (r0 == 0 || bid < r0) return;
    const int ne = G - r0, e = bid - r0, nb = blk_hi - blk_lo;
    const int lo = blk_lo + (int)((long long)nb * e / ne), hi = blk_lo + (int)((long long)nb * (e + 1) / ne);
    for (int blk = lo + wave; blk < hi; blk += 8) {
        f32x4 v[16]; float* dst[16];
#pragma unroll
        for (int q = 0; q < 16; ++q) { const float* src; cp_decode(p, l, (blk * 16 + q) * 64 + lane, src, dst[q]); v[q] = __builtin_nontemporal_load((const f32x4*)src); }
#pragma unroll
        for (int q = 0; q < 16; ++q) __builtin_nontemporal_store(v[q], (f32x4*)dst[q]);
    }
}
constexpr int CP_NB = CP_NCH / 16, CPQ0 = 0, CPQ1 = 3149, CPQ2 = 7874, CPQ3 = 11023, CPQ4 = 14060, CPQ5 = CP_NB;
static_assert(CP_NCH % 16 == 0 && CP_NB == 22496, "copy blocks");
DI void mixer_phase(const Params& p, LAS unsigned char* lds, int l, int gw, int NGW, int wave, int lane, int gt, int NT) {
    const bf16_t* ZG = (const bf16_t*)(p.ws + WS_ZG);
    bf16_t* BR = (bf16_t*)(p.ws + WS_BR); bf16_t* OB = (bf16_t*)(p.ws + WS_OB); float* LSE = (float*)(p.ws + WS_LSE);
    LAS unsigned char* qimg = lds + wave * 16896; LAS unsigned char* img = qimg + 12288;
    constexpr int NCMP = 7;
    { const int bid_ = gw >> 3, G_ = NGW >> 3;
      if (wave >= NCMP) return;
      gw = bid_ * NCMP + wave; NGW = G_ * NCMP; gt = bid_ * (NCMP * 64) + wave * 64 + lane; NT = G_ * (NCMP * 64); }
#ifndef MIX_REP
#define MIX_REP 0
#endif
    for (int rep_ = 0; rep_ < ((MIX_REP & 1) ? 2 : 1); ++rep_)
    for (int u = gw; u < 8192; u += NGW) {
        const int gi = u >> 11, rem = u & 2047; const int ld = gi < 2 ? 0 : (gi == 2 ? 2 : 4), dil = 1 << ld, lnqb = 6 - ld;
        const int qb = rem & ((1 << lnqb) - 1), rem2 = rem >> lnqb, res = rem2 & (dil - 1), rem3 = rem2 >> ld, kvh = rem3 & 1, b = rem3 >> 1;
        attn_unit(qimg, img, ZG, b * 2048 + res, dil, qb, gi, kvh, gi == 0 ? BR : OB + (size_t)(gi - 1) * MPAD * BW, gi == 0 ? 4 * BW : BW, gi == 0 ? nullptr : LSE + (size_t)(gi - 1) * MPAD * 8, gi == 0 ? p.in[I_SINK] + l * 6 : nullptr, lane);
    }
    const bf16_t* Wm = (const bf16_t*)(p.ws + WS_WM) + (size_t)l * 6 * 128 * 128;
#if 0
#else
    for (int rep_ = 0; rep_ < ((MIX_REP & 2) ? 2 : 1); ++rep_)
    for (int u = gw; u < 6144; u += NGW) { const int ib = u & 3, g = (u >> 2) % 6, ch = u / 24; sg_unit(img, ZG, Wm, p.in[I_BSD] + l * 768, ch * 128, g, ib, BR + 3 * BW, 4 * BW, lane); }
#endif
    for (int rep_ = 0; rep_ < ((MIX_REP & 4) ? 2 : 1); ++rep_)
    for (int u = gw; u < 3072; u += NGW) {
        const int hq = u % 6, gi = (u / 6) & 3, b = u / 24; const int W = gi < 2 ? 128 : (gi == 2 ? 512 : 2048), dil = gi < 2 ? 1 : (gi == 2 ? 4 : 16);
        const float* cache = (gi == 0 ? p.in[I_CA] : (gi == 1 ? p.in[I_CB1] : (gi == 2 ? p.in[I_CB2] : p.in[I_CB3]))) + (size_t)l * 256 * W * 128;
        sattn_unit(ZG, cache, W, dil, b, gi, hq, gi == 0 ? BR : OB + (size_t)(gi - 1) * MPAD * BW, gi == 0 ? 4 * BW : BW, gi == 0 ? nullptr : LSE + (size_t)(gi - 1) * MPAD * 8, gi == 0 ? p.in[I_SINK] + l * 6 : nullptr, lane);
    }
    const float* cw = p.in[I_CONV] + l * 3 * BW;
    for (int it = gt; it < (MP / 16) * 48; it += NT) {
        const int run = it / 48, c0 = (it % 48) * 8, m0 = run * 16, t0 = m0 & 2047;
        float w0[8], w1[8], w2[8], z1[8], z2[8];
#pragma unroll
        for (int e = 0; e < 8; ++e) { w0[e] = cw[c0 + e]; w1[e] = cw[BW + c0 + e]; w2[e] = cw[2 * BW + c0 + e]; z1[e] = 0.f; z2[e] = 0.f; }
        if (t0 >= 2) { float a[8], bb[8]; const bf16_t* zr = ZG + (size_t)(m0 - 1) * ZLD;
            unpack8(*(const u32x4*)(zr + 2944 + c0), a); unpack8(*(const u32x4*)(zr + 3328 + c0), bb);
#pragma unroll
            for (int e = 0; e < 8; ++e) z1[e] = a[e] * bb[e];
            unpack8(*(const u32x4*)(zr - ZLD + 2944 + c0), a); unpack8(*(const u32x4*)(zr - ZLD + 3328 + c0), bb);
#pragma unroll
            for (int e = 0; e < 8; ++e) z2[e] = a[e] * bb[e]; }
        for (int b4 = 0; b4 < 4; ++b4) {
            u32x4 rb[4], rc[4], rx[4];
#pragma unroll
            for (int j = 0; j < 4; ++j) { const bf16_t* zr = ZG + (size_t)(m0 + 4 * b4 + j) * ZLD; rb[j] = *(const u32x4*)(zr + 2560 + c0); rc[j] = *(const u32x4*)(zr + 2944 + c0); rx[j] = *(const u32x4*)(zr + 3328 + c0); }
#pragma unroll
            for (int j = 0; j < 4; ++j) {
                const int m = m0 + 4 * b4 + j, t = t0 + 4 * b4 + j;
                float gb[8], gc[8], xc[8], zc[8], oc[8]; unpack8(rb[j], gb); unpack8(rc[j], gc); unpack8(rx[j], xc);
#pragma unroll
                for (int e = 0; e < 8; ++e) { zc[e] = gc[e] * xc[e]; oc[e] = gb[e] * (w0[e] * z2[e] + w1[e] * z1[e] + w2[e] * zc[e]); z2[e] = z1[e]; z1[e] = zc[e]; }
                *(u32x4*)(BR + (size_t)m * (4 * BW) + 2 * BW + c0) = pack8(oc);
                if (t >= 2046) { float* d = p.out + O_CP + ((size_t)(l * 16 + (m >> 11)) * 2 + (t - 2046)) * BW + c0; *(f32x4*)d = (f32x4){zc[0], zc[1], zc[2], zc[3]}; *(f32x4*)(d + 4) = (f32x4){zc[4], zc[5], zc[6], zc[7]}; }
            }
        }
    }
    for (int it = gt; it < MS * 48; it += NT) {
        const int b = it / 48, c0 = (it % 48) * 8, m = MP + b;
        const bf16_t* zrow = ZG + (size_t)m * ZLD;
        float gb[8], gc[8], xc[8], uu[8], vv[8], oc[8], od[8];
        unpack8(*(const u32x4*)(zrow + 2560 + c0), gb); unpack8(*(const u32x4*)(zrow + 2944 + c0), gc); unpack8(*(const u32x4*)(zrow + 3328 + c0), xc);
        unpack8(*(const u32x4*)(zrow + 3712 + c0), uu); unpack8(*(const u32x4*)(zrow + 4096 + c0), vv);
        const float* s = p.in[I_SC] + ((size_t)(l * 128 + b) * 2) * BW + c0;
        const int g = c0 >> 6; const float w00 = p.in[I_WSD][((size_t)l * 6 + g) * 16384], b0 = p.in[I_BSD][l * 768 + g * 128];
        float* dc = p.out + O_CS + ((size_t)(l * 128 + b) * 2) * BW + c0; float* dd = p.out + O_DS + (size_t)(l * 128 + b) * BW + c0;
#pragma unroll
        for (int e = 0; e < 8; ++e) { const float zc = gc[e] * xc[e]; oc[e] = gb[e] * (cw[c0 + e] * s[e] + cw[BW + c0 + e] * s[BW + e] + cw[2 * BW + c0 + e] * zc); od[e] = uu[e] * (w00 * vv[e] + b0);
            dc[e] = s[BW + e]; dc[BW + e] = zc; dd[e] = vv[e]; }
        *(u32x4*)(BR + (size_t)m * (4 * BW) + 2 * BW + c0) = pack8(oc);
        *(u32x4*)(BR + (size_t)m * (4 * BW) + 3 * BW + c0) = pack8(od);
    }
}
DI void merge_phase(const Params& p, int gt, int NT) {
    bf16_t* BR = (bf16_t*)(p.ws + WS_BR); const bf16_t* OB = (const bf16_t*)(p.ws + WS_OB); const float* LSE = (const float*)(p.ws + WS_LSE);
    for (int it = gt; it < MTOK * 48; it += NT) {
        const int m = it / 48, cch = it % 48, head = cch >> 3;
        const float l0 = LSE[(size_t)m * 8 + head], l1 = LSE[(size_t)MPAD * 8 + (size_t)m * 8 + head], l2 = LSE[2ull * MPAD * 8 + (size_t)m * 8 + head];
        const float mx = fmaxf(l0, fmaxf(l1, l2)); float w0 = __expf(l0 - mx), w1 = __expf(l1 - mx), w2 = __expf(l2 - mx); const float inv = 1.0f / (w0 + w1 + w2); w0 *= inv; w1 *= inv; w2 *= inv;
        float a[8], b[8], c[8], o[8];
        unpack8(*(const u32x4*)(OB + (size_t)m * BW + cch * 8), a); unpack8(*(const u32x4*)(OB + (size_t)MPAD * BW + (size_t)m * BW + cch * 8), b); unpack8(*(const u32x4*)(OB + 2ull * MPAD * BW + (size_t)m * BW + cch * 8), c);
#pragma unroll
        for (int e = 0; e < 8; ++e) o[e] = w0 * a[e] + w1 * b[e] + w2 * c[e];
        *(u32x4*)(BR + (size_t)m * (4 * BW) + BW + cch * 8) = pack8(o);
    }
}
constexpr int NPH = 20;
DI void grid_barrier(unsigned* bar, unsigned target, int wave_s) {
    __syncthreads();
    if (wave_s == 0) {
        if (__builtin_amdgcn_mbcnt_hi(~0u, __builtin_amdgcn_mbcnt_lo(~0u, 0u)) == 0u) {
            __builtin_amdgcn_fence(__ATOMIC_RELEASE, "agent");
            __hip_atomic_fetch_add(bar, 1u, __ATOMIC_RELAXED, __HIP_MEMORY_SCOPE_AGENT);
            while (__hip_atomic_load(bar, __ATOMIC_RELAXED, __HIP_MEMORY_SCOPE_AGENT) < target) __builtin_amdgcn_s_sleep(1);
        }
        __builtin_amdgcn_fence(__ATOMIC_ACQUIRE, "agent");
    }
    __syncthreads();
}
#ifndef DEBUG_CHK
#define DEBUG_CHK 0
#endif
#if DEBUG_CHK
DI const float* xin_row(const Params& p, int m) { return m < MP ? p.in[I_XP] + (size_t)m * 1024 : p.in[I_XS] + (size_t)(m - MP) * 1024; }
DI void dbg_phase(const Params& p, int kind_in, int gw, int NGW, int lane, int gt, int NT) {
    const int L = (kind_in >= 10 && kind_in < 20) ? 1 : 0, kind = kind_in == 99 ? 99 : kind_in - 10 * L;
    float* dbg = (float*)(p.ws + WS_BAR + 128);
    const bf16_t* ZG = (const bf16_t*)(p.ws + WS_ZG); const bf16_t* BR = (const bf16_t*)(p.ws + WS_BR); const bf16_t* MRG = (const bf16_t*)(p.ws + WS_MRG);
    const bf16_t* H = (const bf16_t*)(p.ws + WS_H); const bf16_t* ACT = (const bf16_t*)(p.ws + WS_ACT); const float* X = (const float*)(p.ws + WS_X);
    if (kind == 99) {
        int code = 0;
        for (int k = 1; k <= 7; ++k) if (code == 0 && dbg[k] > 1e-3f * dbg[8 + k]) code = k;
        if (code) { const float a = 1.0f + 0.1f * sqrtf((float)code); for (int i = gt; i < 98304; i += NT) p.out[O_DS + i] *= a; }
        return;
    }
    for (int s = gw; s < 16384; s += NGW) {
        const int m = MP + (int)(((unsigned)s * 2654435761u) % 128u), ci = s & 7; const unsigned hsh = (unsigned)s * 40503u + 12345u; float fast = 0.f, naive = 0.f;
        const float* xr = L ? X + (size_t)m * 1024 : xin_row(p, m);
        if (kind == 1) {
            int c = (int)(hsh % 8576u); if (c >= 4480) c += 128;
            float ss = 0.f; for (int k = lane; k < 1024; k += 64) ss += xr[k] * xr[k];
            const float rs = 1.0f / sqrtf(wave_sum(ss) * (1.f / 1024.f) + EPS); float acc = 0.f;
            for (int k = lane; k < 1024; k += 64) { const float hv = xr[k] * rs * p.in[I_LN1][L * 1024 + k];
                acc += hv * (c < GOFF ? p.in[I_WIN][(size_t)L * 1024 * 4480 + (size_t)k * 4480 + c] : p.in[I_WG][(size_t)L * 4 * 1048576 + ((size_t)((c - GOFF) >> 10) * 1024 + k) * 1024 + ((c - GOFF) & 1023)]); }
            acc = wave_sum(acc); naive = c < GOFF ? acc : 1.0f / (1.0f + __expf(-(acc + p.in[I_BG][L * 4096 + c - GOFF])));
            fast = bf1(ZG[(size_t)m * ZLD + c]);
        } else if (kind == 2 || kind == 3 || kind == 6) {
            const int c = (int)(hsh & 1023u);
            float v = 0.f;
            if (kind == 2) {
                for (int n = 0; n < 4; ++n) { float acc = 0.f; for (int k = lane; k < 384; k += 64) acc += bf1(BR[((size_t)n * MPAD + m) * BW + k]) * p.in[I_WB][(size_t)L * 4 * 384 * 1024 + ((size_t)n * 384 + k) * 1024 + c];
                    v += bf1(ZG[(size_t)m * ZLD + GOFF + n * 1024 + c]) * wave_sum(acc); }
                naive = v; fast = bf1(MRG[(size_t)m * 1024 + c]);
            } else {
                float acc = 0.f; for (int k = lane; k < 1024; k += 64) acc += bf1(MRG[(size_t)m * 1024 + k]) * p.in[I_WO][(size_t)k * 1024 + c];
                v = xr[c] + wave_sum(acc);
                if (kind == 6) { float a2 = 0.f; for (int k = lane; k < DFF; k += 64) a2 += bf1(ACT[(size_t)m * DFF + k]) * p.in[I_WFO][(size_t)k * 1024 + c]; v += wave_sum(a2); }
                naive = v; fast = X[(size_t)m * 1024 + c];
            }
        } else if (kind == 7) {
            const int hs = (int)(hsh & 31u), gi = hs >> 3, hh = hs & 7, col0 = gi * 640 + hh * 64;
            float ss = 0.f; for (int k = lane; k < 1024; k += 64) ss += xr[k] * xr[k];
            const float rs = 1.0f / sqrtf(wave_sum(ss) * (1.f / 1024.f) + EPS); float z = 0.f;
            for (int k = 0; k < 1024; ++k) z += xr[k] * rs * p.in[I_LN1][k] * p.in[I_WIN][(size_t)k * 4480 + col0 + lane];
            const float r2 = 1.0f / sqrtf(wave_sum(z * z) * (1.f / 64.f) + EPS);
            const float* gn = hh < 6 ? (gi == 0 ? p.in[I_QNA] : p.in[I_QNB] + (gi - 1) * 64) : (gi == 0 ? p.in[I_KNA] : p.in[I_KNB] + (gi - 1) * 64);
            float y = z * r2 * gn[lane];
            const float pos = m >= MP ? 16384.f : (float)(m & 2047); const float ang = pos * INV_FREQ[lane & 7];
            const float other = __shfl_xor(y, 8);
            if (lane < 8) y = y * cosf(ang) - other * sinf(ang); else if (lane < 16) y = y * cosf(ang) + other * sinf(ang);
            naive = y; fast = bf1(ZG[(size_t)m * ZLD + col0 + lane]);
            atomicAdd(&dbg[kind], (fast - naive) * (fast - naive)); atomicAdd(&dbg[8 + kind], naive * naive); continue;
        } else if (kind == 7 + 100) {
        } else if (kind == 9) {
            const int b = m - MP, hq = (int)(hsh % 6u), gi = (int)((hsh >> 8) & 3u), kvh = hq / 3, W = gi < 2 ? 128 : (gi == 2 ? 512 : 2048), dil = gi < 2 ? 1 : (gi == 2 ? 4 : 16);
            const float* cache = (gi == 0 ? p.in[I_CA] : (gi == 1 ? p.in[I_CB1] : (gi == 2 ? p.in[I_CB2] : p.in[I_CB3])));
            const float* Kc = cache + ((size_t)(b * 2 + 0) * W) * 128 + kvh * 64; const float* Vc = cache + ((size_t)(b * 2 + 1) * W) * 128 + kvh * 64;
            const bf16_t* zr = ZG + (size_t)m * ZLD + gi * 640; const bf16_t* qp = zr + hq * 64;
            float sc[3], pv[3]; float mx = -1e30f;
            for (int j = 0; j < 3; ++j) { const int n = j < 2 ? 1 + lane + 64 * j : 0; const bool ok = j < 2 || lane == 0; float dsum = 0.f;
                if (ok) { for (int e = 0; e < 64; ++e) dsum += bf1(qp[e]) * (n == 0 ? bf1(zr[384 + kvh * 64 + e]) : Kc[(size_t)(W - n * dil) * 128 + e]); }
                sc[j] = ok ? dsum * 0.125f : -1e30f; mx = fmaxf(mx, sc[j]); }
            mx = wave_max(mx); float ls = 0.f;
            for (int j = 0; j < 3; ++j) { pv[j] = sc[j] > -1e29f ? __expf(sc[j] - mx) : 0.f; ls += pv[j]; }
            ls = wave_sum(ls); if (gi == 0) ls += __expf(p.in[I_SINK][hq] - mx);
            const bf16_t* fo = (gi == 0 ? BR : (const bf16_t*)(p.ws + WS_OB) + (size_t)(gi - 1) * MPAD * BW) + (size_t)m * BW + hq * 64;
            for (int dd = 0; dd < 8; ++dd) { float a = 0.f;
                for (int j = 0; j < 3; ++j) { const int n = j < 2 ? 1 + lane + 64 * j : 0; if (pv[j] > 0.f) a += pv[j] * (n == 0 ? bf1(zr[512 + kvh * 64 + dd]) : Vc[(size_t)(W - n * dil) * 128 + dd]); }
                a = wave_sum(a) / ls; const float f = bf1(fo[dd]);
                if (lane == 0) { atomicAdd(&dbg[7], (f - a) * (f - a)); atomicAdd(&dbg[15], a * a); } }
            continue;
        } else if (kind == 8) {
            const int mm = (int)(((unsigned)s * 2654435761u) % (unsigned)MP), hq = (int)(hsh % 6u), gi = (int)((hsh >> 8) & 3u), t = mm & 2047, dil = gi < 2 ? 1 : (gi == 2 ? 4 : 16), kvh = hq / 3;
            const bf16_t* qp = ZG + (size_t)mm * ZLD + gi * 640 + hq * 64;
            float sc[3], pv[3]; float mx = -1e30f;
            for (int j = 0; j < 3; ++j) { const int n = j < 2 ? lane + 64 * j : 128; const bool ok = (j < 2 || lane == 0) && (t - n * dil >= 0); float dsum = 0.f;
                if (ok) { const bf16_t* kp = ZG + (size_t)(mm - n * dil) * ZLD + gi * 640 + 384 + kvh * 64; for (int e = 0; e < 64; ++e) dsum += bf1(qp[e]) * bf1(kp[e]); }
                sc[j] = ok ? dsum * 0.125f : -1e30f; mx = fmaxf(mx, sc[j]); }
            mx = wave_max(mx); float ls = 0.f;
            for (int j = 0; j < 3; ++j) { pv[j] = sc[j] > -1e29f ? __expf(sc[j] - mx) : 0.f; ls += pv[j]; }
            ls = wave_sum(ls); if (gi == 0) ls += __expf(p.in[I_SINK][hq] - mx);
            const bf16_t* fo = (gi == 0 ? BR : (const bf16_t*)(p.ws + WS_OB) + (size_t)(gi - 1) * MPAD * BW) + (size_t)mm * BW + hq * 64;
            for (int dd = 0; dd < 8; ++dd) { float a = 0.f;
                for (int j = 0; j < 3; ++j) { const int n = j < 2 ? lane + 64 * j : 128; if (pv[j] > 0.f) a += pv[j] * bf1(ZG[(size_t)(mm - n * dil) * ZLD + gi * 640 + 512 + kvh * 64 + dd]); }
                a = wave_sum(a) / ls; const float f = bf1(fo[dd]);
                if (lane == 0) { atomicAdd(&dbg[gi], (f - a) * (f - a)); atomicAdd(&dbg[8 + gi], a * a); } }
            if (gi > 0 && lane == 0) { const float lf = ((const float*)(p.ws + WS_LSE))[(size_t)(gi - 1) * MPAD * 8 + (size_t)mm * 8 + hq], ln = mx + __logf(ls); atomicAdd(&dbg[4], (lf - ln) * (lf - ln)); atomicAdd(&dbg[12], 1.0f); }
            continue;
        } else if (kind == 4) {
            const int c = (int)(hsh & 1023u); const float* xx = X + (size_t)m * 1024;
            float ss = 0.f; for (int k = lane; k < 1024; k += 64) ss += xx[k] * xx[k];
            const float rs = 1.0f / sqrtf(wave_sum(ss) * (1.f / 1024.f) + EPS); naive = xx[c] * rs * p.in[I_LN2][L * 1024 + c]; fast = bf1(H[(size_t)m * 1024 + c]);
        } else if (kind == 5) {
            const int c = (int)(hsh % 2816u);
            float a1 = 0.f, a2 = 0.f; for (int k = lane; k < 1024; k += 64) { const float hv = bf1(H[(size_t)m * 1024 + k]); a1 += hv * p.in[I_WFI][(size_t)L * 1024 * 5632 + (size_t)k * 5632 + c]; a2 += hv * p.in[I_WFI][(size_t)L * 1024 * 5632 + (size_t)k * 5632 + DFF + c]; }
            a1 = wave_sum(a1); a2 = wave_sum(a2); naive = a1 / (1.0f + __expf(-a1)) * a2; fast = bf1(ACT[(size_t)m * DFF + c]);
        }
        if (lane == 0) { atomicAdd(&dbg[kind], (fast - naive) * (fast - naive)); atomicAdd(&dbg[8 + kind], naive * naive); }
    }
}
#endif
template <int PH> DI void run_phase(const Params& p0, LAS unsigned char* lds, int wave_s) {
    Params p;
    { int z_ = 0; asm volatile("" : "+s"(z_));
#pragma unroll
      for (int i = 0; i < 24; ++i) p.in[i] = p0.in[i + z_];
      p.out = (&p0.out)[z_]; p.ws = (&p0.ws)[z_]; p.ph_lo = 0; p.ph_hi = 0; }
    int tid = wave_s * 64 + (int)__builtin_amdgcn_mbcnt_hi(~0u, __builtin_amdgcn_mbcnt_lo(~0u, 0u)); asm volatile("" : "+v"(tid));
    const int G = gridDim.x, bid = blockIdx.x, NGW = G * 8, NT = G * 512;
    const int lane = tid & 63, wave = wave_s, gw = bid * 8 + wave, gt = bid * 512 + tid;
    float* X = (float*)(p.ws + WS_X); bf16_t* H = (bf16_t*)(p.ws + WS_H); bf16_t* ZG = (bf16_t*)(p.ws + WS_ZG);
    if constexpr (PH == 0) {
        prologue_weights(p, lds, gw, NGW, wave, lane);
        prologue_misc(p, gt, NT);
        norm_phase(p.in[I_XP], p.in[I_XS], nullptr, p.in[I_LN1], H, gw, NGW, lane);
    } else {
        constexpr int l = (PH - 1) / 10, k = (PH - 1) % 10;
        unsigned char* wl = p.ws + WS_W + (size_t)l * WL_B;
        const bf16_t* W1t = (const bf16_t*)wl; const bf16_t* Wbt = (const bf16_t*)(wl + W1_B); const bf16_t* Wot = (const bf16_t*)(wl + W1_B + WB_B);
        const bf16_t* Wft = (const bf16_t*)(wl + W1_B + WB_B + WO_B); const bf16_t* Wdt = (const bf16_t*)(wl + W1_B + WB_B + WO_B + WF_B);
        if constexpr (k == 0) {
            pg8::Gemm g{H, W1t, MPAD, ZLD, 1024}; pg8::StaticOrder S; S.init(MPAD, ZLD, G, bid);
            EpiZG E{ZG, p.in[I_BG] + (size_t)l * 4096, (const float*)(p.ws + WS_ROPE), p.in[I_QNA] + l * 64, p.in[I_KNA] + l * 64, p.in[I_QNB] + l * 192, p.in[I_KNB] + l * 192, p.out, l};
            pg8::gemm_phase<EpiZG, pg8::StaticOrder, PG8_ALIGN, PG8_SP2>(lds, g, S, E, tid);
            tail_copy(p, l, CPQ0, CPQ1, NTM * 34, wave_s);
        } else if constexpr (k == 1) {
        } else if constexpr (k == 2) {
            mixer_phase(p, lds, l, gw, NGW, wave, lane, gt, NT);
        } else if constexpr (k == 3) {
            merge_phase(p, gt, NT);
        } else if constexpr (k == 4) {
            pg8::Gemm g{(const bf16_t*)(p.ws + WS_BR), Wbt, MPAD, 1024, 4 * BW}; pg8::StaticOrder S; S.init(MPAD, 1024, G, bid);
            EpiBranch E{ZG, (bf16_t*)(p.ws + WS_MRG)};
            pg8::gemm_phase<EpiBranch, pg8::StaticOrder, PG8_ALIGN, PG8_SP2>(lds, g, S, E, tid);
            tail_copy(p, l, CPQ1, CPQ2, NTM * 4, wave_s);
        } else if constexpr (k == 5) {
            pg8::Gemm g{(const bf16_t*)(p.ws + WS_MRG), Wot, MPAD, 1024, 1024}; pg8::StaticOrder S; S.init(MPAD, 1024, G, bid);
            EpiResid E{l == 0 ? p.in[I_XP] : X, X, MPAD, l == 0 ? p.in[I_XS] : nullptr};
            pg8::gemm_phase<EpiResid, pg8::StaticOrder, PG8_ALIGN, PG8_SP2>(lds, g, S, E, tid);
            tail_copy(p, l, CPQ2, CPQ3, NTM * 4, wave_s);
        } else if constexpr (k == 6) {
            norm_phase(X, nullptr, nullptr, p.in[I_LN2] + l * 1024, H, gw, NGW, lane);
        } else if constexpr (k == 7) {
            pg8::Gemm g{H, Wft, MPAD, 2 * DFF, 1024}; pg8::StaticOrder S; S.init(MPAD, 2 * DFF, G, bid);
            EpiSwiglu E{(bf16_t*)(p.ws + WS_ACT)};
            pg8::gemm_phase<EpiSwiglu, pg8::StaticOrder, PG8_ALIGN, PG8_SP2>(lds, g, S, E, tid);
            tail_copy(p, l, CPQ3, CPQ4, NTM * 22, wave_s);
        } else if constexpr (k == 8) {
            pg8::Gemm g{(const bf16_t*)(p.ws + WS_ACT), Wdt, MPAD, 1024, DFF}; pg8::StaticOrder S; S.init(MPAD, 1024, G, bid);
            EpiResid E{X, l == 1 ? p.out : X, l == 1 ? MTOK : MPAD, nullptr};
            pg8::gemm_phase<EpiResid, pg8::StaticOrder, PG8_ALIGN, PG8_SP2>(lds, g, S, E, tid);
            tail_copy(p, l, CPQ4, CPQ5, NTM * 4, wave_s);
        } else {
            if constexpr (l == 0) norm_phase(X, nullptr, nullptr, p.in[I_LN1] + 1024, H, gw, NGW, lane);
        }
    }
}
__global__ void __launch_bounds__(512, 2) fwd_kernel(Params p) {
    extern __shared__ __attribute__((aligned(16))) unsigned char lds_raw[];
    LAS unsigned char* lds = (LAS unsigned char*)lds_raw;
    const int wave_s = __builtin_amdgcn_readfirstlane(threadIdx.x >> 6);
    unsigned* bar = (unsigned*)(p.ws + WS_BAR); const unsigned nblk = gridDim.x;
    if (p.ph_hi - p.ph_lo > 1) cg::this_grid().sync();
#if DEBUG_CHK
    if (p.ph_lo >= 100) { const int tid = threadIdx.x; dbg_phase(p, p.ph_lo - 100, blockIdx.x * 8 + wave_s, gridDim.x * 8, tid & 63, blockIdx.x * 512 + tid, gridDim.x * 512); return; }
#endif
#ifndef REP_MASK
#define REP_MASK 0u
#endif
#define EMPTYPH(K) ((K) == 2 || (K) == 12)
#define NEMPTY(K) ((unsigned)(((K) > 2) + ((K) > 12)))
#define RUN(K) if (!EMPTYPH(K) && p.ph_lo <= (K) && (K) < p.ph_hi) { if ((K) > p.ph_lo) grid_barrier(bar, ((unsigned)((K) - p.ph_lo) - NEMPTY(K)) * nblk, wave_s); run_phase<(K)>(p, lds, wave_s); }
    RUN(0) RUN(1) RUN(2) RUN(3) RUN(4) RUN(5) RUN(6) RUN(7) RUN(8) RUN(9) RUN(10) RUN(11) RUN(12) RUN(13) RUN(14) RUN(15) RUN(16) RUN(17) RUN(18) RUN(19)
#undef RUN
}
}

extern "C" void kernel_launch(void* const* d_in, const int* in_sizes, int n_in, void* d_out, int out_size, void* d_ws, size_t ws_size, hipStream_t stream) {
    static int grid = 0;
    if (grid == 0) {
        if (n_in != 24 || (size_t)out_size != mk::O_END || ws_size < mk::WS_END) { fprintf(stderr, "kernel_launch: unexpected shapes: n_in %d out %d ws %zu (need %zu)\n", n_in, out_size, ws_size, (size_t)mk::WS_END); grid = -1; return; }
        int dev = 0, cus = 0, per_cu = 0;
        if (hipGetDevice(&dev) != hipSuccess || hipDeviceGetAttribute(&cus, hipDeviceAttributeMultiprocessorCount, dev) != hipSuccess) { fprintf(stderr, "kernel_launch: device query failed\n"); grid = -1; return; }
        if (hipFuncSetAttribute((const void*)mk::fwd_kernel, hipFuncAttributeMaxDynamicSharedMemorySize, mk::LDS_BYTES) != hipSuccess) { fprintf(stderr, "kernel_launch: hipFuncSetAttribute failed\n"); grid = -1; return; }
        if (hipOccupancyMaxActiveBlocksPerMultiprocessor(&per_cu, (const void*)mk::fwd_kernel, 512, mk::LDS_BYTES) != hipSuccess || per_cu < 1) { fprintf(stderr, "kernel_launch: occupancy query gave %d\n", per_cu); per_cu = 1; }
        (void)hipGetLastError();
        grid = cus * 1;
    }
    if (grid < 0) return;
    if (hipMemsetAsync((char*)d_ws + mk::WS_BAR, 0, 256, stream) != hipSuccess) { fprintf(stderr, "kernel_launch: memset failed\n"); return; }
    mk::Params p{};
    for (int i = 0; i < 24; ++i) p.in[i] = (const float*)d_in[i];
    p.out = (float*)d_out; p.ws = (unsigned char*)d_ws;
#if ONE_LAUNCH
    p.ph_lo = 0; p.ph_hi = mk::NPH;
    void* args[] = {&p};
    hipError_t e = hipLaunchCooperativeKernel((const void*)mk::fwd_kernel, dim3(grid), dim3(512), args, mk::LDS_BYTES, stream);
    if (e != hipSuccess) fprintf(stderr, "kernel_launch: cooperative launch failed: %s (grid %d)\n", hipGetErrorString(e), grid);
#else
    for (int ph = 0; ph < mk::NPH; ++ph) {
        p.ph_lo = ph; p.ph_hi = ph + 1;
        hipLaunchKernelGGL(mk::fwd_kernel, dim3(grid), dim3(512), mk::LDS_BYTES, stream, p);
#if DEBUG_CHK
        const int kind = ph == 1 ? 1 : ph == 3 ? 9 : ph == 5 ? 2 : ph == 6 ? 3 : ph == 7 ? 4 : ph == 8 ? 5 : ph == 9 ? 6 : 0;
        if (kind) { p.ph_lo = 100 + kind; p.ph_hi = 101 + kind; hipLaunchKernelGGL(mk::fwd_kernel, dim3(grid), dim3(512), mk::LDS_BYTES, stream, p); }
#endif
    }
#if DEBUG_CHK
    p.ph_lo = 199; p.ph_hi = 200; hipLaunchKernelGGL(mk::fwd_kernel, dim3(grid), dim3(512), mk::LDS_BYTES, stream, p);
#endif
#endif
}
```
